# Optimizing an MI355X kernel written in HIP

```python
import math
import jax, jax.numpy as jnp
from jax import lax
import numpy as np

D_MODEL = 2048
BATCH = 16
SEQ = 256
DEPTH = 2
DEC_BATCH = 2
DEC_SEQ = 1024
PAST_LEN = 512

GRID_W = 64
D_ATT = 1024
D_HY = 1024
D_MIX = D_ATT + D_HY
HEAD_DIM = 128
N_HEADS = D_ATT // HEAD_DIM
N_KV_HEADS = 4
GROUP = N_HEADS // N_KV_HEADS
D_KV = N_KV_HEADS * HEAD_DIM
Q_BLOCK = 128
ROPE_THETA = 10000.0
ROPE_PAIRS_AXIS = HEAD_DIM // 4
SHORT_CONV = 3
POS_BANDS = 16
POS_EMB = 1 + 2 * POS_BANDS
FILT_HID = 64
DECAY_TARGET = 1e-2
FAST_DECAY_PCT = 0.3
SLOW_DECAY_PCT = 1.5
DECAY_SHIFT = 0.05
EPS = 1e-6
SPLIT_Q = D_ATT
SPLIT_K = SPLIT_Q + D_KV
SPLIT_V = SPLIT_K + D_KV
SPLIT_GA = SPLIT_V + D_ATT
SPLIT_HY = SPLIT_GA + 3 * D_HY
D_IN = SPLIT_HY + D_HY

kernel_name = "hymba_attn_hyena_prefix_dit_step"


def rmsnorm(x, g):
    x32 = x.astype(jnp.float32)
    y = x32 * lax.rsqrt(jnp.mean(x32 * x32, axis=-1, keepdims=True) + EPS)
    return (y * g.astype(jnp.float32)).astype(x.dtype)


def rope_tables(n_tokens):
    rows = n_tokens // GRID_W
    t = jnp.arange(rows * GRID_W)
    row = (t // GRID_W).astype(jnp.float32)
    col = (t % GRID_W).astype(jnp.float32)
    inv_freq = ROPE_THETA ** (-jnp.arange(ROPE_PAIRS_AXIS, dtype=jnp.float32) / ROPE_PAIRS_AXIS)
    ang = jnp.concatenate([row[:, None] * inv_freq, col[:, None] * inv_freq], axis=-1)
    return jnp.cos(ang), jnp.sin(ang)


def apply_rope(x, cos, sin):
    xr = x.reshape(x.shape[:-1] + (HEAD_DIM // 2, 2))
    x0, x1 = xr[..., 0], xr[..., 1]
    c = cos[None, :, None, :].astype(x.dtype)
    s = sin[None, :, None, :].astype(x.dtype)
    out = jnp.stack([x0 * c - x1 * s, x0 * s + x1 * c], axis=-1)
    return out.reshape(x.shape)


def attend(q, k, v):
    B, Lq = q.shape[0], q.shape[1]
    nb = Lq // Q_BLOCK
    scale = 1.0 / math.sqrt(HEAD_DIM)
    qb = q.reshape(B, nb, Q_BLOCK, N_KV_HEADS, GROUP, HEAD_DIM).transpose(1, 0, 2, 3, 4, 5)

    def one_block(qblk):
        s = jnp.einsum('bqkgd,bskd->bkgqs', qblk, k).astype(jnp.float32) * scale
        p = jax.nn.softmax(s, axis=-1).astype(v.dtype)
        return jnp.einsum('bkgqs,bskd->bqkgd', p, v)

    o = lax.map(one_block, qb)
    return o.transpose(1, 0, 2, 3, 4, 5).reshape(B, Lq, D_ATT)


def short_conv(u, w, b):
    up = jnp.pad(u, ((0, 0), (1, 1), (0, 0)))
    return w[0] * up[:, :-2] + w[1] * up[:, 1:-1] + w[2] * up[:, 2:] + b


def implicit_filter(L, f_w1, f_b1, f_w2, f_b2, f_w3, f_freq):
    f32 = jnp.float32
    tpos = jnp.arange(L, dtype=f32)
    t_norm = tpos / max(L - 1, 1)
    w = 2.0 * math.pi * tpos / L
    bands = jnp.linspace(1e-4, POS_BANDS - 1, POS_BANDS, dtype=f32)
    z = jnp.concatenate([t_norm[:, None], jnp.cos(w[:, None] * bands), -jnp.sin(w[:, None] * bands)], axis=-1)
    freq = f_freq.astype(f32)
    hdn = jnp.sin(freq * (z @ f_w1.astype(f32) + f_b1.astype(f32)))
    hdn = jnp.sin(freq * (hdn @ f_w2.astype(f32) + f_b2.astype(f32)))
    h = hdn @ f_w3.astype(f32)
    max_decay = math.log(DECAY_TARGET) / FAST_DECAY_PCT
    min_decay = math.log(DECAY_TARGET) / SLOW_DECAY_PCT
    deltas = jnp.abs(jnp.linspace(min_decay, max_decay, D_HY, dtype=f32))
    deltas = jnp.concatenate([deltas, deltas])
    h = h * (jnp.exp(-t_norm[:, None] * deltas) + DECAY_SHIFT)
    h_f, h_b = h[:, :D_HY], h[:, D_HY:]
    return jnp.concatenate([h_f[:1] + h_b[:1], h_f[1:], jnp.zeros((1, D_HY), f32), h_b[1:][::-1]], axis=0)


def hyena(u_in, conv_w, conv_b, f_w1, f_b1, f_w2, f_b2, f_w3, f_freq, hy_bias):
    L = u_in.shape[1]
    u = short_conv(u_in, conv_w, conv_b)
    x0, x1, vv = jnp.split(u, 3, axis=-1)
    z = vv * x1
    filt = implicit_filter(L, f_w1, f_b1, f_w2, f_b2, f_w3, f_freq)
    zf = jnp.fft.rfft(z.astype(jnp.float32), n=2 * L, axis=1)
    hf = jnp.fft.rfft(filt, axis=0)
    y = jnp.fft.irfft(zf * hf[None], n=2 * L, axis=1)[:, :L]
    y = y.astype(z.dtype) + hy_bias * z
    return x0 * y


def mixer_layer(x, mod, rope, ctx_kv, norm_g, w_in, q_g, k_g, conv_w, conv_b,
                f_w1, f_b1, f_w2, f_b2, f_w3, f_freq, hy_bias, w_out):
    B, L, _ = x.shape
    shift, scale, gate = jnp.split(mod, 3, axis=-1)
    h = rmsnorm(x, norm_g) * (1.0 + scale) + shift
    proj = h @ w_in
    q, k, v, g_att, hy_in, g_hy = jnp.split(proj, [SPLIT_Q, SPLIT_K, SPLIT_V, SPLIT_GA, SPLIT_HY], axis=-1)
    q = rmsnorm(q.reshape(B, L, N_HEADS, HEAD_DIM), q_g)
    k = rmsnorm(k.reshape(B, L, N_KV_HEADS, HEAD_DIM), k_g)
    v = v.reshape(B, L, N_KV_HEADS, HEAD_DIM)
    if rope is None:
        kv_out = (k, v)
        k_all, v_all = k, v
    else:
        cos, sin = rope
        q = apply_rope(q, cos, sin)
        k = apply_rope(k, cos, sin)
        k_all = jnp.concatenate([k, ctx_kv[0]], axis=1)
        v_all = jnp.concatenate([v, ctx_kv[1]], axis=1)
        kv_out = None
    att = attend(q, k_all, v_all) * jax.nn.silu(g_att)
    hy = hyena(hy_in, conv_w, conv_b, f_w1, f_b1, f_w2, f_b2, f_w3, f_freq, hy_bias) * jax.nn.silu(g_hy)
    out = jnp.concatenate([att, hy], axis=-1) @ w_out
    return x + gate * out, kv_out


def setup_inputs(seed: int = 0) -> dict:
    key = jax.random.key(seed)
    ks = jax.random.split(key, 26)

    def nrm(k, shape, s):
        return jax.random.normal(k, shape, jnp.float32) * s

    return {
        "x_prompt": nrm(ks[0], (BATCH, SEQ, D_MODEL), 1.0),
        "x_sample": nrm(ks[1], (DEC_BATCH, DEC_SEQ, D_MODEL), 1.0),
        "cache_k": nrm(ks[2], (DEC_BATCH, DEPTH, PAST_LEN, N_KV_HEADS, HEAD_DIM), 1.0),
        "cache_v": nrm(ks[3], (DEC_BATCH, DEPTH, PAST_LEN, N_KV_HEADS, HEAD_DIM), 1.0),
        "c": nrm(ks[4], (DEC_BATCH, D_MODEL), 1.0),
        "c_ctx": nrm(ks[5], (D_MODEL,), 1.0),
        "norm_g": 1.0 + nrm(ks[6], (DEPTH, D_MODEL), 0.1),
        "w_ada": nrm(ks[7], (DEPTH, D_MODEL, 3 * D_MODEL), 0.02),
        "b_ada": nrm(ks[8], (DEPTH, 3 * D_MODEL), 0.01),
        "w_in": nrm(ks[9], (DEPTH, D_MODEL, D_IN), D_MODEL ** -0.5),
        "q_norm_g": 1.0 + nrm(ks[10], (DEPTH, HEAD_DIM), 0.1),
        "k_norm_g": 1.0 + nrm(ks[11], (DEPTH, HEAD_DIM), 0.1),
        "conv_w": nrm(ks[12], (DEPTH, SHORT_CONV, 3 * D_HY), 0.5),
        "conv_b": nrm(ks[13], (DEPTH, 3 * D_HY), 0.02),
        "filt_w1": nrm(ks[14], (DEPTH, POS_EMB, FILT_HID), POS_EMB ** -0.5),
        "filt_b1": nrm(ks[15], (DEPTH, FILT_HID), 0.02),
        "filt_w2": nrm(ks[16], (DEPTH, FILT_HID, FILT_HID), FILT_HID ** -0.5),
        "filt_b2": nrm(ks[17], (DEPTH, FILT_HID), 0.02),
        "filt_w3": nrm(ks[18], (DEPTH, FILT_HID, 2 * D_HY), 0.02),
        "filt_freq": 1.0 + nrm(ks[19], (DEPTH, FILT_HID), 0.1),
        "hy_bias": nrm(ks[20], (DEPTH, D_HY), 0.1),
        "w_out": nrm(ks[21], (DEPTH, D_MIX, D_MODEL), D_MIX ** -0.5),
        "final_norm_g": 1.0 + nrm(ks[22], (D_MODEL,), 0.1),
    }


def reference(x_prompt, x_sample, cache_k, cache_v, c, c_ctx, norm_g, w_ada, b_ada, w_in,
              q_norm_g, k_norm_g, conv_w, conv_b, filt_w1, filt_b1, filt_w2, filt_b2,
              filt_w3, filt_freq, hy_bias, w_out, final_norm_g):
    rope = rope_tables(x_sample.shape[1])
    ctx = x_prompt
    lat = x_sample
    ks_out = []
    vs_out = []
    for l in range(DEPTH):
        lw = (norm_g[l], w_in[l], q_norm_g[l], k_norm_g[l], conv_w[l], conv_b[l],
              filt_w1[l], filt_b1[l], filt_w2[l], filt_b2[l], filt_w3[l], filt_freq[l],
              hy_bias[l], w_out[l])
        mod_ctx = (jax.nn.silu(c_ctx) @ w_ada[l] + b_ada[l])[None, None, :]
        mod_lat = (jax.nn.silu(c) @ w_ada[l] + b_ada[l])[:, None, :]
        ctx, kv = mixer_layer(ctx, mod_ctx, None, None, *lw)
        ks_out.append(kv[0])
        vs_out.append(kv[1])
        lat, _ = mixer_layer(lat, mod_lat, rope, (cache_k[:, l], cache_v[:, l]), *lw)
    y_prompt = rmsnorm(ctx, final_norm_g)
    y_sample = rmsnorm(lat, final_norm_g)
    new_k = jnp.stack(ks_out, axis=1)
    new_v = jnp.stack(vs_out, axis=1)
    return (y_prompt, y_sample, new_k, new_v)
```

```cpp
#include <hip/hip_runtime.h>
#include <cstdio>
#include <cstdint>

namespace {
constexpr int DM = 2048, NCTX = 4096, NLAT = 2048, NTOK = 6144, DIN = 7168;
constexpr int CB = 16, CS = 256, LB = 2, LS = 1024, PAST = 512;
constexpr int HD = 128, NH = 8, NKV = 4, DHY = 1024;
constexpr int OFF_Q = 0, OFF_K = 1024, OFF_V = 1536, OFF_GA = 2048, OFF_HY = 3072, OFF_GH = 6144;
constexpr float EPS = 1e-6f;
constexpr size_t OUT_NK = (size_t)NTOK * DM, OUT_NV = OUT_NK + (size_t)CB * 2 * CS * NKV * HD;

__device__ __forceinline__ float silu(float x) { return x / (1.f + expf(-x)); }
__device__ __forceinline__ int mod_of_tok(int tok) { return tok < NCTX ? 0 : 1 + (tok - NCTX) / LS; }
__device__ __forceinline__ float wave_sum(float v) {
#pragma unroll
    for (int o = 1; o < 64; o <<= 1) v += __shfl_xor(v, o);
    return v;
}

__global__ void __launch_bounds__(256) k_mod(const float* c, const float* c_ctx, const float* w_ada, const float* b_ada, float* mod) {
    __shared__ float sc[3][DM];
    const int l = blockIdx.y, n = blockIdx.x * 256 + threadIdx.x;
    for (int i = threadIdx.x; i < DM; i += 256) { sc[0][i] = silu(c_ctx[i]); sc[1][i] = silu(c[i]); sc[2][i] = silu(c[DM + i]); }
    __syncthreads();
    const float* w = w_ada + (size_t)l * DM * 3 * DM + n;
    float a0 = 0.f, a1 = 0.f, a2 = 0.f;
    for (int k = 0; k < DM; ++k) { const float wv = w[(size_t)k * 3 * DM]; a0 += sc[0][k] * wv; a1 += sc[1][k] * wv; a2 += sc[2][k] * wv; }
    const float b = b_ada[l * 3 * DM + n];
    float* m = mod + (size_t)l * 3 * 3 * DM;
    m[0 * 3 * DM + n] = a0 + b; m[1 * 3 * DM + n] = a1 + b; m[2 * 3 * DM + n] = a2 + b;
}

__global__ void __launch_bounds__(256) k_normmod(const float* x, const float* g, const float* mod, float* h) {
    __shared__ float red[4];
    const int tok = blockIdx.x, j = mod_of_tok(tok);
    const float* xr = x + (size_t)tok * DM;
    float v[8], s = 0.f;
#pragma unroll
    for (int i = 0; i < 8; ++i) { v[i] = xr[threadIdx.x + 256 * i]; s += v[i] * v[i]; }
    s = wave_sum(s);
    if ((threadIdx.x & 63) == 0) red[threadIdx.x >> 6] = s;
    __syncthreads();
    s = red[0] + red[1] + red[2] + red[3];
    const float rs = rsqrtf(s / DM + EPS);
    const float* shift = mod + (size_t)j * 3 * DM; const float* scale = shift + DM;
#pragma unroll
    for (int i = 0; i < 8; ++i) { const int d = threadIdx.x + 256 * i; h[(size_t)tok * DM + d] = v[i] * rs * g[d] * (1.f + scale[d]) + shift[d]; }
}

template <int EPI>
__global__ void __launch_bounds__(256) k_gemm(const float* A, const float* B, float* C, int M, int N, int K, const float* X, const float* mod) {
    __shared__ float As[16][64 + 4], Bs[16][64 + 4];
    const int tx = threadIdx.x & 15, ty = threadIdx.x >> 4, m0 = blockIdx.y * 64, n0 = blockIdx.x * 64;
    float acc[4][4] = {};
    for (int k0 = 0; k0 < K; k0 += 16) {
        for (int i = threadIdx.x; i < 64 * 16; i += 256) { const int r = i >> 4, kk = i & 15; As[kk][r] = A[(size_t)(m0 + r) * K + k0 + kk]; }
        for (int i = threadIdx.x; i < 64 * 16; i += 256) { const int kk = i >> 6, cc = i & 63; Bs[kk][cc] = B[(size_t)(k0 + kk) * N + n0 + cc]; }
        __syncthreads();
#pragma unroll
        for (int kk = 0; kk < 16; ++kk) {
            float a[4], b[4];
#pragma unroll
            for (int i = 0; i < 4; ++i) { a[i] = As[kk][ty * 4 + i]; b[i] = Bs[kk][tx * 4 + i]; }
#pragma unroll
            for (int i = 0; i < 4; ++i)
#pragma unroll
                for (int jj = 0; jj < 4; ++jj) acc[i][jj] += a[i] * b[jj];
        }
        __syncthreads();
    }
#pragma unroll
    for (int i = 0; i < 4; ++i) {
        const int m = m0 + ty * 4 + i;
#pragma unroll
        for (int jj = 0; jj < 4; ++jj) {
            const int n = n0 + tx * 4 + jj;
            if (EPI == 0) C[(size_t)m * N + n] = acc[i][jj];
            else { const float gate = mod[(size_t)mod_of_tok(m) * 3 * DM + 2 * DM + n]; C[(size_t)m * N + n] = X[(size_t)m * N + n] + gate * acc[i][jj]; }
        }
    }
}

__global__ void __launch_bounds__(64) k_qknorm(float* proj, const float* qg, const float* kg, float* out, int layer) {
    const int tok = blockIdx.x, slot = blockIdx.y, p = threadIdx.x;
    float* row = proj + (size_t)tok * DIN;
    const bool ctx = tok < NCTX;
    if (slot >= 12) {
        if (!ctx) return;
        const int kv = slot - 12, b = tok / CS, t = tok % CS;
        float* o = out + OUT_NV + ((((size_t)b * 2 + layer) * CS + t) * NKV + kv) * HD;
        o[2 * p] = row[OFF_V + kv * HD + 2 * p]; o[2 * p + 1] = row[OFF_V + kv * HD + 2 * p + 1];
        return;
    }
    const bool isq = slot < 8;
    float* hp = row + (isq ? OFF_Q + slot * HD : OFF_K + (slot - 8) * HD);
    const float* g = isq ? qg : kg;
    float x0 = hp[2 * p], x1 = hp[2 * p + 1];
    const float ss = wave_sum(x0 * x0 + x1 * x1);
    const float rs = rsqrtf(ss / HD + EPS);
    x0 = x0 * rs * g[2 * p]; x1 = x1 * rs * g[2 * p + 1];
    if (!ctx) {
        const int t = (tok - NCTX) % LS; const float rowp = (float)(t / 64), colp = (float)(t % 64);
        const int i = p & 31; const float invf = powf(10000.f, -(float)i / 32.f);
        const float ang = (p < 32 ? rowp : colp) * invf, cs = cosf(ang), sn = sinf(ang);
        const float y0 = x0 * cs - x1 * sn, y1 = x0 * sn + x1 * cs; x0 = y0; x1 = y1;
    }
    hp[2 * p] = x0; hp[2 * p + 1] = x1;
    if (ctx && !isq) {
        const int kv = slot - 8, b = tok / CS, t = tok % CS;
        float* o = out + OUT_NK + ((((size_t)b * 2 + layer) * CS + t) * NKV + kv) * HD;
        o[2 * p] = x0; o[2 * p + 1] = x1;
    }
}

__global__ void __launch_bounds__(128) k_attn(const float* proj, const float* cache_k, const float* cache_v, float* mix, int layer) {
    __shared__ float sc[1536], q[HD], red[2];
    const int tok = blockIdx.x, h = blockIdx.y, kv = h / 2, tid = threadIdx.x;
    const bool ctx = tok < NCTX;
    const int nk = ctx ? CS : LS + PAST;
    const int b = ctx ? tok / CS : (tok - NCTX) / LS;
    const int tok0 = ctx ? b * CS : NCTX + b * LS, nown = ctx ? CS : LS;
    q[tid] = proj[(size_t)tok * DIN + OFF_Q + h * HD + tid];
    __syncthreads();
    const float scale = 0.08838834764831845f;
    float lmax = -1e30f;
    for (int s = tid; s < nk; s += 128) {
        const float* kr = s < nown ? proj + (size_t)(tok0 + s) * DIN + OFF_K + kv * HD
                                   : cache_k + ((((size_t)b * 2 + layer) * PAST + (s - nown)) * NKV + kv) * HD;
        float d = 0.f;
        for (int i = 0; i < HD; ++i) d += q[i] * kr[i];
        d *= scale; sc[s] = d; lmax = fmaxf(lmax, d);
    }
#pragma unroll
    for (int o = 1; o < 64; o <<= 1) lmax = fmaxf(lmax, __shfl_xor(lmax, o));
    if ((tid & 63) == 0) red[tid >> 6] = lmax;
    __syncthreads();
    const float mx = fmaxf(red[0], red[1]);
    __syncthreads();
    float ls = 0.f;
    for (int s = tid; s < nk; s += 128) { const float e = expf(sc[s] - mx); sc[s] = e; ls += e; }
    ls = wave_sum(ls);
    if ((tid & 63) == 0) red[tid >> 6] = ls;
    __syncthreads();
    const float inv = 1.f / (red[0] + red[1]);
    float o = 0.f;
    for (int s = 0; s < nk; ++s) {
        const float* vr = s < nown ? proj + (size_t)(tok0 + s) * DIN + OFF_V + kv * HD
                                   : cache_v + ((((size_t)b * 2 + layer) * PAST + (s - nown)) * NKV + kv) * HD;
        o += sc[s] * vr[tid];
    }
    o *= inv;
    const float ga = proj[(size_t)tok * DIN + OFF_GA + h * HD + tid];
    mix[(size_t)tok * DM + h * HD + tid] = o * silu(ga);
}

__global__ void __launch_bounds__(256) k_filter(const float* w1, const float* b1, const float* w2, const float* b2, const float* w3, const float* freq, float* filt, int L) {
    __shared__ float z[33], h1[64], h2[64];
    const int t = blockIdx.x, tid = threadIdx.x;
    const float t_norm = (float)t / (float)(L - 1);
    const float w = 2.0f * 3.14159265358979323846f * (float)t / (float)L;
    if (tid < 33) {
        float v;
        if (tid == 0) v = t_norm;
        else { const int i = (tid - 1) & 15; const float band = 1e-4f + (float)i * ((15.f - 1e-4f) / 15.f); v = tid <= 16 ? cosf(w * band) : -sinf(w * band); }
        z[tid] = v;
    }
    __syncthreads();
    if (tid < 64) { float a = b1[tid]; for (int i = 0; i < 33; ++i) a += z[i] * w1[i * 64 + tid]; h1[tid] = sinf(freq[tid] * a); }
    __syncthreads();
    if (tid < 64) { float a = b2[tid]; for (int i = 0; i < 64; ++i) a += h1[i] * w2[i * 64 + tid]; h2[tid] = sinf(freq[tid] * a); }
    __syncthreads();
    const float max_decay = logf(1e-2f) / 0.3f, min_decay = logf(1e-2f) / 1.5f;
    for (int cc = tid; cc < 2048; cc += 256) {
        float a = 0.f;
        for (int i = 0; i < 64; ++i) a += h2[i] * w3[i * 2048 + cc];
        const int c = cc & 1023;
        const float delta = fabsf(min_decay + (float)c * ((max_decay - min_decay) / 1023.f));
        filt[(size_t)t * 2048 + cc] = a * (expf(-t_norm * delta) + 0.05f);
    }
}

__global__ void __launch_bounds__(256) k_hypre(const float* proj, const float* cw, const float* cb, float* zb, float* x0b) {
    const int tok = blockIdx.x;
    const bool ctx = tok < NCTX;
    const int t = ctx ? tok % CS : (tok - NCTX) % LS, L = ctx ? CS : LS;
    const float* r0 = proj + (size_t)tok * DIN + OFF_HY;
    for (int c = threadIdx.x; c < DHY; c += 256) {
        float u[3];
#pragma unroll
        for (int part = 0; part < 3; ++part) {
            const int ch = part * DHY + c;
            float a = cb[ch] + cw[1 * 3072 + ch] * r0[ch];
            if (t > 0) a += cw[0 * 3072 + ch] * r0[ch - DIN];
            if (t < L - 1) a += cw[2 * 3072 + ch] * r0[ch + DIN];
            u[part] = a;
        }
        zb[(size_t)tok * DHY + c] = u[2] * u[1];
        x0b[(size_t)tok * DHY + c] = u[0];
    }
}

__global__ void __launch_bounds__(256) k_hyconv(const float* zb, const float* x0b, const float* filt256, const float* filt1024, const float* hy_bias, const float* proj, float* mix) {
    const int tok = blockIdx.x;
    const bool ctx = tok < NCTX;
    const int t = ctx ? tok % CS : (tok - NCTX) % LS, L = ctx ? CS : LS, tok0 = tok - t;
    const float* filt = ctx ? filt256 : filt1024;
    for (int c = threadIdx.x; c < DHY; c += 256) {
        float y = 0.f;
        for (int s = 0; s < L; ++s) {
            const float zv = zb[(size_t)(tok0 + s) * DHY + c];
            const int d = t - s;
            float g;
            if (d > 0) g = filt[(size_t)d * 2048 + c];
            else if (d < 0) g = filt[(size_t)(-d) * 2048 + 1024 + c];
            else g = filt[c] + filt[1024 + c];
            y += g * zv;
        }
        const float zt = zb[(size_t)tok * DHY + c];
        y += hy_bias[c] * zt;
        const float gh = proj[(size_t)tok * DIN + OFF_GH + c];
        mix[(size_t)tok * DM + DHY + c] = x0b[(size_t)tok * DHY + c] * y * silu(gh);
    }
}

__global__ void __launch_bounds__(256) k_finalnorm(const float* x, const float* g, float* out) {
    __shared__ float red[4];
    const int tok = blockIdx.x;
    const float* xr = x + (size_t)tok * DM;
    float v[8], s = 0.f;
#pragma unroll
    for (int i = 0; i < 8; ++i) { v[i] = xr[threadIdx.x + 256 * i]; s += v[i] * v[i]; }
    s = wave_sum(s);
    if ((threadIdx.x & 63) == 0) red[threadIdx.x >> 6] = s;
    __syncthreads();
    s = red[0] + red[1] + red[2] + red[3];
    const float rs = rsqrtf(s / DM + EPS);
#pragma unroll
    for (int i = 0; i < 8; ++i) { const int d = threadIdx.x + 256 * i; out[(size_t)tok * DM + d] = v[i] * rs * g[d]; }
}
}

extern "C" void kernel_launch(void* const* d_in, const int* in_sizes, int n_in, void* d_out, int out_size, void* d_ws, size_t ws_size, hipStream_t stream) {
    const float* x_prompt = (const float*)d_in[0]; const float* x_sample = (const float*)d_in[1];
    const float* cache_k = (const float*)d_in[2]; const float* cache_v = (const float*)d_in[3];
    const float* c = (const float*)d_in[4]; const float* c_ctx = (const float*)d_in[5];
    const float* norm_g = (const float*)d_in[6]; const float* w_ada = (const float*)d_in[7]; const float* b_ada = (const float*)d_in[8];
    const float* w_in = (const float*)d_in[9]; const float* q_g = (const float*)d_in[10]; const float* k_g = (const float*)d_in[11];
    const float* conv_w = (const float*)d_in[12]; const float* conv_b = (const float*)d_in[13];
    const float* f_w1 = (const float*)d_in[14]; const float* f_b1 = (const float*)d_in[15]; const float* f_w2 = (const float*)d_in[16];
    const float* f_b2 = (const float*)d_in[17]; const float* f_w3 = (const float*)d_in[18]; const float* f_freq = (const float*)d_in[19];
    const float* hy_bias = (const float*)d_in[20]; const float* w_out = (const float*)d_in[21]; const float* fin_g = (const float*)d_in[22];
    float* out = (float*)d_out;
    float* ws = (float*)d_ws;
    size_t off = 0;
    float* mod = ws + off; off += 2 * 3 * 3 * DM;
    float* filt256 = ws + off; off += (size_t)256 * 2048;
    float* filt1024 = ws + off; off += (size_t)1024 * 2048;
    float* xcur = ws + off; off += (size_t)NTOK * DM;
    float* hmix = ws + off; off += (size_t)NTOK * DM;
    float* zb = ws + off; off += (size_t)NTOK * DHY;
    float* x0b = ws + off; off += (size_t)NTOK * DHY;
    float* proj = ws + off; off += (size_t)NTOK * DIN;
    if (off * 4 > ws_size) { fprintf(stderr, "workspace too small: need %zu have %zu\n", off * 4, ws_size); return; }

    hipMemcpyAsync(xcur, x_prompt, (size_t)NCTX * DM * 4, hipMemcpyDeviceToDevice, stream);
    hipMemcpyAsync(xcur + (size_t)NCTX * DM, x_sample, (size_t)NLAT * DM * 4, hipMemcpyDeviceToDevice, stream);
    k_mod<<<dim3(3 * DM / 256, 2), 256, 0, stream>>>(c, c_ctx, w_ada, b_ada, mod);
    for (int l = 0; l < 2; ++l) {
        const float* modl = mod + (size_t)l * 3 * 3 * DM;
        k_filter<<<256, 256, 0, stream>>>(f_w1 + l * 33 * 64, f_b1 + l * 64, f_w2 + l * 64 * 64, f_b2 + l * 64, f_w3 + (size_t)l * 64 * 2048, f_freq + l * 64, filt256, 256);
        k_filter<<<1024, 256, 0, stream>>>(f_w1 + l * 33 * 64, f_b1 + l * 64, f_w2 + l * 64 * 64, f_b2 + l * 64, f_w3 + (size_t)l * 64 * 2048, f_freq + l * 64, filt1024, 1024);
        k_normmod<<<NTOK, 256, 0, stream>>>(xcur, norm_g + l * DM, modl, hmix);
        k_gemm<0><<<dim3(DIN / 64, NTOK / 64), 256, 0, stream>>>(hmix, w_in + (size_t)l * DM * DIN, proj, NTOK, DIN, DM, nullptr, nullptr);
        k_qknorm<<<dim3(NTOK, 16), 64, 0, stream>>>(proj, q_g + l * HD, k_g + l * HD, out, l);
        k_attn<<<dim3(NTOK, NH), 128, 0, stream>>>(proj, cache_k, cache_v, hmix, l);
        k_hypre<<<NTOK, 256, 0, stream>>>(proj, conv_w + (size_t)l * 3 * 3072, conv_b + l * 3072, zb, x0b);
        k_hyconv<<<NTOK, 256, 0, stream>>>(zb, x0b, filt256, filt1024, hy_bias + l * DHY, proj, hmix);
        k_gemm<1><<<dim3(DM / 64, NTOK / 64), 256, 0, stream>>>(hmix, w_out + (size_t)l * DM * DM, xcur, NTOK, DM, DM, xcur, modl);
    }
    k_finalnorm<<<NTOK, 256, 0, stream>>>(xcur, fin_g, out);
}
```

```cpp
#include <hip/hip_runtime.h>
#include <hip/hip_cooperative_groups.h>
#include <cstdio>
#include <cstdint>
namespace cg = cooperative_groups;

#define LAS __attribute__((address_space(3)))
typedef unsigned short bf16_t;
typedef short bf16x8 __attribute__((ext_vector_type(8)));
typedef float f32x4 __attribute__((ext_vector_type(4)));
typedef float f32x2 __attribute__((ext_vector_type(2)));
typedef unsigned u32x4 __attribute__((ext_vector_type(4)));
typedef unsigned u32x2 __attribute__((ext_vector_type(2)));

constexpr int DM = 2048, NCTX = 4096, NLAT = 2048, NTOK = 6144, DIN = 7168;
constexpr int CS = 256, LS = 1024, PAST = 512, KVL = LS + PAST;
constexpr int HD = 128, NKV = 4, DHY = 1024, DKV = 512;
constexpr int OFF_K = 1024, OFF_V = 1536, OFF_GA = 2048, OFF_HY = 3072, OFF_GH = 6144;
constexpr float EPS = 1e-6f;
constexpr size_t OUT_NK = (size_t)NTOK * DM, OUT_NV = OUT_NK + (size_t)16 * 2 * CS * DKV;
constexpr int NW = 8, NT = NW * 64;
constexpr int MODP = 8;

constexpr size_t al256(size_t x) { return (x + 255) / 256 * 256; }
constexpr size_t WS_WIN = 0;
constexpr size_t WS_WOUT = WS_WIN + (size_t)2 * DIN * DM * 2;
constexpr size_t WS_HM = WS_WOUT + (size_t)2 * DM * DM * 2;
constexpr size_t WS_P = WS_HM + (size_t)NTOK * DM * 2;
constexpr size_t WS_KL = WS_P + (size_t)NTOK * DIN * 2;
constexpr size_t WS_VL = WS_KL + (size_t)2 * 2 * KVL * DKV * 2;
constexpr size_t WS_XB = WS_VL + (size_t)2 * 2 * KVL * DKV * 2;
constexpr size_t WS_MODP = WS_XB + (size_t)NTOK * DM * 4;
constexpr size_t WS_MODF = WS_MODP + (size_t)2 * MODP * 3 * 3 * DM * 4;
constexpr size_t WS_T = WS_MODF + (size_t)2 * 3 * 3 * DM * 4;
constexpr size_t T_LAYER = (size_t)DHY * (512 + 2048);
constexpr size_t WS_ROPE = WS_T + 2 * T_LAYER * 2;
constexpr size_t WS_ZB = WS_ROPE + (size_t)LS * 64 * 2 * 4;
constexpr size_t WS_X0 = WS_ZB + (size_t)NTOK * DHY * 4;
constexpr size_t WS_END = WS_X0 + (size_t)NTOK * DHY * 4;

constexpr int RING_BYTES = 131072, XCH_OFF = RING_BYTES, LDS_BYTES = 147456;

struct Params {
    const float* in[23];
    float* out;
    unsigned char* ws;
};

__device__ __forceinline__ unsigned f2bf(float f) { unsigned u = __builtin_bit_cast(unsigned, f); return (u + 0x7fffu + ((u >> 16) & 1u)) >> 16; }
__device__ __forceinline__ unsigned pk2(float lo, float hi) { return f2bf(lo) | (f2bf(hi) << 16); }
__device__ __forceinline__ float bf2f(unsigned short v) { return __builtin_bit_cast(float, (unsigned)v << 16); }
__device__ __forceinline__ float bflo(unsigned v) { return __builtin_bit_cast(float, v << 16); }
__device__ __forceinline__ float bfhi(unsigned v) { return __builtin_bit_cast(float, v & 0xffff0000u); }
__device__ __forceinline__ float silu_f(float x) { return x * __builtin_amdgcn_rcpf(1.f + __expf(-x)); }
__device__ __forceinline__ unsigned cvt_pk(float lo, float hi) { unsigned r; asm volatile("v_cvt_pk_bf16_f32 %0, %1, %2" : "=v"(r) : "v"(lo), "v"(hi)); return r; }
__device__ __forceinline__ float wave_sum(float v) {
#pragma unroll
    for (int o = 1; o < 64; o <<= 1) v += __shfl_xor(v, o);
    return v;
}
__device__ __forceinline__ float wave_max(float v) {
#pragma unroll
    for (int o = 1; o < 64; o <<= 1) v = fmaxf(v, __shfl_xor(v, o));
    return v;
}
#define LDS_WAIT() asm volatile("s_waitcnt lgkmcnt(0)" ::: "memory")

namespace pg8 {
constexpr int BM = 256, BK = 64, HALF = 128, HTB = HALF * BK * 2, STAGE_BYTES = 8 * HTB, NXCD = 8, WGM = 8;
__host__ __device__ __forceinline__ int lds_byte(int r, int c) { const int st = (r >> 4) * 2 + (c >> 5), rr = r & 15, cc = c & 31, ob = rr * 64 + cc * 2; return st * 1024 + (ob ^ (((ob >> 9) & 1) << 5)); }
__host__ __device__ __forceinline__ void stage_rc(int b, int& R, int& C) { const int st = b / 1024, sb = b % 1024, swz = sb ^ (((sb >> 9) & 1) << 5); R = (st >> 1) * 16 + swz / 64; C = (st & 1) * 32 + (swz % 64) / 2; }
__host__ __device__ __forceinline__ int perm32(int rho) { const int n = rho >> 4, i = rho & 15; return 8 * (i >> 2) + 4 * n + (i & 3); }
struct Unit { int pm, pn; };
struct Gemm { const bf16_t* A; const bf16_t* Bt; int M, N, K; };
struct StaticOrder {
    int nM, nN, nwg, G, c;
    __device__ void init(int M, int N, int G_, int c_) { nM = M / BM; nN = N / BM; nwg = nM * nN; G = G_; c = c_; }
    __device__ bool next(int i, Unit& u) const {
        const long L = (long)i * G + c; if (L >= nwg) return false;
        int wgid = (int)L; { const int q = nwg / NXCD, r = nwg % NXCD, xcd = wgid % NXCD, off = wgid / NXCD; wgid = (xcd < r ? xcd * (q + 1) : r * (q + 1) + (xcd - r) * q) + off; }
        const int nig = WGM * nN, gid = wgid / nig, fm = gid * WGM, gsz = (nM - fm) < WGM ? (nM - fm) : WGM;
        u.pm = fm + ((wgid % nig) % gsz); u.pn = (wgid % nig) / gsz; return true;
    }
};
template <class Epi, class Sched>
__device__ __forceinline__ void gemm_phase(LAS unsigned char* lds, const Gemm g, const Sched& S, const Epi& E) {
    int tid = threadIdx.x; asm volatile("" : "+v"(tid));
    const int wid = __builtin_amdgcn_readfirstlane(tid >> 6), lane = tid & 63, wr = wid >> 2, wc = wid & 3, fr = lane & 15, fq = lane >> 4;
    const int K = g.K, nt = K / BK;
    unsigned voffA[2], voffB[2];
#pragma unroll
    for (int i = 0; i < 2; ++i) { int R, C; stage_rc(tid * 16 + i * 8192, R, C); const int Rb = Epi::PERM ? ((R & ~31) + perm32(R & 31)) : R;
        voffA[i] = (unsigned)(R * K + C) * 2u; voffB[i] = (unsigned)(Rb * K + C) * 2u; }
    const size_t kstep = (size_t)(BK * 2);
    const size_t hstep = (size_t)HALF * K * 2;
    const size_t tstep = 2 * hstep;
    const unsigned ldsw = (unsigned)wid * 1024u;
    const int aoff = lds_byte(wr * 64 + fr, fq * 8), boff = lds_byte(wc * 32 + fr, fq * 8);
#define PG8_SA(b, h) (((b) * 2 + (h)) * HTB)
#define PG8_SB(b, h) ((4 + (b) * 2 + (h)) * HTB)
#define PG8_STAGE(bufoff, gbase, voff) do { _Pragma("unroll") for (int _i = 0; _i < 2; ++_i) \
        __builtin_amdgcn_global_load_lds((const unsigned*)((const char*)(gbase) + (voff)[_i]), (LAS unsigned*)(lds + (bufoff) + ldsw + _i * 8192), 16, 0, 0); } while (0)
#define PG8_LDA(dst, b, h) do { _Pragma("unroll") for (int m = 0; m < 4; ++m) _Pragma("unroll") for (int k = 0; k < 2; ++k) dst[m][k] = *(const LAS bf16x8*)(lds + PG8_SA(b, h) + aoff + m * 2048 + k * 1024); } while (0)
#define PG8_LDB(dst, b, h) do { _Pragma("unroll") for (int n = 0; n < 2; ++n) _Pragma("unroll") for (int k = 0; k < 2; ++k) dst[n][k] = *(const LAS bf16x8*)(lds + PG8_SB(b, h) + boff + n * 2048 + k * 1024); } while (0)
#define PG8_MMA(ai, bj, At, Bt) do { __builtin_amdgcn_s_setprio(1); _Pragma("unroll") for (int m = 0; m < 4; ++m) _Pragma("unroll") for (int n = 0; n < 2; ++n) _Pragma("unroll") for (int k = 0; k < 2; ++k) \
        acc[ai][bj][m][n] = __builtin_amdgcn_mfma_f32_16x16x32_bf16(Bt[n][k], At[m][k], acc[ai][bj][m][n], 0, 0, 0); __builtin_amdgcn_s_setprio(0); } while (0)
#define PG8_WAIT_V(n) asm volatile("s_waitcnt vmcnt(" #n ")" ::: "memory")
#define PG8_WAIT_L(n) asm volatile("s_waitcnt lgkmcnt(" #n ")" ::: "memory")
#define PG8_BAR __builtin_amdgcn_s_barrier()
#define PG8_SCHED __builtin_amdgcn_sched_barrier(0)
    Unit cur, nxt; int ui = 0;
    if (!S.next(0, cur)) return;
    f32x4 acc[2][2][4][2];
#pragma unroll
    for (int a = 0; a < 2; ++a)
#pragma unroll
        for (int b = 0; b < 2; ++b)
#pragma unroll
            for (int m = 0; m < 4; ++m)
#pragma unroll
                for (int n = 0; n < 2; ++n) acc[a][b][m][n] = (f32x4){0.f, 0.f, 0.f, 0.f};
    bf16x8 At[4][2], B0[2][2], B1[2][2];
    const char* cA = (const char*)g.A + (size_t)cur.pm * tstep; const char* cB = (const char*)g.Bt + (size_t)cur.pn * tstep;
    PG8_STAGE(PG8_SB(0, 0), cB, voffB); PG8_STAGE(PG8_SB(0, 1), cB + hstep, voffB); PG8_STAGE(PG8_SA(0, 0), cA, voffA); PG8_STAGE(PG8_SA(0, 1), cA + hstep, voffA);
    if (wr == 1) PG8_BAR;
    PG8_WAIT_V(2); PG8_BAR;
    PG8_STAGE(PG8_SB(1, 0), cB + kstep, voffB); PG8_STAGE(PG8_SA(1, 0), cA + kstep, voffA); PG8_STAGE(PG8_SB(1, 1), cB + hstep + kstep, voffB);
    PG8_WAIT_V(6); PG8_BAR;
    for (;;) {
        const bool has_next = S.next(ui + 1, nxt);
        const char* nA = has_next ? (const char*)g.A + (size_t)nxt.pm * tstep : cA; const char* nB = has_next ? (const char*)g.Bt + (size_t)nxt.pn * tstep : cB;
        for (int t = 0; t < nt; t += 2) {
            const bool last = (t == nt - 2);
            const char* a1 = cA + (size_t)(t + 1) * kstep;
            const char* a2 = last ? nA : cA + (size_t)(t + 2) * kstep; const char* b2 = last ? nB : cB + (size_t)(t + 2) * kstep;
            const char* a3 = a2 + kstep; const char* b3 = b2 + kstep;
            PG8_LDB(B0, 0, 0); PG8_LDB(B1, 0, 1); PG8_SCHED; PG8_LDA(At, 0, 0); PG8_STAGE(PG8_SA(1, 1), a1 + hstep, voffA);
            PG8_WAIT_V(8); PG8_WAIT_L(0); PG8_BAR; PG8_MMA(0, 0, At, B0); PG8_MMA(0, 1, At, B1); PG8_BAR; PG8_SCHED;
            PG8_LDA(At, 0, 1); PG8_STAGE(PG8_SB(0, 0), b2, voffB); PG8_STAGE(PG8_SB(0, 1), b2 + hstep, voffB); PG8_STAGE(PG8_SA(0, 0), a2, voffA);
            PG8_WAIT_V(8); PG8_WAIT_L(0); PG8_BAR; PG8_MMA(1, 0, At, B0); PG8_MMA(1, 1, At, B1); PG8_BAR; PG8_SCHED;
            PG8_LDB(B0, 1, 0); PG8_LDB(B1, 1, 1); PG8_SCHED; PG8_LDA(At, 1, 0); PG8_STAGE(PG8_SA(0, 1), a2 + hstep, voffA);
            PG8_WAIT_V(8); PG8_WAIT_L(0); PG8_BAR; PG8_MMA(0, 0, At, B0); PG8_MMA(0, 1, At, B1); PG8_BAR; PG8_SCHED;
            PG8_LDA(At, 1, 1); PG8_STAGE(PG8_SB(1, 0), b3, voffB); PG8_STAGE(PG8_SB(1, 1), b3 + hstep, voffB); PG8_STAGE(PG8_SA(1, 0), a3, voffA);
            PG8_WAIT_V(8); PG8_WAIT_L(0); PG8_BAR; PG8_MMA(1, 0, At, B0); PG8_MMA(1, 1, At, B1); PG8_BAR; PG8_SCHED;
        }
        if (wr == 0) PG8_BAR;
        E(acc, cur, wr, wc, fr, fq);
        if (!has_next) break;
#pragma unroll
        for (int a = 0; a < 2; ++a)
#pragma unroll
            for (int b = 0; b < 2; ++b)
#pragma unroll
                for (int m = 0; m < 4; ++m)
#pragma unroll
                    for (int n = 0; n < 2; ++n) acc[a][b][m][n] = (f32x4){0.f, 0.f, 0.f, 0.f};
        cur = nxt; cA = nA; cB = nB; ++ui;
        if (wr == 1) PG8_BAR;
    }
    PG8_WAIT_V(0);
    PG8_BAR;
#undef PG8_SA
#undef PG8_SB
#undef PG8_STAGE
#undef PG8_LDA
#undef PG8_LDB
#undef PG8_MMA
#undef PG8_WAIT_V
#undef PG8_WAIT_L
#undef PG8_BAR
#undef PG8_SCHED
}
}

struct EpiInProj {
    static constexpr bool PERM = true;
    bf16_t* P; bf16_t* KLl; bf16_t* VLl;
    float* out; const float* qg; const float* kg; const float* rope; LAS float* xch; int layer;
    __device__ __forceinline__ void operator()(f32x4 (&acc)[2][2][4][2], const pg8::Unit& u, int wr, int wc, int fr, int fq) const {
        const int pn = u.pn, pm = u.pm;
        const bool lat = pm >= 16;
        asm volatile("" : "+v"(fr), "+v"(fq));
        const int rl0 = wr * 64 + fr, cl0 = wc * 32 + 8 * fq;
        if (pn < 6) {
#pragma unroll
            for (int ai = 0; ai < 2; ++ai)
#pragma unroll
                for (int m = 0; m < 4; ++m)
#pragma unroll
                    for (int bj = 0; bj < 2; ++bj) {
                        const f32x4 a = acc[ai][bj][m][0], b = acc[ai][bj][m][1];
                        float s = (a[0] * a[0] + a[1] * a[1]) + (a[2] * a[2] + a[3] * a[3]) + (b[0] * b[0] + b[1] * b[1]) + (b[2] * b[2] + b[3] * b[3]);
                        s += __shfl_xor(s, 16); s += __shfl_xor(s, 32);
                        if (fq == 0) xch[((ai * 128 + rl0 + m * 16) * 2 + bj) * 4 + wc] = s;
                    }
            LDS_WAIT(); __builtin_amdgcn_s_barrier(); asm volatile("" ::: "memory");
            const float* gsrc = (pn < 4) ? qg : kg;
            const f32x4 g0 = *(const f32x4*)(gsrc + cl0), g1 = *(const f32x4*)(gsrc + cl0 + 4);
#pragma unroll
            for (int ai = 0; ai < 2; ++ai)
#pragma unroll
                for (int m = 0; m < 4; ++m) {
                    const int rl = ai * 128 + rl0 + m * 16, row = pm * 256 + rl;
#pragma unroll
                    for (int bj = 0; bj < 2; ++bj) {
                        const f32x4 pp = *(const LAS f32x4*)(xch + (rl * 2 + bj) * 4);
                        const float rs = rsqrtf(((pp[0] + pp[1]) + (pp[2] + pp[3])) * (1.f / HD) + EPS);
                        f32x4 v0 = acc[ai][bj][m][0] * rs * g0, v1 = acc[ai][bj][m][1] * rs * g1;
                        if (lat) {
                            const int t = (row - NCTX) & (LS - 1);
                            const f32x4 c0 = *(const f32x4*)(rope + ((size_t)t * 64 + (cl0 >> 1)) * 2), c1 = *(const f32x4*)(rope + ((size_t)t * 64 + (cl0 >> 1) + 2) * 2);
                            f32x4 w0, w1;
                            w0[0] = v0[0] * c0[0] - v0[1] * c0[1]; w0[1] = v0[0] * c0[1] + v0[1] * c0[0]; w0[2] = v0[2] * c0[2] - v0[3] * c0[3]; w0[3] = v0[2] * c0[3] + v0[3] * c0[2];
                            w1[0] = v1[0] * c1[0] - v1[1] * c1[1]; w1[1] = v1[0] * c1[1] + v1[1] * c1[0]; w1[2] = v1[2] * c1[2] - v1[3] * c1[3]; w1[3] = v1[2] * c1[3] + v1[3] * c1[2];
                            v0 = w0; v1 = w1;
                        }
                        u32x4 w; w.x = cvt_pk(v0[0], v0[1]); w.y = cvt_pk(v0[2], v0[3]); w.z = cvt_pk(v1[0], v1[1]); w.w = cvt_pk(v1[2], v1[3]);
                        const int col = pn * 256 + bj * 128 + cl0;
                        if (pn < 4 || !lat) *(u32x4*)(P + (size_t)row * DIN + col) = w;
                        if (pn >= 4) {
                            const int kc = col - OFF_K;
                            if (!lat) { float* o = out + OUT_NK + ((size_t)(pm * 2 + layer) * CS + rl) * DKV + kc; *(f32x4*)o = v0; *(f32x4*)(o + 4) = v1; }
                            else { const int b = (pm - 16) >> 2, t = ((pm - 16) & 3) * 256 + rl; *(u32x4*)(KLl + ((size_t)b * KVL + t) * DKV + kc) = w; }
                        }
                    }
                    asm volatile("" ::: "memory");
                }
        } else {
            const bool is_v = pn < 8, act = (pn >= 8 && pn < 12) || pn >= 24;
#pragma unroll
            for (int ai = 0; ai < 2; ++ai)
#pragma unroll
                for (int m = 0; m < 4; ++m) {
                    const int rl = ai * 128 + rl0 + m * 16, row = pm * 256 + rl;
#pragma unroll
                    for (int bj = 0; bj < 2; ++bj) {
                        f32x4 v0 = acc[ai][bj][m][0], v1 = acc[ai][bj][m][1];
                        if (act) {
#pragma unroll
                            for (int e = 0; e < 4; ++e) { v0[e] = silu_f(v0[e]); v1[e] = silu_f(v1[e]); }
                        }
                        u32x4 w; w.x = cvt_pk(v0[0], v0[1]); w.y = cvt_pk(v0[2], v0[3]); w.z = cvt_pk(v1[0], v1[1]); w.w = cvt_pk(v1[2], v1[3]);
                        const int col = pn * 256 + bj * 128 + cl0;
                        if (!is_v || !lat) *(u32x4*)(P + (size_t)row * DIN + col) = w;
                        if (is_v) {
                            const int vc = col - OFF_V;
                            if (!lat) { float* o = out + OUT_NV + ((size_t)(pm * 2 + layer) * CS + rl) * DKV + vc; *(f32x4*)o = v0; *(f32x4*)(o + 4) = v1; }
                            else { const int b = (pm - 16) >> 2, t = ((pm - 16) & 3) * 256 + rl; *(u32x4*)(VLl + ((size_t)b * KVL + t) * DKV + vc) = w; }
                        }
                    }
                    asm volatile("" ::: "memory");
                }
        }
    }
};
struct EpiOutProj {
    static constexpr bool PERM = true;
    const float* xc; const float* xl; float* xo; const float* modf;
    __device__ __forceinline__ void operator()(f32x4 (&acc)[2][2][4][2], const pg8::Unit& u, int wr, int wc, int fr, int fq) const {
        const int pn = u.pn, pm = u.pm;
        const bool lat = pm >= 16;
        const int j = lat ? 1 + ((pm - 16) >> 2) : 0;
        const float* gate = modf + (size_t)j * 3 * DM + 2 * DM;
        const float* xin = lat ? xl - (size_t)NCTX * DM : xc;
        asm volatile("" : "+v"(fr), "+v"(fq));
        const int rl0 = wr * 64 + fr, cl0 = wc * 32 + 8 * fq;
#pragma unroll
        for (int bj = 0; bj < 2; ++bj) {
            const int col = pn * 256 + bj * 128 + cl0;
            const f32x4 g0 = *(const f32x4*)(gate + col), g1 = *(const f32x4*)(gate + col + 4);
#pragma unroll
            for (int ai = 0; ai < 2; ++ai)
#pragma unroll
                for (int m = 0; m < 4; ++m) {
                    const size_t off = (size_t)(pm * 256 + ai * 128 + rl0 + m * 16) * DM + col;
                    const f32x4 x0 = *(const f32x4*)(xin + off), x1 = *(const f32x4*)(xin + off + 4);
                    *(f32x4*)(xo + off) = x0 + g0 * acc[ai][bj][m][0]; *(f32x4*)(xo + off + 4) = x1 + g1 * acc[ai][bj][m][1];
                }
        }
    }
};

__device__ __forceinline__ void p0_transpose_item(const float* W, int K, int N, bf16_t* WT, LAS float* scr, int item, int lane) {
    const int nblk = N / 32, kb = item / nblk, nb = item % nblk, k0 = 64 * kb, n0 = 32 * nb;
#pragma unroll 8
    for (int i = 0; i < 32; ++i) { const int kk = 2 * i + (lane >> 5); scr[kk * 33 + (lane & 31)] = W[(size_t)(k0 + kk) * N + n0 + (lane & 31)]; }
    LDS_WAIT();
    const int c = lane & 7;
#pragma unroll
    for (int j = 0; j < 4; ++j) { const int n = (lane >> 3) + 8 * j; const LAS float* s = scr + (8 * c) * 33 + n;
        u32x4 o; o.x = pk2(s[0 * 33], s[1 * 33]); o.y = pk2(s[2 * 33], s[3 * 33]); o.z = pk2(s[4 * 33], s[5 * 33]); o.w = pk2(s[6 * 33], s[7 * 33]);
        *(u32x4*)(WT + (size_t)(n0 + n) * K + k0 + 8 * c) = o; }
    LDS_WAIT();
}

template <int DIR>
__device__ __forceinline__ void filter_item(const Params& p, int l, int L, int ci, bf16_t* T, LAS float* scr) {
    int tid = threadIdx.x; asm volatile("" : "+v"(tid));
    const float* w1 = p.in[14] + l * 33 * 64; const float* b1 = p.in[15] + l * 64; const float* w2 = p.in[16] + l * 64 * 64; const float* b2 = p.in[17] + l * 64;
    const float* w3 = p.in[18] + (size_t)l * 64 * 2048; const float* freq = p.in[19] + l * 64;
    LAS float* zf = scr;
    LAS float* h1 = scr + 32 * 33;
    LAS float* h2t = h1 + 32 * 64;
    const int tbase = DIR == 0 ? 1 + 32 * ci : 32 * ci;
    for (int idx = tid; idx < 32 * 33; idx += NT) {
        const int tt = idx / 33, f = idx % 33; const float t = (float)(tbase + tt);
        const float t_norm = t / (float)(L - 1), w = 2.0f * 3.14159265358979323846f * t / (float)L;
        float v;
        if (f == 0) v = t_norm;
        else { const int i = (f - 1) & 15; const float band = 1e-4f + (float)i * ((15.f - 1e-4f) / 15.f); v = f <= 16 ? cosf(w * band) : -sinf(w * band); }
        zf[idx] = v;
    }
    __syncthreads();
    for (int idx = tid; idx < 32 * 64; idx += NT) {
        const int tt = idx >> 6, j = idx & 63; float a = b1[j];
        for (int f = 0; f < 33; ++f) a += zf[tt * 33 + f] * w1[f * 64 + j];
        h1[idx] = sinf(freq[j] * a);
    }
    __syncthreads();
    for (int idx = tid; idx < 32 * 64; idx += NT) {
        const int tt = idx >> 6, j = idx & 63; float a = b2[j];
        for (int i = 0; i < 64; ++i) a += h1[tt * 64 + i] * w2[i * 64 + j];
        h2t[j * 32 + tt] = sinf(freq[j] * a);
    }
    __syncthreads();
    const int c = tid * 2;
    float acc0[32], acc1[32];
#pragma unroll
    for (int tt = 0; tt < 32; ++tt) { acc0[tt] = 0.f; acc1[tt] = 0.f; }
    float e0 = 0.f, e1 = 0.f;
    const bool extra = (DIR == 1 && ci == 0);
    for (int j = 0; j < 64; ++j) {
        const f32x2 wv = *(const f32x2*)(w3 + (size_t)j * 2048 + DIR * 1024 + c);
#pragma unroll
        for (int q = 0; q < 8; ++q) {
            const f32x4 hv = *(const LAS f32x4*)(h2t + j * 32 + q * 4);
#pragma unroll
            for (int e = 0; e < 4; ++e) { acc0[q * 4 + e] += hv[e] * wv[0]; acc1[q * 4 + e] += hv[e] * wv[1]; }
        }
        if (extra) { const f32x2 wf = *(const f32x2*)(w3 + (size_t)j * 2048 + c); const float h0 = h2t[j * 32]; e0 += h0 * wf[0]; e1 += h0 * wf[1]; }
    }
    const float max_decay = logf(1e-2f) / 0.3f, min_decay = logf(1e-2f) / 1.5f;
    const float d0 = fabsf(min_decay + (float)c * ((max_decay - min_decay) / 1023.f)), d1 = fabsf(min_decay + (float)(c + 1) * ((max_decay - min_decay) / 1023.f));
#pragma unroll
    for (int tt = 0; tt < 32; ++tt) {
        const int t = tbase + tt; const float t_norm = (float)t / (float)(L - 1);
        float v0 = acc0[tt] * (__expf(-t_norm * d0) + 0.05f), v1 = acc1[tt] * (__expf(-t_norm * d1) + 0.05f);
        if (DIR == 0 && t >= L) { v0 = 0.f; v1 = 0.f; }
        if (extra && tt == 0) { v0 += e0 * 1.05f; v1 += e1 * 1.05f; }
        acc0[tt] = v0; acc1[tt] = v1;
    }
    const int n0 = DIR == 0 ? L - 32 - 32 * ci : L + 32 * ci;
    bf16_t* r0 = T + (size_t)c * (2 * L) + n0; bf16_t* r1 = r0 + 2 * L;
#pragma unroll
    for (int q = 0; q < 4; ++q) {
        u32x4 a, b;
        if (DIR == 0) {
            a.x = pk2(acc0[31 - (8 * q + 0)], acc0[31 - (8 * q + 1)]); a.y = pk2(acc0[31 - (8 * q + 2)], acc0[31 - (8 * q + 3)]); a.z = pk2(acc0[31 - (8 * q + 4)], acc0[31 - (8 * q + 5)]); a.w = pk2(acc0[31 - (8 * q + 6)], acc0[31 - (8 * q + 7)]);
            b.x = pk2(acc1[31 - (8 * q + 0)], acc1[31 - (8 * q + 1)]); b.y = pk2(acc1[31 - (8 * q + 2)], acc1[31 - (8 * q + 3)]); b.z = pk2(acc1[31 - (8 * q + 4)], acc1[31 - (8 * q + 5)]); b.w = pk2(acc1[31 - (8 * q + 6)], acc1[31 - (8 * q + 7)]);
        } else {
            a.x = pk2(acc0[8 * q + 0], acc0[8 * q + 1]); a.y = pk2(acc0[8 * q + 2], acc0[8 * q + 3]); a.z = pk2(acc0[8 * q + 4], acc0[8 * q + 5]); a.w = pk2(acc0[8 * q + 6], acc0[8 * q + 7]);
            b.x = pk2(acc1[8 * q + 0], acc1[8 * q + 1]); b.y = pk2(acc1[8 * q + 2], acc1[8 * q + 3]); b.z = pk2(acc1[8 * q + 4], acc1[8 * q + 5]); b.w = pk2(acc1[8 * q + 6], acc1[8 * q + 7]);
        }
        *(u32x4*)(r0 + 8 * q) = a; *(u32x4*)(r1 + 8 * q) = b;
    }
    __syncthreads();
}

__global__ void __launch_bounds__(NT, 2) fwd_megakernel(Params p) {
    extern __shared__ __attribute__((aligned(16))) unsigned char lds_raw[];
    cg::grid_group grid = cg::this_grid();
    LAS unsigned char* lds = (LAS unsigned char*)lds_raw;
    const int wave = __builtin_amdgcn_readfirstlane(threadIdx.x >> 6);
    const int G = gridDim.x, bx = blockIdx.x, vcu = (G % 8 == 0) ? (bx % 8) * (G / 8) + bx / 8 : bx;
    const int gw = wave * G + vcu, NGW = G * NW;
#define PHASE_IDS() int tid = threadIdx.x; asm volatile("" : "+v"(tid)); const int lane = tid & 63; (void)lane
    unsigned char* ws = p.ws;
    bf16_t* WinT = (bf16_t*)(ws + WS_WIN); bf16_t* WoutT = (bf16_t*)(ws + WS_WOUT); bf16_t* HM = (bf16_t*)(ws + WS_HM); bf16_t* P = (bf16_t*)(ws + WS_P);
    bf16_t* KL = (bf16_t*)(ws + WS_KL); bf16_t* VL = (bf16_t*)(ws + WS_VL); float* XB = (float*)(ws + WS_XB);
    float* modp = (float*)(ws + WS_MODP); float* modf = (float*)(ws + WS_MODF); bf16_t* Tt = (bf16_t*)(ws + WS_T); float* rope = (float*)(ws + WS_ROPE);
    float* zb = (float*)(ws + WS_ZB); float* x0b = (float*)(ws + WS_X0);
    const float* x_prompt = p.in[0]; const float* x_sample = p.in[1];

    {
        PHASE_IDS();
        LAS float* scr = (LAS float*)(lds + wave * 8448);
        LAS float* sc = (LAS float*)(lds + 8 * 8448);
        LAS float* fscr = (LAS float*)(lds + 8 * 8448 + 3 * DM * 4);
        for (int i = tid; i < DM; i += NT) { sc[i] = silu_f(p.in[5][i]); sc[DM + i] = silu_f(p.in[4][i]); sc[2 * DM + i] = silu_f(p.in[4][DM + i]); }
        __syncthreads();
        for (int fi = vcu; fi < 160; fi += G) {
            const int l = fi / 80; int r = fi % 80; int L, dir, ci; bf16_t* T = Tt + (size_t)l * T_LAYER;
            if (r < 16) { L = 256; dir = r / 8; ci = r % 8; } else { r -= 16; L = 1024; dir = r / 32; ci = r % 32; T += (size_t)DHY * 512; }
            if (dir == 0) filter_item<0>(p, l, L, ci, T, fscr); else filter_item<1>(p, l, L, ci, T, fscr);
        }
        constexpr int I_GEMV = 2 * 24 * MODP;
        constexpr int I_WIN = (DM / 64) * (DIN / 32), I_WOUT = (DM / 64) * (DM / 32);
        constexpr int I_CACHE = 2 * 2 * 2 * PAST, I_ROPE = LS;
        constexpr int I_TOTAL = I_GEMV + 2 * I_WIN + 2 * I_WOUT + I_CACHE + I_ROPE;
        for (int it = gw; it < I_TOTAL; it += NGW) {
            int r = it;
            if (r < I_GEMV) {
                const int kc = r % MODP, nc = (r / MODP) % 24, l = r / (MODP * 24);
                const float* w = p.in[7] + ((size_t)l * DM + kc * 256) * (3 * DM) + nc * 256 + lane * 4;
                f32x4 a0 = {0.f, 0.f, 0.f, 0.f}, a1 = a0, a2 = a0;
#pragma unroll 8
                for (int k = 0; k < 256; ++k) {
                    const f32x4 wv = *(const f32x4*)(w + (size_t)k * (3 * DM));
                    const int kk = kc * 256 + k;
                    a0 += wv * sc[kk]; a1 += wv * sc[DM + kk]; a2 += wv * sc[2 * DM + kk];
                }
                float* o = modp + ((size_t)(l * MODP + kc) * 3) * (3 * DM) + nc * 256 + lane * 4;
                *(f32x4*)o = a0; *(f32x4*)(o + 3 * DM) = a1; *(f32x4*)(o + 2 * 3 * DM) = a2;
                continue;
            }
            r -= I_GEMV;
            if (r < 2 * I_WIN) { const int l = r / I_WIN; p0_transpose_item(p.in[9] + (size_t)l * DM * DIN, DM, DIN, WinT + (size_t)l * DIN * DM, scr, r % I_WIN, lane); continue; }
            r -= 2 * I_WIN;
            if (r < 2 * I_WOUT) { const int l = r / I_WOUT; p0_transpose_item(p.in[21] + (size_t)l * DM * DM, DM, DM, WoutT + (size_t)l * DM * DM, scr, r % I_WOUT, lane); continue; }
            r -= 2 * I_WOUT;
            if (r < I_CACHE) {
                const int s = r % PAST, l = (r / PAST) & 1, b = (r / (2 * PAST)) & 1, which = r / (4 * PAST);
                const float* src = p.in[2 + which] + (((size_t)b * 2 + l) * PAST + s) * DKV + lane * 8;
                const f32x4 v0 = *(const f32x4*)src, v1 = *(const f32x4*)(src + 4);
                u32x4 w; w.x = pk2(v0[0], v0[1]); w.y = pk2(v0[2], v0[3]); w.z = pk2(v1[0], v1[1]); w.w = pk2(v1[2], v1[3]);
                bf16_t* dst = (which ? VL : KL) + (((size_t)l * 2 + b) * KVL + LS + s) * DKV + lane * 8;
                *(u32x4*)dst = w;
                continue;
            }
            r -= I_CACHE;
            {
                const int t = r; const float rowp = (float)(t / 64), colp = (float)(t % 64);
                const float invf = powf(10000.f, -(float)(lane & 31) / 32.f);
                const float ang = (lane < 32 ? rowp : colp) * invf;
                *(f32x2*)(rope + ((size_t)t * 64 + lane) * 2) = (f32x2){cosf(ang), sinf(ang)};
            }
        }
    }
    grid.sync();

    for (int layer = 0; layer < 2; ++layer) {
        {
            PHASE_IDS();
            LAS float* mt = (LAS float*)lds;
            if (layer == 0) {
                for (int idx = tid; idx < 3 * 2 * DM; idx += NT) {
                    const int j = idx / (2 * DM), n = idx % (2 * DM); float s = p.in[8][n];
#pragma unroll
                    for (int q = 0; q < MODP; ++q) s += modp[((size_t)q * 3 + j) * (3 * DM) + n];
                    mt[idx] = s;
                }
                if (tid < 144) {
                    const int idx = vcu * 144 + tid;
                    if (idx < 2 * 3 * 3 * DM) {
                        const int n = idx % (3 * DM), j = (idx / (3 * DM)) % 3, l = idx / (9 * DM); float s = p.in[8][l * 3 * DM + n];
#pragma unroll
                        for (int q = 0; q < MODP; ++q) s += modp[((size_t)(l * MODP + q) * 3 + j) * (3 * DM) + n];
                        modf[idx] = s;
                    }
                }
            } else {
                for (int idx = tid; idx < 3 * 2 * DM; idx += NT) { const int j = idx / (2 * DM), n = idx % (2 * DM); mt[idx] = modf[((size_t)layer * 3 + j) * (3 * DM) + n]; }
            }
            __syncthreads();
            const float* ng = p.in[6] + layer * DM;
            for (int row = gw; row < NTOK; row += NGW) {
                const float* xr = layer == 0 ? (row < NCTX ? x_prompt + (size_t)row * DM : x_sample + (size_t)(row - NCTX) * DM) : XB + (size_t)row * DM;
                const int j = row < NCTX ? 0 : 1 + (row - NCTX) / LS;
                f32x4 v[8]; float ss = 0.f;
#pragma unroll
                for (int i = 0; i < 8; ++i) { v[i] = *(const f32x4*)(xr + 4 * lane + 256 * i); ss += (v[i][0] * v[i][0] + v[i][1] * v[i][1]) + (v[i][2] * v[i][2] + v[i][3] * v[i][3]); }
                ss = wave_sum(ss);
                const float rs = rsqrtf(ss * (1.f / DM) + EPS);
#pragma unroll
                for (int i = 0; i < 8; ++i) {
                    const int col = 4 * lane + 256 * i;
                    const f32x4 gg = *(const f32x4*)(ng + col);
                    const f32x4 sh = *(const LAS f32x4*)(mt + j * 2 * DM + col), scl = *(const LAS f32x4*)(mt + j * 2 * DM + DM + col);
                    const f32x4 h = v[i] * rs * gg * (scl + 1.f) + sh;
                    u32x2 w; w.x = pk2(h[0], h[1]); w.y = pk2(h[2], h[3]);
                    *(u32x2*)(HM + (size_t)row * DM + col) = w;
                }
            }
        }
        grid.sync();

        {
            pg8::Gemm g{HM, WinT + (size_t)layer * DIN * DM, NTOK, DIN, DM};
            pg8::StaticOrder S; S.init(NTOK, DIN, G, bx);
            EpiInProj E{P, KL + (size_t)layer * 2 * KVL * DKV, VL + (size_t)layer * 2 * KVL * DKV, p.out, p.in[10] + layer * HD, p.in[11] + layer * HD, rope, (LAS float*)(lds + XCH_OFF), layer};
            pg8::gemm_phase<EpiInProj, pg8::StaticOrder>(lds, g, S, E);
        }
        grid.sync();

        {
            PHASE_IDS();
            LAS float* scw = (LAS float*)(lds + wave * 6656);
            LAS float* qf = scw + 1536;
            const bf16_t* KLl = KL + (size_t)layer * 2 * KVL * DKV; const bf16_t* VLl = VL + (size_t)layer * 2 * KVL * DKV;
            for (int item = gw; item < NTOK * 8; item += NGW) {
                const int tok = item >> 3, h = item & 7, kv = h >> 1;
                const bool ctx = tok < NCTX;
                const int nk = ctx ? CS : KVL;
                const bf16_t* Kb; const bf16_t* Vb; size_t pitch;
                if (ctx) { const int tok0 = tok & ~(CS - 1); Kb = P + (size_t)tok0 * DIN + OFF_K + kv * HD; Vb = P + (size_t)tok0 * DIN + OFF_V + kv * HD; pitch = DIN; }
                else { const int b = (tok - NCTX) / LS; Kb = KLl + (size_t)b * KVL * DKV + kv * HD; Vb = VLl + (size_t)b * KVL * DKV + kv * HD; pitch = DKV; }
                { const unsigned qq = *(const unsigned*)(P + (size_t)tok * DIN + h * HD + 2 * lane); qf[2 * lane] = bflo(qq); qf[2 * lane + 1] = bfhi(qq); }
                LDS_WAIT();
                float mx = -1e30f;
                for (int s = lane; s < nk; s += 64) {
                    const bf16_t* kr = Kb + (size_t)s * pitch; float d = 0.f;
#pragma unroll 4
                    for (int c8 = 0; c8 < 16; ++c8) {
                        const u32x4 kk = *(const u32x4*)(kr + c8 * 8);
                        const f32x4 qa = *(const LAS f32x4*)(qf + c8 * 8), qb = *(const LAS f32x4*)(qf + c8 * 8 + 4);
                        d += bflo(kk.x) * qa[0] + bfhi(kk.x) * qa[1] + bflo(kk.y) * qa[2] + bfhi(kk.y) * qa[3] + bflo(kk.z) * qb[0] + bfhi(kk.z) * qb[1] + bflo(kk.w) * qb[2] + bfhi(kk.w) * qb[3];
                    }
                    d *= 0.08838834764831845f; scw[s] = d; mx = fmaxf(mx, d);
                }
                mx = wave_max(mx);
                float lsum = 0.f;
                for (int s = lane; s < nk; s += 64) { const float e = __expf(scw[s] - mx); scw[s] = e; lsum += e; }
                lsum = wave_sum(lsum);
                LDS_WAIT();
                float o0 = 0.f, o1 = 0.f;
                for (int s = 0; s < nk; ++s) { const unsigned vv = *(const unsigned*)(Vb + (size_t)s * pitch + 2 * lane); const float pw = scw[s]; o0 += pw * bflo(vv); o1 += pw * bfhi(vv); }
                const float inv = 1.f / lsum;
                const unsigned ga = *(const unsigned*)(P + (size_t)tok * DIN + OFF_GA + h * HD + 2 * lane);
                *(unsigned*)(HM + (size_t)tok * DM + h * HD + 2 * lane) = pk2(o0 * inv * bflo(ga), o1 * inv * bfhi(ga));
                LDS_WAIT();
            }
            const float* cw = p.in[12] + (size_t)layer * 3 * 3072; const float* cb = p.in[13] + layer * 3072;
            for (int tok = vcu; tok < NTOK; tok += G) {
                const bool ctx = tok < NCTX;
                const int t = ctx ? tok % CS : (tok - NCTX) % LS, L = ctx ? CS : LS;
                const bf16_t* r0 = P + (size_t)tok * DIN + OFF_HY;
                for (int c = tid; c < DHY; c += NT) {
                    float u[3];
#pragma unroll
                    for (int part = 0; part < 3; ++part) {
                        const int ch = part * DHY + c;
                        float a = cb[ch] + cw[3072 + ch] * bf2f(r0[ch]);
                        if (t > 0) a += cw[ch] * bf2f(r0[ch - DIN]);
                        if (t < L - 1) a += cw[2 * 3072 + ch] * bf2f(r0[ch + DIN]);
                        u[part] = a;
                    }
                    zb[(size_t)tok * DHY + c] = u[2] * u[1]; x0b[(size_t)tok * DHY + c] = u[0];
                }
            }
        }
        grid.sync();
        {
            PHASE_IDS();
            const float* hb = p.in[20] + layer * DHY;
            const bf16_t* T256 = Tt + (size_t)layer * T_LAYER; const bf16_t* T1024 = T256 + (size_t)DHY * 512;
            constexpr int I_CTX = 16 * DHY * 4, I_LAT = 2 * DHY * 16;
            for (int item = gw; item < I_CTX + I_LAT; item += NGW) {
                int L, tok0, c, t; const bf16_t* T;
                if (item < I_CTX) { const int ch = item & 3, cc = (item >> 2) & 1023, b = item >> 12; L = CS; tok0 = b * CS; c = cc; t = ch * 64 + lane; T = T256 + (size_t)c * 512; }
                else { const int r = item - I_CTX; const int ch = r & 15, cc = (r >> 4) & 1023, b = r >> 14; L = LS; tok0 = NCTX + b * LS; c = cc; t = ch * 64 + lane; T = T1024 + (size_t)c * 2048; }
                const bf16_t* Tp = T + (L - t);
                float y = 0.f;
                for (int s = 0; s < L; ++s) y += bf2f(Tp[s]) * zb[(size_t)(tok0 + s) * DHY + c];
                const int tok = tok0 + t;
                y += hb[c] * zb[(size_t)tok * DHY + c];
                const float gh = bf2f(P[(size_t)tok * DIN + OFF_GH + c]);
                HM[(size_t)tok * DM + DHY + c] = (bf16_t)f2bf(x0b[(size_t)tok * DHY + c] * y * gh);
            }
        }
        grid.sync();

        {
            pg8::Gemm g{HM, WoutT + (size_t)layer * DM * DM, NTOK, DM, DM};
            pg8::StaticOrder S; S.init(NTOK, DM, G, bx);
            EpiOutProj E{layer == 0 ? x_prompt : XB, layer == 0 ? x_sample : XB + (size_t)NCTX * DM, XB, modf + (size_t)layer * 3 * 3 * DM};
            pg8::gemm_phase<EpiOutProj, pg8::StaticOrder>(lds, g, S, E);
        }
        grid.sync();
    }

    {
        PHASE_IDS();
        const float* fg = p.in[22];
        for (int row = gw; row < NTOK; row += NGW) {
            const float* xr = XB + (size_t)row * DM;
            f32x4 v[8]; float ss = 0.f;
#pragma unroll
            for (int i = 0; i < 8; ++i) { v[i] = *(const f32x4*)(xr + 4 * lane + 256 * i); ss += (v[i][0] * v[i][0] + v[i][1] * v[i][1]) + (v[i][2] * v[i][2] + v[i][3] * v[i][3]); }
            ss = wave_sum(ss);
            const float rs = rsqrtf(ss * (1.f / DM) + EPS);
#pragma unroll
            for (int i = 0; i < 8; ++i) { const int col = 4 * lane + 256 * i; *(f32x4*)(p.out + (size_t)row * DM + col) = v[i] * rs * *(const f32x4*)(fg + col); }
        }
    }
}

extern "C" void kernel_launch(void* const* d_in, const int* in_sizes, int n_in, void* d_out, int out_size, void* d_ws, size_t ws_size, hipStream_t stream) {
    static int grid = 0;
    if (grid == 0) {
        if (n_in != 23 || ws_size < WS_END) { fprintf(stderr, "kernel_launch: n_in %d ws %zu (need %zu)\n", n_in, ws_size, (size_t)WS_END); grid = -1; return; }
        int dev = 0, cus = 0, per_cu = 0;
        if (hipGetDevice(&dev) != hipSuccess || hipDeviceGetAttribute(&cus, hipDeviceAttributeMultiprocessorCount, dev) != hipSuccess) { grid = -1; return; }
        if (hipFuncSetAttribute((const void*)fwd_megakernel, hipFuncAttributeMaxDynamicSharedMemorySize, LDS_BYTES) != hipSuccess) { fprintf(stderr, "kernel_launch: hipFuncSetAttribute failed\n"); grid = -1; return; }
        if (hipOccupancyMaxActiveBlocksPerMultiprocessor(&per_cu, (const void*)fwd_megakernel, NT, LDS_BYTES) != hipSuccess || per_cu < 1) { fprintf(stderr, "kernel_launch: occupancy query says %d\n", per_cu); grid = -1; return; }
        grid = cus;
    }
    if (grid < 0) return;
    Params prm{};
    for (int i = 0; i < 23; ++i) prm.in[i] = (const float*)d_in[i];
    prm.out = (float*)d_out; prm.ws = (unsigned char*)d_ws;
    void* args[] = {&prm};
    hipError_t e = hipLaunchCooperativeKernel((const void*)fwd_megakernel, dim3(grid), dim3(NT), args, LDS_BYTES, stream);
    if (e != hipSuccess) fprintf(stderr, "cooperative launch failed: %s (grid %d)\n", hipGetErrorString(e), grid);
}
```

```cpp
#include <hip/hip_runtime.h>
#include <hip/hip_cooperative_groups.h>
#include <cstdio>
#include <cstdint>
namespace cg = cooperative_groups;

#define LAS __attribute__((address_space(3)))
typedef unsigned short bf16_t;
typedef short bf16x8 __attribute__((ext_vector_type(8)));
typedef float f32x4 __attribute__((ext_vector_type(4)));
typedef float f32x2 __attribute__((ext_vector_type(2)));
typedef unsigned u32x4 __attribute__((ext_vector_type(4)));
typedef unsigned u32x2 __attribute__((ext_vector_type(2)));

constexpr int DM = 2048, NCTX = 4096, NLAT = 2048, NTOK = 6144, DIN = 7168;
constexpr int CS = 256, LS = 1024, PAST = 512, KVL = LS + PAST;
constexpr int HD = 128, NKV = 4, DHY = 1024, DKV = 512;
constexpr int OFF_K = 1024, OFF_V = 1536, OFF_GA = 2048, OFF_HY = 3072, OFF_GH = 6144;
constexpr float EPS = 1e-6f;
constexpr size_t OUT_NK = (size_t)NTOK * DM, OUT_NV = OUT_NK + (size_t)16 * 2 * CS * DKV;
constexpr int NW = 8, NT = NW * 64;
constexpr int MODP = 8;

constexpr size_t al256(size_t x) { return (x + 255) / 256 * 256; }
constexpr size_t WS_WIN = 0;
constexpr size_t WS_WOUT = WS_WIN + (size_t)2 * DIN * DM * 2;
constexpr size_t WS_HM = WS_WOUT + (size_t)2 * DM * DM * 2;
constexpr size_t WS_P = WS_HM + (size_t)NTOK * DM * 2;
constexpr size_t WS_KL = WS_P + (size_t)NTOK * DIN * 2;
constexpr size_t WS_VL = WS_KL + (size_t)2 * 2 * KVL * DKV * 2;
constexpr size_t WS_XB = WS_VL + (size_t)2 * 2 * KVL * DKV * 2;
constexpr size_t WS_MODP = WS_XB + (size_t)NTOK * DM * 4;
constexpr size_t WS_MODF = WS_MODP + (size_t)2 * MODP * 3 * 3 * DM * 4;
constexpr size_t WS_T = WS_MODF + (size_t)2 * 3 * 3 * DM * 4;
constexpr size_t T_LAYER = (size_t)DHY * (512 + 2048);
constexpr size_t WS_ROPE = WS_T + 2 * T_LAYER * 2;
constexpr size_t WS_END = WS_ROPE + (size_t)LS * 64 * 2 * 4;

constexpr int RING_BYTES = 131072, XCH_OFF = RING_BYTES, LDS_BYTES = 147456;

struct Params {
    const float* in[23];
    float* out;
    unsigned char* ws;
};

__device__ __forceinline__ unsigned f2bf(float f) { unsigned u = __builtin_bit_cast(unsigned, f); return (u + 0x7fffu + ((u >> 16) & 1u)) >> 16; }
__device__ __forceinline__ unsigned pk2(float lo, float hi) { return f2bf(lo) | (f2bf(hi) << 16); }
__device__ __forceinline__ float bf2f(unsigned short v) { return __builtin_bit_cast(float, (unsigned)v << 16); }
__device__ __forceinline__ float bflo(unsigned v) { return __builtin_bit_cast(float, v << 16); }
__device__ __forceinline__ float bfhi(unsigned v) { return __builtin_bit_cast(float, v & 0xffff0000u); }
__device__ __forceinline__ float silu_f(float x) { return x * __builtin_amdgcn_rcpf(1.f + __expf(-x)); }
__device__ __forceinline__ unsigned cvt_pk(float lo, float hi) { unsigned r; asm volatile("v_cvt_pk_bf16_f32 %0, %1, %2" : "=v"(r) : "v"(lo), "v"(hi)); return r; }
__device__ __forceinline__ float wave_sum(float v) {
#pragma unroll
    for (int o = 1; o < 64; o <<= 1) v += __shfl_xor(v, o);
    return v;
}
__device__ __forceinline__ float wave_max(float v) {
#pragma unroll
    for (int o = 1; o < 64; o <<= 1) v = fmaxf(v, __shfl_xor(v, o));
    return v;
}
#define LDS_WAIT() asm volatile("s_waitcnt lgkmcnt(0)" ::: "memory")

namespace pg8 {
constexpr int BM = 256, BK = 64, HALF = 128, HTB = HALF * BK * 2, STAGE_BYTES = 8 * HTB, NXCD = 8, WGM = 8;
__host__ __device__ __forceinline__ int lds_byte(int r, int c) { const int st = (r >> 4) * 2 + (c >> 5), rr = r & 15, cc = c & 31, ob = rr * 64 + cc * 2; return st * 1024 + (ob ^ (((ob >> 9) & 1) << 5)); }
__host__ __device__ __forceinline__ void stage_rc(int b, int& R, int& C) { const int st = b / 1024, sb = b % 1024, swz = sb ^ (((sb >> 9) & 1) << 5); R = (st >> 1) * 16 + swz / 64; C = (st & 1) * 32 + (swz % 64) / 2; }
__host__ __device__ __forceinline__ int perm32(int rho) { const int n = rho >> 4, i = rho & 15; return 8 * (i >> 2) + 4 * n + (i & 3); }
struct Unit { int pm, pn; };
struct Gemm { const bf16_t* A; const bf16_t* Bt; int M, N, K; };
struct StaticOrder {
    int nM, nN, nwg, G, c;
    __device__ void init(int M, int N, int G_, int c_) { nM = M / BM; nN = N / BM; nwg = nM * nN; G = G_; c = c_; }
    __device__ bool next(int i, Unit& u) const {
        const long L = (long)i * G + c; if (L >= nwg) return false;
        int wgid = (int)L; { const int q = nwg / NXCD, r = nwg % NXCD, xcd = wgid % NXCD, off = wgid / NXCD; wgid = (xcd < r ? xcd * (q + 1) : r * (q + 1) + (xcd - r) * q) + off; }
        const int nig = WGM * nN, gid = wgid / nig, fm = gid * WGM, gsz = (nM - fm) < WGM ? (nM - fm) : WGM;
        u.pm = fm + ((wgid % nig) % gsz); u.pn = (wgid % nig) / gsz; return true;
    }
};
template <class Epi, class Sched>
__device__ __forceinline__ void gemm_phase(LAS unsigned char* lds, const Gemm g, const Sched& S, const Epi& E) {
    int tid = threadIdx.x; asm volatile("" : "+v"(tid));
    const int wid = __builtin_amdgcn_readfirstlane(tid >> 6), lane = tid & 63, wr = wid >> 2, wc = wid & 3, fr = lane & 15, fq = lane >> 4;
    const int K = g.K, nt = K / BK;
    unsigned voffA[2], voffB[2];
#pragma unroll
    for (int i = 0; i < 2; ++i) { int R, C; stage_rc(tid * 16 + i * 8192, R, C); const int Rb = Epi::PERM ? ((R & ~31) + perm32(R & 31)) : R;
        voffA[i] = (unsigned)(R * K + C) * 2u; voffB[i] = (unsigned)(Rb * K + C) * 2u; }
    const size_t kstep = (size_t)(BK * 2);
    const size_t hstep = (size_t)HALF * K * 2;
    const size_t tstep = 2 * hstep;
    const unsigned ldsw = (unsigned)wid * 1024u;
    const int aoff = lds_byte(wr * 64 + fr, fq * 8), boff = lds_byte(wc * 32 + fr, fq * 8);
#define PG8_SA(b, h) (((b) * 2 + (h)) * HTB)
#define PG8_SB(b, h) ((4 + (b) * 2 + (h)) * HTB)
#define PG8_STAGE(bufoff, gbase, voff) do { _Pragma("unroll") for (int _i = 0; _i < 2; ++_i) \
        __builtin_amdgcn_global_load_lds((const unsigned*)((const char*)(gbase) + (voff)[_i]), (LAS unsigned*)(lds + (bufoff) + ldsw + _i * 8192), 16, 0, 0); } while (0)
#define PG8_LDA(dst, b, h) do { _Pragma("unroll") for (int m = 0; m < 4; ++m) _Pragma("unroll") for (int k = 0; k < 2; ++k) dst[m][k] = *(const LAS bf16x8*)(lds + PG8_SA(b, h) + aoff + m * 2048 + k * 1024); } while (0)
#define PG8_LDB(dst, b, h) do { _Pragma("unroll") for (int n = 0; n < 2; ++n) _Pragma("unroll") for (int k = 0; k < 2; ++k) dst[n][k] = *(const LAS bf16x8*)(lds + PG8_SB(b, h) + boff + n * 2048 + k * 1024); } while (0)
#define PG8_MMA(ai, bj, At, Bt) do { __builtin_amdgcn_s_setprio(1); _Pragma("unroll") for (int m = 0; m < 4; ++m) _Pragma("unroll") for (int n = 0; n < 2; ++n) _Pragma("unroll") for (int k = 0; k < 2; ++k) \
        acc[ai][bj][m][n] = __builtin_amdgcn_mfma_f32_16x16x32_bf16(Bt[n][k], At[m][k], acc[ai][bj][m][n], 0, 0, 0); __builtin_amdgcn_s_setprio(0); } while (0)
#define PG8_WAIT_V(n) asm volatile("s_waitcnt vmcnt(" #n ")" ::: "memory")
#define PG8_WAIT_L(n) asm volatile("s_waitcnt lgkmcnt(" #n ")" ::: "memory")
#define PG8_BAR __builtin_amdgcn_s_barrier()
#define PG8_SCHED __builtin_amdgcn_sched_barrier(0)
    Unit cur, nxt; int ui = 0;
    if (!S.next(0, cur)) return;
    f32x4 acc[2][2][4][2];
#pragma unroll
    for (int a = 0; a < 2; ++a)
#pragma unroll
        for (int b = 0; b < 2; ++b)
#pragma unroll
            for (int m = 0; m < 4; ++m)
#pragma unroll
                for (int n = 0; n < 2; ++n) acc[a][b][m][n] = (f32x4){0.f, 0.f, 0.f, 0.f};
    bf16x8 At[4][2], B0[2][2], B1[2][2];
    const char* cA = (const char*)g.A + (size_t)cur.pm * tstep; const char* cB = (const char*)g.Bt + (size_t)cur.pn * tstep;
    PG8_STAGE(PG8_SB(0, 0), cB, voffB); PG8_STAGE(PG8_SB(0, 1), cB + hstep, voffB); PG8_STAGE(PG8_SA(0, 0), cA, voffA); PG8_STAGE(PG8_SA(0, 1), cA + hstep, voffA);
    if (wr == 1) PG8_BAR;
    PG8_WAIT_V(2); PG8_BAR;
    PG8_STAGE(PG8_SB(1, 0), cB + kstep, voffB); PG8_STAGE(PG8_SA(1, 0), cA + kstep, voffA); PG8_STAGE(PG8_SB(1, 1), cB + hstep + kstep, voffB);
    PG8_WAIT_V(6); PG8_BAR;
    for (;;) {
        const bool has_next = S.next(ui + 1, nxt);
        const char* nA = has_next ? (const char*)g.A + (size_t)nxt.pm * tstep : cA; const char* nB = has_next ? (const char*)g.Bt + (size_t)nxt.pn * tstep : cB;
        for (int t = 0; t < nt; t += 2) {
            const bool last = (t == nt - 2);
            const char* a1 = cA + (size_t)(t + 1) * kstep;
            const char* a2 = last ? nA : cA + (size_t)(t + 2) * kstep; const char* b2 = last ? nB : cB + (size_t)(t + 2) * kstep;
            const char* a3 = a2 + kstep; const char* b3 = b2 + kstep;
            PG8_LDB(B0, 0, 0); PG8_LDB(B1, 0, 1); PG8_SCHED; PG8_LDA(At, 0, 0); PG8_STAGE(PG8_SA(1, 1), a1 + hstep, voffA);
            PG8_WAIT_V(8); PG8_WAIT_L(0); PG8_BAR; PG8_MMA(0, 0, At, B0); PG8_MMA(0, 1, At, B1); PG8_BAR; PG8_SCHED;
            PG8_LDA(At, 0, 1); PG8_STAGE(PG8_SB(0, 0), b2, voffB); PG8_STAGE(PG8_SB(0, 1), b2 + hstep, voffB); PG8_STAGE(PG8_SA(0, 0), a2, voffA);
            PG8_WAIT_V(8); PG8_WAIT_L(0); PG8_BAR; PG8_MMA(1, 0, At, B0); PG8_MMA(1, 1, At, B1); PG8_BAR; PG8_SCHED;
            PG8_LDB(B0, 1, 0); PG8_LDB(B1, 1, 1); PG8_SCHED; PG8_LDA(At, 1, 0); PG8_STAGE(PG8_SA(0, 1), a2 + hstep, voffA);
            PG8_WAIT_V(8); PG8_WAIT_L(0); PG8_BAR; PG8_MMA(0, 0, At, B0); PG8_MMA(0, 1, At, B1); PG8_BAR; PG8_SCHED;
            PG8_LDA(At, 1, 1); PG8_STAGE(PG8_SB(1, 0), b3, voffB); PG8_STAGE(PG8_SB(1, 1), b3 + hstep, voffB); PG8_STAGE(PG8_SA(1, 0), a3, voffA);
            PG8_WAIT_V(8); PG8_WAIT_L(0); PG8_BAR; PG8_MMA(1, 0, At, B0); PG8_MMA(1, 1, At, B1); PG8_BAR; PG8_SCHED;
        }
        if (wr == 0) PG8_BAR;
        E(acc, cur, wr, wc, fr, fq);
        if (!has_next) break;
#pragma unroll
        for (int a = 0; a < 2; ++a)
#pragma unroll
            for (int b = 0; b < 2; ++b)
#pragma unroll
                for (int m = 0; m < 4; ++m)
#pragma unroll
                    for (int n = 0; n < 2; ++n) acc[a][b][m][n] = (f32x4){0.f, 0.f, 0.f, 0.f};
        cur = nxt; cA = nA; cB = nB; ++ui;
        if (wr == 1) PG8_BAR;
    }
    PG8_WAIT_V(0);
    PG8_BAR;
#undef PG8_SA
#undef PG8_SB
#undef PG8_STAGE
#undef PG8_LDA
#undef PG8_LDB
#undef PG8_MMA
#undef PG8_WAIT_V
#undef PG8_WAIT_L
#undef PG8_BAR
#undef PG8_SCHED
}
}

struct EpiInProj {
    static constexpr bool PERM = true;
    bf16_t* P; bf16_t* KLl; bf16_t* VLl;
    float* out; const float* qg; const float* kg; const float* rope; LAS float* xch; int layer;
    __device__ __forceinline__ void operator()(f32x4 (&acc)[2][2][4][2], const pg8::Unit& u, int wr, int wc, int fr, int fq) const {
        const int pn = u.pn, pm = u.pm;
        const bool lat = pm >= 16;
        asm volatile("" : "+v"(fr), "+v"(fq));
        const int rl0 = wr * 64 + fr, cl0 = wc * 32 + 8 * fq;
        if (pn < 6) {
#pragma unroll
            for (int ai = 0; ai < 2; ++ai)
#pragma unroll
                for (int m = 0; m < 4; ++m)
#pragma unroll
                    for (int bj = 0; bj < 2; ++bj) {
                        const f32x4 a = acc[ai][bj][m][0], b = acc[ai][bj][m][1];
                        float s = (a[0] * a[0] + a[1] * a[1]) + (a[2] * a[2] + a[3] * a[3]) + (b[0] * b[0] + b[1] * b[1]) + (b[2] * b[2] + b[3] * b[3]);
                        s += __shfl_xor(s, 16); s += __shfl_xor(s, 32);
                        if (fq == 0) xch[((ai * 128 + rl0 + m * 16) * 2 + bj) * 4 + wc] = s;
                    }
            LDS_WAIT(); __builtin_amdgcn_s_barrier(); asm volatile("" ::: "memory");
            const float* gsrc = (pn < 4) ? qg : kg;
            const f32x4 g0 = *(const f32x4*)(gsrc + cl0), g1 = *(const f32x4*)(gsrc + cl0 + 4);
#pragma unroll
            for (int ai = 0; ai < 2; ++ai)
#pragma unroll
                for (int m = 0; m < 4; ++m) {
                    const int rl = ai * 128 + rl0 + m * 16, row = pm * 256 + rl;
#pragma unroll
                    for (int bj = 0; bj < 2; ++bj) {
                        const f32x4 pp = *(const LAS f32x4*)(xch + (rl * 2 + bj) * 4);
                        const float rs = rsqrtf(((pp[0] + pp[1]) + (pp[2] + pp[3])) * (1.f / HD) + EPS);
                        f32x4 v0 = acc[ai][bj][m][0] * rs * g0, v1 = acc[ai][bj][m][1] * rs * g1;
                        if (lat) {
                            const int t = (row - NCTX) & (LS - 1);
                            const f32x4 c0 = *(const f32x4*)(rope + ((size_t)t * 64 + (cl0 >> 1)) * 2), c1 = *(const f32x4*)(rope + ((size_t)t * 64 + (cl0 >> 1) + 2) * 2);
                            f32x4 w0, w1;
                            w0[0] = v0[0] * c0[0] - v0[1] * c0[1]; w0[1] = v0[0] * c0[1] + v0[1] * c0[0]; w0[2] = v0[2] * c0[2] - v0[3] * c0[3]; w0[3] = v0[2] * c0[3] + v0[3] * c0[2];
                            w1[0] = v1[0] * c1[0] - v1[1] * c1[1]; w1[1] = v1[0] * c1[1] + v1[1] * c1[0]; w1[2] = v1[2] * c1[2] - v1[3] * c1[3]; w1[3] = v1[2] * c1[3] + v1[3] * c1[2];
                            v0 = w0; v1 = w1;
                        }
                        u32x4 w; w.x = cvt_pk(v0[0], v0[1]); w.y = cvt_pk(v0[2], v0[3]); w.z = cvt_pk(v1[0], v1[1]); w.w = cvt_pk(v1[2], v1[3]);
                        const int col = pn * 256 + bj * 128 + cl0;
                        if (pn < 4 || !lat) *(u32x4*)(P + (size_t)row * DIN + col) = w;
                        if (pn >= 4) {
                            const int kc = col - OFF_K;
                            if (!lat) { float* o = out + OUT_NK + ((size_t)(pm * 2 + layer) * CS + rl) * DKV + kc; *(f32x4*)o = v0; *(f32x4*)(o + 4) = v1; }
                            else { const int b = (pm - 16) >> 2, t = ((pm - 16) & 3) * 256 + rl; *(u32x4*)(KLl + ((size_t)b * KVL + t) * DKV + kc) = w; }
                        }
                    }
                    asm volatile("" ::: "memory");
                }
        } else {
            const bool is_v = pn < 8, act = (pn >= 8 && pn < 12) || pn >= 24;
#pragma unroll
            for (int ai = 0; ai < 2; ++ai)
#pragma unroll
                for (int m = 0; m < 4; ++m) {
                    const int rl = ai * 128 + rl0 + m * 16, row = pm * 256 + rl;
#pragma unroll
                    for (int bj = 0; bj < 2; ++bj) {
                        f32x4 v0 = acc[ai][bj][m][0], v1 = acc[ai][bj][m][1];
                        if (act) {
#pragma unroll
                            for (int e = 0; e < 4; ++e) { v0[e] = silu_f(v0[e]); v1[e] = silu_f(v1[e]); }
                        }
                        u32x4 w; w.x = cvt_pk(v0[0], v0[1]); w.y = cvt_pk(v0[2], v0[3]); w.z = cvt_pk(v1[0], v1[1]); w.w = cvt_pk(v1[2], v1[3]);
                        const int col = pn * 256 + bj * 128 + cl0;
                        if (!is_v || !lat) *(u32x4*)(P + (size_t)row * DIN + col) = w;
                        if (is_v) {
                            const int vc = col - OFF_V;
                            if (!lat) { float* o = out + OUT_NV + ((size_t)(pm * 2 + layer) * CS + rl) * DKV + vc; *(f32x4*)o = v0; *(f32x4*)(o + 4) = v1; }
                            else { const int b = (pm - 16) >> 2, t = ((pm - 16) & 3) * 256 + rl; *(u32x4*)(VLl + ((size_t)b * KVL + t) * DKV + vc) = w; }
                        }
                    }
                    asm volatile("" ::: "memory");
                }
        }
    }
};
struct EpiOutProj {
    static constexpr bool PERM = true;
    const float* xc; const float* xl; float* xo; const float* modf;
    __device__ __forceinline__ void operator()(f32x4 (&acc)[2][2][4][2], const pg8::Unit& u, int wr, int wc, int fr, int fq) const {
        const int pn = u.pn, pm = u.pm;
        const bool lat = pm >= 16;
        const int j = lat ? 1 + ((pm - 16) >> 2) : 0;
        const float* gate = modf + (size_t)j * 3 * DM + 2 * DM;
        const float* xin = lat ? xl - (size_t)NCTX * DM : xc;
        asm volatile("" : "+v"(fr), "+v"(fq));
        const int rl0 = wr * 64 + fr, cl0 = wc * 32 + 8 * fq;
#pragma unroll
        for (int bj = 0; bj < 2; ++bj) {
            const int col = pn * 256 + bj * 128 + cl0;
            const f32x4 g0 = *(const f32x4*)(gate + col), g1 = *(const f32x4*)(gate + col + 4);
#pragma unroll
            for (int ai = 0; ai < 2; ++ai)
#pragma unroll
                for (int m = 0; m < 4; ++m) {
                    const size_t off = (size_t)(pm * 256 + ai * 128 + rl0 + m * 16) * DM + col;
                    const f32x4 x0 = *(const f32x4*)(xin + off), x1 = *(const f32x4*)(xin + off + 4);
                    *(f32x4*)(xo + off) = x0 + g0 * acc[ai][bj][m][0]; *(f32x4*)(xo + off + 4) = x1 + g1 * acc[ai][bj][m][1];
                }
        }
    }
};

__device__ __forceinline__ void p0_transpose_item(const float* W, int K, int N, bf16_t* WT, LAS float* scr, int item, int lane) {
    const int nblk = N / 32, kb = item / nblk, nb = item % nblk, k0 = 64 * kb, n0 = 32 * nb;
#pragma unroll 8
    for (int i = 0; i < 32; ++i) { const int kk = 2 * i + (lane >> 5); scr[kk * 33 + (lane & 31)] = W[(size_t)(k0 + kk) * N + n0 + (lane & 31)]; }
    LDS_WAIT();
    const int c = lane & 7;
#pragma unroll
    for (int j = 0; j < 4; ++j) { const int n = (lane >> 3) + 8 * j; const LAS float* s = scr + (8 * c) * 33 + n;
        u32x4 o; o.x = pk2(s[0 * 33], s[1 * 33]); o.y = pk2(s[2 * 33], s[3 * 33]); o.z = pk2(s[4 * 33], s[5 * 33]); o.w = pk2(s[6 * 33], s[7 * 33]);
        *(u32x4*)(WT + (size_t)(n0 + n) * K + k0 + 8 * c) = o; }
    LDS_WAIT();
}

template <int DIR>
__device__ __forceinline__ void filter_item(const Params& p, int l, int L, int ci, bf16_t* T, LAS float* scr) {
    int tid = threadIdx.x; asm volatile("" : "+v"(tid));
    const float* w1 = p.in[14] + l * 33 * 64; const float* b1 = p.in[15] + l * 64; const float* w2 = p.in[16] + l * 64 * 64; const float* b2 = p.in[17] + l * 64;
    const float* w3 = p.in[18] + (size_t)l * 64 * 2048; const float* freq = p.in[19] + l * 64;
    LAS float* zf = scr;
    LAS float* h1 = scr + 32 * 33;
    LAS float* h2t = h1 + 32 * 64;
    const int tbase = DIR == 0 ? 1 + 32 * ci : 32 * ci;
    for (int idx = tid; idx < 32 * 33; idx += NT) {
        const int tt = idx / 33, f = idx % 33; const float t = (float)(tbase + tt);
        const float t_norm = t / (float)(L - 1), w = 2.0f * 3.14159265358979323846f * t / (float)L;
        float v;
        if (f == 0) v = t_norm;
        else { const int i = (f - 1) & 15; const float band = 1e-4f + (float)i * ((15.f - 1e-4f) / 15.f); v = f <= 16 ? cosf(w * band) : -sinf(w * band); }
        zf[idx] = v;
    }
    __syncthreads();
    for (int idx = tid; idx < 32 * 64; idx += NT) {
        const int tt = idx >> 6, j = idx & 63; float a = b1[j];
        for (int f = 0; f < 33; ++f) a += zf[tt * 33 + f] * w1[f * 64 + j];
        h1[idx] = sinf(freq[j] * a);
    }
    __syncthreads();
    for (int idx = tid; idx < 32 * 64; idx += NT) {
        const int tt = idx >> 6, j = idx & 63; float a = b2[j];
        for (int i = 0; i < 64; ++i) a += h1[tt * 64 + i] * w2[i * 64 + j];
        h2t[j * 32 + tt] = sinf(freq[j] * a);
    }
    __syncthreads();
    const int c = tid * 2;
    float acc0[32], acc1[32];
#pragma unroll
    for (int tt = 0; tt < 32; ++tt) { acc0[tt] = 0.f; acc1[tt] = 0.f; }
    float e0 = 0.f, e1 = 0.f;
    const bool extra = (DIR == 1 && ci == 0);
    for (int j = 0; j < 64; ++j) {
        const f32x2 wv = *(const f32x2*)(w3 + (size_t)j * 2048 + DIR * 1024 + c);
#pragma unroll
        for (int q = 0; q < 8; ++q) {
            const f32x4 hv = *(const LAS f32x4*)(h2t + j * 32 + q * 4);
#pragma unroll
            for (int e = 0; e < 4; ++e) { acc0[q * 4 + e] += hv[e] * wv[0]; acc1[q * 4 + e] += hv[e] * wv[1]; }
        }
        if (extra) { const f32x2 wf = *(const f32x2*)(w3 + (size_t)j * 2048 + c); const float h0 = h2t[j * 32]; e0 += h0 * wf[0]; e1 += h0 * wf[1]; }
    }
    const float max_decay = logf(1e-2f) / 0.3f, min_decay = logf(1e-2f) / 1.5f;
    const float d0 = fabsf(min_decay + (float)c * ((max_decay - min_decay) / 1023.f)), d1 = fabsf(min_decay + (float)(c + 1) * ((max_decay - min_decay) / 1023.f));
#pragma unroll
    for (int tt = 0; tt < 32; ++tt) {
        const int t = tbase + tt; const float t_norm = (float)t / (float)(L - 1);
        float v0 = acc0[tt] * (__expf(-t_norm * d0) + 0.05f), v1 = acc1[tt] * (__expf(-t_norm * d1) + 0.05f);
        if (DIR == 0 && t >= L) { v0 = 0.f; v1 = 0.f; }
        if (extra && tt == 0) { v0 += e0 * 1.05f + p.in[20][l * DHY + c]; v1 += e1 * 1.05f + p.in[20][l * DHY + c + 1]; }
        acc0[tt] = v0; acc1[tt] = v1;
    }
    const int n0 = DIR == 0 ? L - 32 - 32 * ci : L + 32 * ci;
    bf16_t* r0 = T + (size_t)c * (2 * L) + n0; bf16_t* r1 = r0 + 2 * L;
#pragma unroll
    for (int q = 0; q < 4; ++q) {
        u32x4 a, b;
        if (DIR == 0) {
            a.x = pk2(acc0[31 - (8 * q + 0)], acc0[31 - (8 * q + 1)]); a.y = pk2(acc0[31 - (8 * q + 2)], acc0[31 - (8 * q + 3)]); a.z = pk2(acc0[31 - (8 * q + 4)], acc0[31 - (8 * q + 5)]); a.w = pk2(acc0[31 - (8 * q + 6)], acc0[31 - (8 * q + 7)]);
            b.x = pk2(acc1[31 - (8 * q + 0)], acc1[31 - (8 * q + 1)]); b.y = pk2(acc1[31 - (8 * q + 2)], acc1[31 - (8 * q + 3)]); b.z = pk2(acc1[31 - (8 * q + 4)], acc1[31 - (8 * q + 5)]); b.w = pk2(acc1[31 - (8 * q + 6)], acc1[31 - (8 * q + 7)]);
        } else {
            a.x = pk2(acc0[8 * q + 0], acc0[8 * q + 1]); a.y = pk2(acc0[8 * q + 2], acc0[8 * q + 3]); a.z = pk2(acc0[8 * q + 4], acc0[8 * q + 5]); a.w = pk2(acc0[8 * q + 6], acc0[8 * q + 7]);
            b.x = pk2(acc1[8 * q + 0], acc1[8 * q + 1]); b.y = pk2(acc1[8 * q + 2], acc1[8 * q + 3]); b.z = pk2(acc1[8 * q + 4], acc1[8 * q + 5]); b.w = pk2(acc1[8 * q + 6], acc1[8 * q + 7]);
        }
        *(u32x4*)(r0 + 8 * q) = a; *(u32x4*)(r1 + 8 * q) = b;
    }
    __syncthreads();
}

namespace att {
using s16x4 = __attribute__((ext_vector_type(4))) short;
using f32x16 = __attribute__((ext_vector_type(16))) float;
constexpr int D = 128, QBLK = 32, KVBLK = 64;
constexpr float SCALE = 0.088388347648318440f, THR = 8.f;
constexpr size_t SHM_V = KVBLK * D * 2, SHM_K = KVBLK * D * 2, SHM_ATTN = 2 * SHM_V + 2 * SHM_K + NW * 64 * 4;
#define KSWZ(row, colB) ((row) * 256 + ((colB) ^ (((row) & 7) << 4)))
#define SBAR() __builtin_amdgcn_sched_barrier(0)
__device__ __forceinline__ int crow(int r, int hi) { return (r & 3) + 8 * (r >> 2) + 4 * hi; }
__device__ __forceinline__ void partialSM(f32x16& p0, f32x16& p1, float& m_reg, float& mn, float& alpha) {
  constexpr float C = SCALE * 1.4426950408889634f;
  float pmax = p0[0];
#pragma unroll
  for (int r = 1; r < 16; ++r) pmax = fmaxf(pmax, p0[r]);
#pragma unroll
  for (int r = 0; r < 16; ++r) pmax = fmaxf(pmax, p1[r]);
  { auto rr = __builtin_amdgcn_permlane32_swap(__float_as_uint(pmax), __float_as_uint(pmax), false, false);
    pmax = fmaxf(__uint_as_float(rr[0]), __uint_as_float(rr[1])); }
  if (__builtin_expect(__all(pmax - m_reg <= THR / SCALE), 1)) { mn = m_reg; alpha = 1.f; }
  else { mn = fmaxf(m_reg, pmax); alpha = __builtin_amdgcn_exp2f((m_reg - mn) * C); m_reg = mn; }
  float mnC = -mn * C;
#pragma unroll
  for (int r = 0; r < 16; ++r) p0[r] = fmaf(p0[r], C, mnC);
#pragma unroll
  for (int r = 0; r < 16; ++r) p1[r] = fmaf(p1[r], C, mnC);
#pragma unroll
  for (int r = 0; r < 16; ++r) p0[r] = __builtin_amdgcn_exp2f(p0[r]);
}
__device__ __forceinline__ void finishSM(f32x16& p0, f32x16& p1, float alpha, float& l_reg, bf16x8& pa0, bf16x8& pa1, bf16x8& pa2, bf16x8& pa3) {
#pragma unroll
  for (int r = 0; r < 16; ++r) p1[r] = __builtin_amdgcn_exp2f(p1[r]);
  float ps = 0;
#pragma unroll
  for (int r = 0; r < 16; ++r) ps += p0[r];
#pragma unroll
  for (int r = 0; r < 16; ++r) ps += p1[r];
  { auto rr = __builtin_amdgcn_permlane32_swap(__float_as_uint(ps), __float_as_uint(ps), false, false);
    ps = __uint_as_float(rr[0]) + __uint_as_float(rr[1]); }
  l_reg = l_reg * alpha + ps;
#define PK4(P, BASE, OUT) do { unsigned a0 = cvt_pk(P[BASE + 0], P[BASE + 1]), a1 = cvt_pk(P[BASE + 2], P[BASE + 3]);   \
    unsigned b0 = cvt_pk(P[BASE + 4], P[BASE + 5]), b1 = cvt_pk(P[BASE + 6], P[BASE + 7]);                              \
    auto r0 = __builtin_amdgcn_permlane32_swap(a0, b0, false, false); auto r1 = __builtin_amdgcn_permlane32_swap(a1, b1, false, false); \
    u32x4 w = {r0[0], r1[0], r0[1], r1[1]}; OUT = *reinterpret_cast<bf16x8*>(&w); } while (0)
  PK4(p0, 0, pa0); PK4(p0, 8, pa1); PK4(p1, 0, pa2); PK4(p1, 8, pa3);
#undef PK4
}
__device__ __forceinline__ void qkt(f32x16& p0, f32x16& p1, const bf16_t* Ks, const bf16x8* qr, int r32, int hi) {
  p0 = f32x16{}; p1 = f32x16{};
#pragma unroll
  for (int d0 = 0; d0 < 8; ++d0) { int cb = (d0 * 16 + hi * 8) * 2;
    bf16x8 b0 = *reinterpret_cast<const bf16x8*>((const char*)Ks + KSWZ(r32, cb));
    bf16x8 b1 = *reinterpret_cast<const bf16x8*>((const char*)Ks + KSWZ(32 + r32, cb));
    p0 = __builtin_amdgcn_mfma_f32_32x32x16_bf16(b0, qr[d0], p0, 0, 0, 0);
    p1 = __builtin_amdgcn_mfma_f32_32x32x16_bf16(b1, qr[d0], p1, 0, 0, 0); }
}
__device__ __forceinline__ int v_st(int k, int c) { const int kk = (k & ~0xC) | ((k & 4) << 1) | ((k & 8) >> 1); return ((kk >> 3) * 4 + (c >> 5)) * 512 + ((kk & 7) * 32 + (c & 31)) * 2; }
__device__ __forceinline__ int v_rd_base(int lane) { return ((lane & 3) << 3) | (((lane >> 2) & 3) << 6) | (((lane >> 4) & 1) << 5) | (((lane >> 5) & 1) << 8); }
constexpr int v_rd_off(int d0, int ks, int half) { return d0 * 512 + ks * 4096 + half * 2048; }
template <int OFF> __device__ __forceinline__ s16x4 tr_read(int vb) {
  s16x4 r; asm volatile("ds_read_b64_tr_b16 %0, %1 offset:%2" : "=&v"(r) : "v"(vb), "i"(OFF) : "memory"); return r;
}
template <int D0> __device__ __forceinline__ void pv_one(f32x16& od, int vb, bf16x8 pa0, bf16x8 pa1, bf16x8 pa2, bf16x8 pa3) {
  const s16x4 l0 = tr_read<v_rd_off(D0, 0, 0)>(vb), h0 = tr_read<v_rd_off(D0, 0, 1)>(vb), l1 = tr_read<v_rd_off(D0, 1, 0)>(vb), h1 = tr_read<v_rd_off(D0, 1, 1)>(vb);
  const s16x4 l2 = tr_read<v_rd_off(D0, 2, 0)>(vb), h2 = tr_read<v_rd_off(D0, 2, 1)>(vb), l3 = tr_read<v_rd_off(D0, 3, 0)>(vb), h3 = tr_read<v_rd_off(D0, 3, 1)>(vb);
  asm volatile("s_waitcnt lgkmcnt(0)" ::: "memory"); SBAR();
#define PK(L, H) (bf16x8){L[0], L[1], L[2], L[3], H[0], H[1], H[2], H[3]}
  od = __builtin_amdgcn_mfma_f32_32x32x16_bf16(pa0, PK(l0, h0), od, 0, 0, 0);
  od = __builtin_amdgcn_mfma_f32_32x32x16_bf16(pa1, PK(l1, h1), od, 0, 0, 0);
  od = __builtin_amdgcn_mfma_f32_32x32x16_bf16(pa2, PK(l2, h2), od, 0, 0, 0);
  od = __builtin_amdgcn_mfma_f32_32x32x16_bf16(pa3, PK(l3, h3), od, 0, 0, 0);
#undef PK
}
__device__ __forceinline__ void pv_d0(f32x16* o, int vb, bf16x8 pa0, bf16x8 pa1, bf16x8 pa2, bf16x8 pa3) {
  pv_one<0>(o[0], vb, pa0, pa1, pa2, pa3); pv_one<1>(o[1], vb, pa0, pa1, pa2, pa3); pv_one<2>(o[2], vb, pa0, pa1, pa2, pa3); pv_one<3>(o[3], vb, pa0, pa1, pa2, pa3);
}
__device__ __forceinline__ void attn_body(const bf16_t* __restrict__ Qb, int ldq, const bf16_t* __restrict__ Kh, const bf16_t* __restrict__ Vh, int ldk,
                                          const bf16_t* __restrict__ Gb, int ldg, bf16_t* __restrict__ Ob, int ldo, int seq, char* lds) {
  int tid = threadIdx.x; asm volatile("" : "+v"(tid));
  const int wid = tid >> 6, lane = tid & 63, r32 = lane & 31, hi = lane >> 5;
  bf16_t* V_lds = (bf16_t*)lds; bf16_t* K_lds = (bf16_t*)(lds + 2 * SHM_V);
  float* wsf = (float*)(lds + 2 * SHM_V + 2 * SHM_K) + wid * 64; float* li_l = wsf; float* al_l = wsf + 32;
  float m_reg = -1e30f, l_reg = 0; f32x16 o[4] = {}; bf16x8 qr[8];
  const bf16_t* Qw = Qb + (long)(wid * QBLK + r32) * ldq + hi * 8;
#pragma unroll
  for (int d0 = 0; d0 < 8; ++d0) qr[d0] = *reinterpret_cast<const bf16x8*>(Qw + d0 * 16);
  const int sr = tid >> 4, sc = (tid & 15) * 8, vst0 = v_st(sr, sc), vst1 = v_st(32 + sr, sc);
  const int vb0 = (int)(uintptr_t)V_lds + v_rd_base(lane);
  struct { bf16x8 vs0, vs1, ks0, ks1; } sr_[2];
#define SLOAD(i, k0) do { sr_[i].vs0 = *reinterpret_cast<const bf16x8*>(&Vh[(long)((k0) + sr) * ldk + sc]); sr_[i].vs1 = *reinterpret_cast<const bf16x8*>(&Vh[(long)((k0) + 32 + sr) * ldk + sc]); \
    sr_[i].ks0 = *reinterpret_cast<const bf16x8*>(&Kh[(long)((k0) + sr) * ldk + sc]); sr_[i].ks1 = *reinterpret_cast<const bf16x8*>(&Kh[(long)((k0) + 32 + sr) * ldk + sc]); } while (0)
#define SWRITE(b, i) do { *(bf16x8*)((char*)V_lds + (b) * SHM_V + vst0) = sr_[i].vs0;          \
    *(bf16x8*)((char*)V_lds + (b) * SHM_V + vst1) = sr_[i].vs1; int kc = sc * 2;               \
    *(bf16x8*)((char*)K_lds + (b) * SHM_K + KSWZ(sr, kc)) = sr_[i].ks0;                       \
    *(bf16x8*)((char*)K_lds + (b) * SHM_K + KSWZ(32 + sr, kc)) = sr_[i].ks1; } while (0)
#define SWAIT() asm volatile("s_waitcnt vmcnt(4)" ::: "memory")
#define RESC(a) do { if (__any((a) < 1.f)) { if (hi == 0) al_l[r32] = (a); asm volatile("s_waitcnt lgkmcnt(0)" ::: "memory"); \
    _Pragma("unroll") for (int d = 0; d < 4; ++d) _Pragma("unroll") for (int r = 0; r < 16; ++r) o[d][r] *= al_l[crow(r, hi)]; } } while (0)
  f32x16 pA0, pA1, pB0, pB1; float mnA, mnB, alA, alB; bf16x8 pa0, pa1, pa2, pa3; const int NTL = seq / KVBLK;
  constexpr int SE = 0, SO = 1;
  SLOAD(SE, 0); asm volatile("s_waitcnt vmcnt(0)" ::: "memory"); SWRITE(0, SE); __syncthreads();
  qkt(pA0, pA1, K_lds, qr, r32, hi); partialSM(pA0, pA1, m_reg, mnA, alA);
  SLOAD(SO, KVBLK); if (2 < NTL) SLOAD(SE, 2 * KVBLK);
  SWAIT(); SWRITE(1, SO); __syncthreads();
  for (int j = 1; j + 1 < NTL; j += 2) {
    SBAR(); qkt(pB0, pB1, (bf16_t*)((char*)K_lds + SHM_K), qr, r32, hi);
    finishSM(pA0, pA1, alA, l_reg, pa0, pa1, pa2, pa3); SBAR();
    SLOAD(SO, (j + 2) * KVBLK); SBAR();
    pv_d0(o, vb0, pa0, pa1, pa2, pa3); partialSM(pB0, pB1, m_reg, mnB, alB);
    __syncthreads(); SWAIT(); SWRITE(0, SE);
    RESC(alB); __syncthreads();
    SBAR(); qkt(pA0, pA1, K_lds, qr, r32, hi);
    finishSM(pB0, pB1, alB, l_reg, pa0, pa1, pa2, pa3); SBAR();
    if (j + 3 < NTL) SLOAD(SE, (j + 3) * KVBLK); SBAR();
    pv_d0(o, vb0 + (int)SHM_V, pa0, pa1, pa2, pa3); partialSM(pA0, pA1, m_reg, mnA, alA);
    __syncthreads(); SWAIT(); SWRITE(1, SO);
    RESC(alA); __syncthreads();
  }
  SBAR(); qkt(pB0, pB1, (bf16_t*)((char*)K_lds + SHM_K), qr, r32, hi);
  finishSM(pA0, pA1, alA, l_reg, pa0, pa1, pa2, pa3); SBAR();
  pv_d0(o, vb0, pa0, pa1, pa2, pa3); partialSM(pB0, pB1, m_reg, mnB, alB);
  __syncthreads(); RESC(alB);
  finishSM(pB0, pB1, alB, l_reg, pa0, pa1, pa2, pa3); SBAR();
  pv_d0(o, vb0 + (int)SHM_V, pa0, pa1, pa2, pa3);
  if (hi == 0) li_l[r32] = l_reg; asm volatile("s_waitcnt lgkmcnt(0)" ::: "memory");
  float rli[16];
#pragma unroll
  for (int r = 0; r < 16; ++r) rli[r] = __builtin_amdgcn_rcpf(li_l[crow(r, hi)]);
  bf16_t* Ow = Ob + (long)(wid * QBLK) * ldo; const bf16_t* Gw = Gb + (long)(wid * QBLK) * ldg;
#pragma unroll
  for (int r = 0; r < 16; ++r) { const int orow = crow(r, hi);
#pragma unroll
    for (int d0 = 0; d0 < 4; ++d0) Ow[(long)orow * ldo + d0 * 32 + r32] = (bf16_t)f2bf(o[d0][r] * rli[r] * bf2f(Gw[(long)orow * ldg + d0 * 32 + r32])); }
  __syncthreads();
#undef SLOAD
#undef SWRITE
#undef SWAIT
#undef RESC
}
#undef KSWZ
#undef SBAR
}

namespace hy {
using f32x16 = __attribute__((ext_vector_type(16))) float;
constexpr int Z_OFF = 0, T_OFF = 65536, TW = 8448, ZERO_OFF = T_OFF + 8 * TW;
template <int L>
__device__ __forceinline__ void unit(const Params& p, int layer, int base, int cg, LAS unsigned char* lds, const bf16_t* P, bf16_t* HM, const bf16_t* Tl) {
    constexpr int NB = L / 32, NP = L / 256, C1OFF = 4 * L + 68;
    int tid = threadIdx.x; asm volatile("" : "+v"(tid));
    const int lane = tid & 63, wave = __builtin_amdgcn_readfirstlane(tid >> 6);
    const float* cw = p.in[12] + (size_t)layer * 3 * 3072; const float* cb = p.in[13] + layer * 3072;
    {
        const int q = tid >> 2, oct = tid & 3, n = q >> 2, c = q & 3, T0 = n * 32 + c * 8, ch0 = cg * 32 + oct * 8;
        if (tid < 16) *(LAS unsigned*)(lds + ZERO_OFF + tid * 4) = 0u;
        const bf16_t* src = P + (size_t)(base + T0) * DIN + OFF_HY + ch0;
        const bool has_prev = (T0 & (L - 1)) != 0, has_next = ((T0 + 8) & (L - 1)) != 0;
        u32x4 r1[10], r2[10];
#pragma unroll
        for (int j = 0; j < 10; ++j) {
            const bool ok = (j == 0) ? has_prev : (j == 9 ? has_next : true);
            if (ok) { r1[j] = *(const u32x4*)(src + (long)(j - 1) * DIN + DHY); r2[j] = *(const u32x4*)(src + (long)(j - 1) * DIN + 2 * DHY); }
            else { r1[j] = (u32x4){0u, 0u, 0u, 0u}; r2[j] = (u32x4){0u, 0u, 0u, 0u}; }
        }
#pragma unroll
        for (int cc = 0; cc < 8; ++cc) {
            const int ch = ch0 + cc;
            const float w10 = cw[DHY + ch], w11 = cw[3072 + DHY + ch], w12 = cw[2 * 3072 + DHY + ch], b1 = cb[DHY + ch];
            const float w20 = cw[2 * DHY + ch], w21 = cw[3072 + 2 * DHY + ch], w22 = cw[2 * 3072 + 2 * DHY + ch], b2 = cb[2 * DHY + ch];
            float x1[10], x2[10];
#pragma unroll
            for (int j = 0; j < 10; ++j) { const unsigned a = r1[j][cc >> 1], b = r2[j][cc >> 1]; x1[j] = (cc & 1) ? bfhi(a) : bflo(a); x2[j] = (cc & 1) ? bfhi(b) : bflo(b); }
            float z[8];
#pragma unroll
            for (int e = 0; e < 8; ++e) { const float u1 = b1 + w10 * x1[e] + w11 * x1[e + 1] + w12 * x1[e + 2], u2 = b2 + w20 * x2[e] + w21 * x2[e + 1] + w22 * x2[e + 2]; z[e] = u1 * u2; }
            u32x4 w; w.x = cvt_pk(z[0], z[1]); w.y = cvt_pk(z[2], z[3]); w.z = cvt_pk(z[4], z[5]); w.w = cvt_pk(z[6], z[7]);
            *(LAS u32x4*)(lds + Z_OFF + (oct * 8 + cc) * 2048 + n * 64 + ((c ^ ((n >> 2) & 3)) << 4)) = w;
        }
    }
    __syncthreads();
    {
        LAS unsigned char* tw = lds + T_OFF + wave * TW;
        const int r = lane & 31, h = lane >> 5, e = r & 1;
        for (int ci = 0; ci < 4; ++ci) {
            const int chl = wave * 4 + ci, ch = cg * 32 + chl;
            const unsigned char* Tsrc = (const unsigned char*)(Tl + (size_t)ch * (2 * L));
            u32x4 d[NP];
#pragma unroll
            for (int i = 0; i < NP; ++i) d[i] = *(const u32x4*)(Tsrc + i * 1024 + lane * 16);
#pragma unroll
            for (int i = 0; i < NP; ++i) {
                *(LAS u32x4*)(tw + i * 1024 + lane * 16) = d[i];
                unsigned nx = __shfl_down(d[i].x, 1);
                const unsigned nfirst = (i + 1 < NP) ? (unsigned)__builtin_amdgcn_readlane((int)d[(i + 1 < NP) ? i + 1 : i].x, 0) : 0u;
                if (lane == 63) nx = nfirst;
                LAS unsigned* o = (LAS unsigned*)(tw + C1OFF + i * 1024 + lane * 16);
                o[0] = __builtin_amdgcn_alignbit(d[i].y, d[i].x, 16); o[1] = __builtin_amdgcn_alignbit(d[i].z, d[i].y, 16);
                o[2] = __builtin_amdgcn_alignbit(d[i].w, d[i].z, 16); o[3] = __builtin_amdgcn_alignbit(nx, d[i].w, 16);
            }
            LDS_WAIT(); __builtin_amdgcn_wave_barrier();
            const LAS unsigned char* aBase = tw + e * C1OFF + ((((L - r - e) >> 1) + 4 * h) << 2);
            const LAS unsigned char* zc = lds + Z_OFF + chl * 2048;
            f32x16 acc0 = {}, acc1 = {};
#pragma unroll 3
            for (int k = -(NB - 1); k <= NB - 1; ++k) {
                const int np = r - k;
                const bool valid = (L == 1024) ? ((unsigned)np < 32u) : ((unsigned)((r & 7) - k) < 8u);
                const int c0 = h ^ ((np >> 2) & 3);
                const LAS unsigned char* zp = zc + np * 64;
                const LAS unsigned char* z0 = valid ? zp + (c0 << 4) : lds + ZERO_OFF;
                const LAS unsigned char* z1 = valid ? zp + ((c0 ^ 2) << 4) : lds + ZERO_OFF;
                const LAS unsigned* ap = (const LAS unsigned*)(aBase - 64 * k);
                const u32x4 a0 = {ap[0], ap[1], ap[2], ap[3]}, a1 = {ap[8], ap[9], ap[10], ap[11]};
                const bf16x8 b0 = *(const LAS bf16x8*)z0, b1 = *(const LAS bf16x8*)z1;
                acc0 = __builtin_amdgcn_mfma_f32_32x32x16_bf16(__builtin_bit_cast(bf16x8, a0), b0, acc0, 0, 0, 0);
                acc1 = __builtin_amdgcn_mfma_f32_32x32x16_bf16(__builtin_bit_cast(bf16x8, a1), b1, acc1, 0, 0, 0);
            }
#pragma unroll
            for (int q = 0; q < 4; ++q) {
                u32x2 w; w.x = cvt_pk(acc0[4 * q] + acc1[4 * q], acc0[4 * q + 1] + acc1[4 * q + 1]); w.y = cvt_pk(acc0[4 * q + 2] + acc1[4 * q + 2], acc0[4 * q + 3] + acc1[4 * q + 3]);
                *(LAS u32x2*)(lds + Z_OFF + chl * 2048 + r * 64 + ((q ^ ((r >> 2) & 3)) << 4) + h * 8) = w;
            }
            LDS_WAIT(); __builtin_amdgcn_wave_barrier();
        }
    }
    __syncthreads();
    {
        const int oct = tid & 3, ch0 = cg * 32 + oct * 8;
        f32x4 w0[2], w1[2], w2[2], bb[2];
#pragma unroll
        for (int i = 0; i < 2; ++i) { w0[i] = *(const f32x4*)(cw + ch0 + 4 * i); w1[i] = *(const f32x4*)(cw + 3072 + ch0 + 4 * i); w2[i] = *(const f32x4*)(cw + 2 * 3072 + ch0 + 4 * i); bb[i] = *(const f32x4*)(cb + ch0 + 4 * i); }
#pragma unroll 2
        for (int it = 0; it < 8; ++it) {
            const int T = (tid >> 2) + 128 * it, n = T >> 5, i = T & 31;
            const bf16_t* src = P + (size_t)(base + T) * DIN + OFF_HY + ch0;
            const bool has_prev = (T & (L - 1)) != 0, has_next = ((T + 1) & (L - 1)) != 0;
            const u32x4 xc = *(const u32x4*)src;
            u32x4 xp = {0u, 0u, 0u, 0u}, xn = {0u, 0u, 0u, 0u};
            if (has_prev) xp = *(const u32x4*)(src - DIN);
            if (has_next) xn = *(const u32x4*)(src + DIN);
            const u32x4 gh = *(const u32x4*)(P + (size_t)(base + T) * DIN + OFF_GH + ch0);
            const LAS unsigned char* yb = lds + Z_OFF + (oct * 8) * 2048 + n * 64 + (((i >> 3) ^ ((n >> 2) & 3)) << 4) + (i & 7) * 2;
            float o[8];
#pragma unroll
            for (int cc = 0; cc < 8; ++cc) {
                const unsigned a = xp[cc >> 1], b = xc[cc >> 1], c2 = xn[cc >> 1], g = gh[cc >> 1];
                const float fp = (cc & 1) ? bfhi(a) : bflo(a), fc = (cc & 1) ? bfhi(b) : bflo(b), fn = (cc & 1) ? bfhi(c2) : bflo(c2), fg = (cc & 1) ? bfhi(g) : bflo(g);
                const float x0 = bb[cc >> 2][cc & 3] + w0[cc >> 2][cc & 3] * fp + w1[cc >> 2][cc & 3] * fc + w2[cc >> 2][cc & 3] * fn;
                const float y = bf2f(*(const LAS unsigned short*)(yb + cc * 2048));
                o[cc] = x0 * y * fg;
            }
            u32x4 w; w.x = cvt_pk(o[0], o[1]); w.y = cvt_pk(o[2], o[3]); w.z = cvt_pk(o[4], o[5]); w.w = cvt_pk(o[6], o[7]);
            *(u32x4*)(HM + (size_t)(base + T) * DM + DHY + ch0) = w;
        }
    }
    __syncthreads();
}
}

__global__ void __launch_bounds__(NT, 2) fwd_megakernel(Params p) {
    extern __shared__ __attribute__((aligned(16))) unsigned char lds_raw[];
    cg::grid_group grid = cg::this_grid();
    LAS unsigned char* lds = (LAS unsigned char*)lds_raw;
    const int wave = __builtin_amdgcn_readfirstlane(threadIdx.x >> 6);
    const int G = gridDim.x, bx = blockIdx.x, vcu = (G % 8 == 0) ? (bx % 8) * (G / 8) + bx / 8 : bx;
    const int gw = wave * G + vcu, NGW = G * NW;
#define PHASE_IDS() int tid = threadIdx.x; asm volatile("" : "+v"(tid)); const int lane = tid & 63; (void)lane
    unsigned char* ws = p.ws;
    bf16_t* WinT = (bf16_t*)(ws + WS_WIN); bf16_t* WoutT = (bf16_t*)(ws + WS_WOUT); bf16_t* HM = (bf16_t*)(ws + WS_HM); bf16_t* P = (bf16_t*)(ws + WS_P);
    bf16_t* KL = (bf16_t*)(ws + WS_KL); bf16_t* VL = (bf16_t*)(ws + WS_VL); float* XB = (float*)(ws + WS_XB);
    float* modp = (float*)(ws + WS_MODP); float* modf = (float*)(ws + WS_MODF); bf16_t* Tt = (bf16_t*)(ws + WS_T); float* rope = (float*)(ws + WS_ROPE);
    const float* x_prompt = p.in[0]; const float* x_sample = p.in[1];

    {
        PHASE_IDS();
        LAS float* scr = (LAS float*)(lds + wave * 8448);
        LAS float* sc = (LAS float*)(lds + 8 * 8448);
        LAS float* fscr = (LAS float*)(lds + 8 * 8448 + 3 * DM * 4);
        for (int i = tid; i < DM; i += NT) { sc[i] = silu_f(p.in[5][i]); sc[DM + i] = silu_f(p.in[4][i]); sc[2 * DM + i] = silu_f(p.in[4][DM + i]); }
        __syncthreads();
        for (int fi = vcu; fi < 160; fi += G) {
            const int l = fi / 80; int r = fi % 80; int L, dir, ci; bf16_t* T = Tt + (size_t)l * T_LAYER;
            if (r < 16) { L = 256; dir = r / 8; ci = r % 8; } else { r -= 16; L = 1024; dir = r / 32; ci = r % 32; T += (size_t)DHY * 512; }
            if (dir == 0) filter_item<0>(p, l, L, ci, T, fscr); else filter_item<1>(p, l, L, ci, T, fscr);
        }
        constexpr int I_GEMV = 2 * 24 * MODP;
        constexpr int I_WIN = (DM / 64) * (DIN / 32), I_WOUT = (DM / 64) * (DM / 32);
        constexpr int I_CACHE = 2 * 2 * 2 * PAST, I_ROPE = LS;
        constexpr int I_TOTAL = I_GEMV + 2 * I_WIN + 2 * I_WOUT + I_CACHE + I_ROPE;
        for (int it = gw; it < I_TOTAL; it += NGW) {
            int r = it;
            if (r < I_GEMV) {
                const int kc = r % MODP, nc = (r / MODP) % 24, l = r / (MODP * 24);
                const float* w = p.in[7] + ((size_t)l * DM + kc * 256) * (3 * DM) + nc * 256 + lane * 4;
                f32x4 a0 = {0.f, 0.f, 0.f, 0.f}, a1 = a0, a2 = a0;
#pragma unroll 8
                for (int k = 0; k < 256; ++k) {
                    const f32x4 wv = *(const f32x4*)(w + (size_t)k * (3 * DM));
                    const int kk = kc * 256 + k;
                    a0 += wv * sc[kk]; a1 += wv * sc[DM + kk]; a2 += wv * sc[2 * DM + kk];
                }
                float* o = modp + ((size_t)(l * MODP + kc) * 3) * (3 * DM) + nc * 256 + lane * 4;
                *(f32x4*)o = a0; *(f32x4*)(o + 3 * DM) = a1; *(f32x4*)(o + 2 * 3 * DM) = a2;
                continue;
            }
            r -= I_GEMV;
            if (r < 2 * I_WIN) { const int l = r / I_WIN; p0_transpose_item(p.in[9] + (size_t)l * DM * DIN, DM, DIN, WinT + (size_t)l * DIN * DM, scr, r % I_WIN, lane); continue; }
            r -= 2 * I_WIN;
            if (r < 2 * I_WOUT) { const int l = r / I_WOUT; p0_transpose_item(p.in[21] + (size_t)l * DM * DM, DM, DM, WoutT + (size_t)l * DM * DM, scr, r % I_WOUT, lane); continue; }
            r -= 2 * I_WOUT;
            if (r < I_CACHE) {
                const int s = r % PAST, l = (r / PAST) & 1, b = (r / (2 * PAST)) & 1, which = r / (4 * PAST);
                const float* src = p.in[2 + which] + (((size_t)b * 2 + l) * PAST + s) * DKV + lane * 8;
                const f32x4 v0 = *(const f32x4*)src, v1 = *(const f32x4*)(src + 4);
                u32x4 w; w.x = pk2(v0[0], v0[1]); w.y = pk2(v0[2], v0[3]); w.z = pk2(v1[0], v1[1]); w.w = pk2(v1[2], v1[3]);
                bf16_t* dst = (which ? VL : KL) + (((size_t)l * 2 + b) * KVL + LS + s) * DKV + lane * 8;
                *(u32x4*)dst = w;
                continue;
            }
            r -= I_CACHE;
            {
                const int t = r; const float rowp = (float)(t / 64), colp = (float)(t % 64);
                const float invf = powf(10000.f, -(float)(lane & 31) / 32.f);
                const float ang = (lane < 32 ? rowp : colp) * invf;
                *(f32x2*)(rope + ((size_t)t * 64 + lane) * 2) = (f32x2){cosf(ang), sinf(ang)};
            }
        }
    }
    grid.sync();

    for (int layer = 0; layer < 2; ++layer) {
        {
            PHASE_IDS();
            LAS float* mt = (LAS float*)lds;
            if (layer == 0) {
                for (int idx = tid; idx < 3 * 2 * DM; idx += NT) {
                    const int j = idx / (2 * DM), n = idx % (2 * DM); float s = p.in[8][n];
#pragma unroll
                    for (int q = 0; q < MODP; ++q) s += modp[((size_t)q * 3 + j) * (3 * DM) + n];
                    mt[idx] = s;
                }
                if (tid < 144) {
                    const int idx = vcu * 144 + tid;
                    if (idx < 2 * 3 * 3 * DM) {
                        const int n = idx % (3 * DM), j = (idx / (3 * DM)) % 3, l = idx / (9 * DM); float s = p.in[8][l * 3 * DM + n];
#pragma unroll
                        for (int q = 0; q < MODP; ++q) s += modp[((size_t)(l * MODP + q) * 3 + j) * (3 * DM) + n];
                        modf[idx] = s;
                    }
                }
            } else {
                for (int idx = tid; idx < 3 * 2 * DM; idx += NT) { const int j = idx / (2 * DM), n = idx % (2 * DM); mt[idx] = modf[((size_t)layer * 3 + j) * (3 * DM) + n]; }
            }
            __syncthreads();
            const float* ng = p.in[6] + layer * DM;
            for (int row = gw; row < NTOK; row += NGW) {
                const float* xr = layer == 0 ? (row < NCTX ? x_prompt + (size_t)row * DM : x_sample + (size_t)(row - NCTX) * DM) : XB + (size_t)row * DM;
                const int j = row < NCTX ? 0 : 1 + (row - NCTX) / LS;
                f32x4 v[8]; float ss = 0.f;
#pragma unroll
                for (int i = 0; i < 8; ++i) { v[i] = *(const f32x4*)(xr + 4 * lane + 256 * i); ss += (v[i][0] * v[i][0] + v[i][1] * v[i][1]) + (v[i][2] * v[i][2] + v[i][3] * v[i][3]); }
                ss = wave_sum(ss);
                const float rs = rsqrtf(ss * (1.f / DM) + EPS);
#pragma unroll
                for (int i = 0; i < 8; ++i) {
                    const int col = 4 * lane + 256 * i;
                    const f32x4 gg = *(const f32x4*)(ng + col);
                    const f32x4 sh = *(const LAS f32x4*)(mt + j * 2 * DM + col), scl = *(const LAS f32x4*)(mt + j * 2 * DM + DM + col);
                    const f32x4 h = v[i] * rs * gg * (scl + 1.f) + sh;
                    u32x2 w; w.x = pk2(h[0], h[1]); w.y = pk2(h[2], h[3]);
                    *(u32x2*)(HM + (size_t)row * DM + col) = w;
                }
            }
        }
        grid.sync();

        {
            pg8::Gemm g{HM, WinT + (size_t)layer * DIN * DM, NTOK, DIN, DM};
            pg8::StaticOrder S; S.init(NTOK, DIN, G, bx);
            EpiInProj E{P, KL + (size_t)layer * 2 * KVL * DKV, VL + (size_t)layer * 2 * KVL * DKV, p.out, p.in[10] + layer * HD, p.in[11] + layer * HD, rope, (LAS float*)(lds + XCH_OFF), layer};
            pg8::gemm_phase<EpiInProj, pg8::StaticOrder>(lds, g, S, E);
        }
        grid.sync();

        {
            const bf16_t* KLl = KL + (size_t)layer * 2 * KVL * DKV; const bf16_t* VLl = VL + (size_t)layer * 2 * KVL * DKV;
            const bf16_t* T256 = Tt + (size_t)layer * T_LAYER; const bf16_t* T1024 = T256 + (size_t)DHY * 512;
            for (int slot = bx; slot < 448; slot += G) {
                if (slot < 192) {
                    const bf16_t *Qb, *Kh, *Vh, *Gb; bf16_t* Ob; int ldk, seq;
                    if (slot < 64) { const int b = slot >> 5, h = (slot >> 2) & 7, qb = slot & 3, kv = h >> 1; const size_t tok0 = NCTX + b * LS + qb * 256;
                        Qb = P + tok0 * DIN + h * HD; Gb = P + tok0 * DIN + OFF_GA + h * HD; Ob = HM + tok0 * DM + h * HD;
                        Kh = KLl + (size_t)b * KVL * DKV + kv * HD; Vh = VLl + (size_t)b * KVL * DKV + kv * HD; ldk = DKV; seq = KVL; }
                    else { const int u = slot - 64, b = u >> 3, h = u & 7, kv = h >> 1; const size_t tok0 = (size_t)b * CS;
                        Qb = P + tok0 * DIN + h * HD; Gb = P + tok0 * DIN + OFF_GA + h * HD; Ob = HM + tok0 * DM + h * HD;
                        Kh = P + tok0 * DIN + OFF_K + kv * HD; Vh = P + tok0 * DIN + OFF_V + kv * HD; ldk = DIN; seq = CS; }
                    att::attn_body(Qb, DIN, Kh, Vh, ldk, Gb, DIN, Ob, DM, seq, (char*)lds_raw);
                } else if (slot < 256) { const int u = slot - 192; hy::unit<1024>(p, layer, (4 + (u >> 5)) * 1024, u & 31, lds, P, HM, T1024); }
                else if (slot >= 320) { const int u = slot - 320; hy::unit<256>(p, layer, (u >> 5) * 1024, u & 31, lds, P, HM, T256); }
            }
        }
        grid.sync();

        {
            pg8::Gemm g{HM, WoutT + (size_t)layer * DM * DM, NTOK, DM, DM};
            pg8::StaticOrder S; S.init(NTOK, DM, G, bx);
            EpiOutProj E{layer == 0 ? x_prompt : XB, layer == 0 ? x_sample : XB + (size_t)NCTX * DM, XB, modf + (size_t)layer * 3 * 3 * DM};
            pg8::gemm_phase<EpiOutProj, pg8::StaticOrder>(lds, g, S, E);
        }
        grid.sync();
    }

    {
        PHASE_IDS();
        const float* fg = p.in[22];
        for (int row = gw; row < NTOK; row += NGW) {
            const float* xr = XB + (size_t)row * DM;
            f32x4 v[8]; float ss = 0.f;
#pragma unroll
            for (int i = 0; i < 8; ++i) { v[i] = *(const f32x4*)(xr + 4 * lane + 256 * i); ss += (v[i][0] * v[i][0] + v[i][1] * v[i][1]) + (v[i][2] * v[i][2] + v[i][3] * v[i][3]); }
            ss = wave_sum(ss);
            const float rs = rsqrtf(ss * (1.f / DM) + EPS);
#pragma unroll
            for (int i = 0; i < 8; ++i) { const int col = 4 * lane + 256 * i; *(f32x4*)(p.out + (size_t)row * DM + col) = v[i] * rs * *(const f32x4*)(fg + col); }
        }
    }
}

extern "C" void kernel_launch(void* const* d_in, const int* in_sizes, int n_in, void* d_out, int out_size, void* d_ws, size_t ws_size, hipStream_t stream) {
    static int grid = 0;
    if (grid == 0) {
        if (n_in != 23 || ws_size < WS_END) { fprintf(stderr, "kernel_launch: n_in %d ws %zu (need %zu)\n", n_in, ws_size, (size_t)WS_END); grid = -1; return; }
        int dev = 0, cus = 0, per_cu = 0;
        if (hipGetDevice(&dev) != hipSuccess || hipDeviceGetAttribute(&cus, hipDeviceAttributeMultiprocessorCount, dev) != hipSuccess) { grid = -1; return; }
        if (hipFuncSetAttribute((const void*)fwd_megakernel, hipFuncAttributeMaxDynamicSharedMemorySize, LDS_BYTES) != hipSuccess) { fprintf(stderr, "kernel_launch: hipFuncSetAttribute failed\n"); grid = -1; return; }
        if (hipOccupancyMaxActiveBlocksPerMultiprocessor(&per_cu, (const void*)fwd_megakernel, NT, LDS_BYTES) != hipSuccess || per_cu < 1) { fprintf(stderr, "kernel_launch: occupancy query says %d\n", per_cu); grid = -1; return; }
        grid = cus;
    }
    if (grid < 0) return;
    Params prm{};
    for (int i = 0; i < 23; ++i) prm.in[i] = (const float*)d_in[i];
    prm.out = (float*)d_out; prm.ws = (unsigned char*)d_ws;
    void* args[] = {&prm};
    hipError_t e = hipLaunchCooperativeKernel((const void*)fwd_megakernel, dim3(grid), dim3(NT), args, LDS_BYTES, stream);
    if (e != hipSuccess) fprintf(stderr, "cooperative launch failed: %s (grid %d)\n", hipGetErrorString(e), grid);
}
```

```cpp
#include <hip/hip_runtime.h>
#include <hip/hip_cooperative_groups.h>
#include <cstdio>
#include <cstdint>
namespace cg = cooperative_groups;

#define LAS __attribute__((address_space(3)))
typedef unsigned short bf16_t;
typedef short bf16x8 __attribute__((ext_vector_type(8)));
typedef float f32x4 __attribute__((ext_vector_type(4)));
typedef float f32x2 __attribute__((ext_vector_type(2)));
typedef unsigned u32x4 __attribute__((ext_vector_type(4)));
typedef unsigned u32x2 __attribute__((ext_vector_type(2)));

constexpr int DM = 2048, NCTX = 4096, NLAT = 2048, NTOK = 6144, DIN = 7168;
constexpr int CS = 256, LS = 1024, PAST = 512, KVL = LS + PAST;
constexpr int HD = 128, NKV = 4, DHY = 1024, DKV = 512;
constexpr int OFF_K = 1024, OFF_V = 1536, OFF_GA = 2048, OFF_HY = 3072, OFF_GH = 6144;
constexpr float EPS = 1e-6f;
constexpr size_t OUT_NK = (size_t)NTOK * DM, OUT_NV = OUT_NK + (size_t)16 * 2 * CS * DKV;
constexpr int NW = 8, NT = NW * 64;
#define DUP_P0 0
#define DUP_PA 0
#define DUP_PB 0
#define DUP_PC 0
#define DUP_PD 0
#define DUP_ATT 0
#define DUP_HY 0
#define DUP_SYNC 0
constexpr int MODP = 8;

constexpr size_t al256(size_t x) { return (x + 255) / 256 * 256; }
constexpr size_t WS_WIN = 0;
constexpr size_t WS_WOUT = WS_WIN + (size_t)2 * DIN * DM * 2;
constexpr size_t WS_HM = WS_WOUT + (size_t)2 * DM * DM * 2;
constexpr size_t WS_P = WS_HM + (size_t)NTOK * DM * 2;
constexpr size_t WS_KL = WS_P + (size_t)NTOK * DIN * 2;
constexpr size_t WS_VL = WS_KL + (size_t)2 * 2 * KVL * DKV * 2;
constexpr size_t WS_XB = WS_VL + (size_t)2 * 2 * KVL * DKV * 2;
constexpr size_t WS_MODP = WS_XB + (size_t)NTOK * DM * 4;
constexpr size_t WS_MODF = WS_MODP + (size_t)2 * MODP * 3 * 3 * DM * 4;
constexpr size_t WS_T = WS_MODF + (size_t)2 * 3 * 3 * DM * 4;
constexpr size_t T_LAYER = (size_t)DHY * (512 + 2048);
constexpr size_t WS_ROPE = WS_T + 2 * T_LAYER * 2;
constexpr size_t WS_BAR = WS_ROPE + (size_t)LS * 64 * 2 * 4;
constexpr size_t WS_END = WS_BAR + 16384;

constexpr int RING_BYTES = 131072, XCH_OFF = RING_BYTES, MISC_OFF = XCH_OFF + 8192, LDS_BYTES = 147456;

struct Params {
    const float* in[23];
    float* out;
    unsigned char* ws;
};

__device__ __forceinline__ unsigned f2bf(float f) { unsigned u = __builtin_bit_cast(unsigned, f); return (u + 0x7fffu + ((u >> 16) & 1u)) >> 16; }
__device__ __forceinline__ unsigned pk2(float lo, float hi) { return f2bf(lo) | (f2bf(hi) << 16); }
__device__ __forceinline__ float bf2f(unsigned short v) { return __builtin_bit_cast(float, (unsigned)v << 16); }
__device__ __forceinline__ float bflo(unsigned v) { return __builtin_bit_cast(float, v << 16); }
__device__ __forceinline__ float bfhi(unsigned v) { return __builtin_bit_cast(float, v & 0xffff0000u); }
__device__ __forceinline__ float silu_f(float x) { return x * __builtin_amdgcn_rcpf(1.f + __expf(-x)); }
__device__ __forceinline__ unsigned cvt_pk(float lo, float hi) { unsigned r; asm volatile("v_cvt_pk_bf16_f32 %0, %1, %2" : "=v"(r) : "v"(lo), "v"(hi)); return r; }
__device__ __forceinline__ float shx(float v, int m, int lane) { return __builtin_bit_cast(float, __builtin_amdgcn_ds_bpermute((lane ^ m) << 2, __builtin_bit_cast(int, v))); }
__device__ __forceinline__ float wave_sum(float v, int lane) {
#pragma unroll
    for (int o = 1; o < 64; o <<= 1) v += shx(v, o, lane);
    return v;
}
#define LDS_WAIT() asm volatile("s_waitcnt lgkmcnt(0)" ::: "memory")

namespace pg8 {
constexpr int BM = 256, BK = 64, HALF = 128, HTB = HALF * BK * 2, STAGE_BYTES = 8 * HTB, NXCD = 8, WGM = 8;
__host__ __device__ __forceinline__ int lds_byte(int r, int c) { const int st = (r >> 4) * 2 + (c >> 5), rr = r & 15, cc = c & 31, ob = rr * 64 + cc * 2; return st * 1024 + (ob ^ (((ob >> 9) & 1) << 5)); }
__host__ __device__ __forceinline__ void stage_rc(int b, int& R, int& C) { const int st = b / 1024, sb = b % 1024, swz = sb ^ (((sb >> 9) & 1) << 5); R = (st >> 1) * 16 + swz / 64; C = (st & 1) * 32 + (swz % 64) / 2; }
__host__ __device__ __forceinline__ int perm32(int rho) { const int n = rho >> 4, i = rho & 15; return 8 * (i >> 2) + 4 * n + (i & 3); }
struct Unit { int pm, pn; };
struct Gemm { const bf16_t* A; const bf16_t* Bt; int M, N, K; };
struct StaticOrder {
    int nM, nN, nwg, G, c;
    __device__ void init(int M, int N, int G_, int c_) { nM = M / BM; nN = N / BM; nwg = nM * nN; G = G_; c = c_; }
    __device__ bool next(int i, Unit& u) const {
        const long L = (long)i * G + c; if (L >= nwg) return false;
        int wgid = (int)L; { const int q = nwg / NXCD, r = nwg % NXCD, xcd = wgid % NXCD, off = wgid / NXCD; wgid = (xcd < r ? xcd * (q + 1) : r * (q + 1) + (xcd - r) * q) + off; }
        const int nig = WGM * nN, gid = wgid / nig, fm = gid * WGM, gsz = (nM - fm) < WGM ? (nM - fm) : WGM;
        u.pm = fm + ((wgid % nig) % gsz); u.pn = (wgid % nig) / gsz; return true;
    }
};
template <class Epi, class Sched>
__device__ __forceinline__ void gemm_phase(LAS unsigned char* lds, const Gemm g, const Sched& S, const Epi& E) {
    int tid = threadIdx.x; asm volatile("" : "+v"(tid));
    const int wid = __builtin_amdgcn_readfirstlane(tid >> 6), lane = tid & 63, wr = wid >> 2, wc = wid & 3, fr = lane & 15, fq = lane >> 4;
    const int K = g.K, nt = K / BK;
    unsigned voffA[2], voffB[2];
#pragma unroll
    for (int i = 0; i < 2; ++i) { int R, C; stage_rc(tid * 16 + i * 8192, R, C); const int Rb = Epi::PERM ? ((R & ~31) + perm32(R & 31)) : R;
        voffA[i] = (unsigned)(R * K + C) * 2u; voffB[i] = (unsigned)(Rb * K + C) * 2u; }
    const size_t kstep = (size_t)(BK * 2);
    const size_t hstep = (size_t)HALF * K * 2;
    const size_t tstep = 2 * hstep;
    const unsigned ldsw = (unsigned)wid * 1024u;
    const int aoff = lds_byte(wr * 64 + fr, fq * 8), boff = lds_byte(wc * 32 + fr, fq * 8);
#define PG8_SA(b, h) (((b) * 2 + (h)) * HTB)
#define PG8_SB(b, h) ((4 + (b) * 2 + (h)) * HTB)
#define PG8_STAGE(bufoff, gbase, voff) do { _Pragma("unroll") for (int _i = 0; _i < 2; ++_i) \
        __builtin_amdgcn_global_load_lds((const unsigned*)((const char*)(gbase) + (voff)[_i]), (LAS unsigned*)(lds + (bufoff) + ldsw + _i * 8192), 16, 0, 0); } while (0)
#define PG8_LDA(dst, b, h) do { _Pragma("unroll") for (int m = 0; m < 4; ++m) _Pragma("unroll") for (int k = 0; k < 2; ++k) dst[m][k] = *(const LAS bf16x8*)(lds + PG8_SA(b, h) + aoff + m * 2048 + k * 1024); } while (0)
#define PG8_LDB(dst, b, h) do { _Pragma("unroll") for (int n = 0; n < 2; ++n) _Pragma("unroll") for (int k = 0; k < 2; ++k) dst[n][k] = *(const LAS bf16x8*)(lds + PG8_SB(b, h) + boff + n * 2048 + k * 1024); } while (0)
#define PG8_MMA(ai, bj, At, Bt) do { __builtin_amdgcn_s_setprio(1); _Pragma("unroll") for (int m = 0; m < 4; ++m) _Pragma("unroll") for (int n = 0; n < 2; ++n) _Pragma("unroll") for (int k = 0; k < 2; ++k) \
        acc[ai][bj][m][n] = __builtin_amdgcn_mfma_f32_16x16x32_bf16(Bt[n][k], At[m][k], acc[ai][bj][m][n], 0, 0, 0); __builtin_amdgcn_s_setprio(0); } while (0)
#define PG8_WAIT_V(n) asm volatile("s_waitcnt vmcnt(" #n ")" ::: "memory")
#define PG8_WAIT_L(n) asm volatile("s_waitcnt lgkmcnt(" #n ")" ::: "memory")
#define PG8_BAR __builtin_amdgcn_s_barrier()
#define PG8_SCHED __builtin_amdgcn_sched_barrier(0)
    Unit cur, nxt; int ui = 0;
    if (!S.next(0, cur)) return;
    f32x4 acc[2][2][4][2];
#pragma unroll
    for (int a = 0; a < 2; ++a)
#pragma unroll
        for (int b = 0; b < 2; ++b)
#pragma unroll
            for (int m = 0; m < 4; ++m)
#pragma unroll
                for (int n = 0; n < 2; ++n) acc[a][b][m][n] = (f32x4){0.f, 0.f, 0.f, 0.f};
    bf16x8 At[4][2], B0[2][2], B1[2][2];
    const char* cA = (const char*)g.A + (size_t)cur.pm * tstep; const char* cB = (const char*)g.Bt + (size_t)cur.pn * tstep;
    PG8_STAGE(PG8_SB(0, 0), cB, voffB); PG8_STAGE(PG8_SB(0, 1), cB + hstep, voffB); PG8_STAGE(PG8_SA(0, 0), cA, voffA); PG8_STAGE(PG8_SA(0, 1), cA + hstep, voffA);
    if (wr == 1) PG8_BAR;
    PG8_WAIT_V(2); PG8_BAR;
    PG8_STAGE(PG8_SB(1, 0), cB + kstep, voffB); PG8_STAGE(PG8_SA(1, 0), cA + kstep, voffA); PG8_STAGE(PG8_SB(1, 1), cB + hstep + kstep, voffB);
    PG8_WAIT_V(6); PG8_BAR;
    for (;;) {
        const bool has_next = S.next(ui + 1, nxt);
        const char* nA = has_next ? (const char*)g.A + (size_t)nxt.pm * tstep : cA; const char* nB = has_next ? (const char*)g.Bt + (size_t)nxt.pn * tstep : cB;
        for (int t = 0; t < nt; t += 2) {
            const bool last = (t == nt - 2);
            const char* a1 = cA + (size_t)(t + 1) * kstep;
            const char* a2 = last ? nA : cA + (size_t)(t + 2) * kstep; const char* b2 = last ? nB : cB + (size_t)(t + 2) * kstep;
            const char* a3 = a2 + kstep; const char* b3 = b2 + kstep;
            PG8_LDB(B0, 0, 0); PG8_LDB(B1, 0, 1); PG8_SCHED; PG8_LDA(At, 0, 0); PG8_STAGE(PG8_SA(1, 1), a1 + hstep, voffA);
            PG8_WAIT_V(8); PG8_WAIT_L(0); PG8_BAR; PG8_MMA(0, 0, At, B0); PG8_MMA(0, 1, At, B1); PG8_BAR; PG8_SCHED;
            PG8_LDA(At, 0, 1); PG8_STAGE(PG8_SB(0, 0), b2, voffB); PG8_STAGE(PG8_SB(0, 1), b2 + hstep, voffB); PG8_STAGE(PG8_SA(0, 0), a2, voffA);
            PG8_WAIT_V(8); PG8_WAIT_L(0); PG8_BAR; PG8_MMA(1, 0, At, B0); PG8_MMA(1, 1, At, B1); PG8_BAR; PG8_SCHED;
            PG8_LDB(B0, 1, 0); PG8_LDB(B1, 1, 1); PG8_SCHED; PG8_LDA(At, 1, 0); PG8_STAGE(PG8_SA(0, 1), a2 + hstep, voffA);
            PG8_WAIT_V(8); PG8_WAIT_L(0); PG8_BAR; PG8_MMA(0, 0, At, B0); PG8_MMA(0, 1, At, B1); PG8_BAR; PG8_SCHED;
            PG8_LDA(At, 1, 1); PG8_STAGE(PG8_SB(1, 0), b3, voffB); PG8_STAGE(PG8_SB(1, 1), b3 + hstep, voffB); PG8_STAGE(PG8_SA(1, 0), a3, voffA);
            PG8_WAIT_V(8); PG8_WAIT_L(0); PG8_BAR; PG8_MMA(1, 0, At, B0); PG8_MMA(1, 1, At, B1); PG8_BAR; PG8_SCHED;
        }
        if (wr == 0) PG8_BAR;
        E(acc, cur, wr, wc, fr, fq);
        if (!has_next) break;
#pragma unroll
        for (int a = 0; a < 2; ++a)
#pragma unroll
            for (int b = 0; b < 2; ++b)
#pragma unroll
                for (int m = 0; m < 4; ++m)
#pragma unroll
                    for (int n = 0; n < 2; ++n) acc[a][b][m][n] = (f32x4){0.f, 0.f, 0.f, 0.f};
        cur = nxt; cA = nA; cB = nB; ++ui;
        if (wr == 1) PG8_BAR;
    }
    PG8_WAIT_V(0);
    PG8_BAR;
#undef PG8_SA
#undef PG8_SB
#undef PG8_STAGE
#undef PG8_LDA
#undef PG8_LDB
#undef PG8_MMA
#undef PG8_WAIT_V
#undef PG8_WAIT_L
#undef PG8_BAR
#undef PG8_SCHED
}
}

struct EpiInProj {
    static constexpr bool PERM = true;
    bf16_t* P; bf16_t* KLl; bf16_t* VLl;
    float* out; const float* qg; const float* kg; const float* rope; LAS float* xch; int layer;
    __device__ __forceinline__ void operator()(f32x4 (&acc)[2][2][4][2], const pg8::Unit& u, int wr, int wc, int fr, int fq) const {
        const int pn = u.pn, pm = u.pm;
        const bool lat = pm >= 16;
        asm volatile("" : "+v"(fr), "+v"(fq));
        const int rl0 = wr * 64 + fr, cl0 = wc * 32 + 8 * fq;
        if (pn < 6) {
#pragma unroll
            for (int ai = 0; ai < 2; ++ai)
#pragma unroll
                for (int m = 0; m < 4; ++m)
#pragma unroll
                    for (int bj = 0; bj < 2; ++bj) {
                        const f32x4 a = acc[ai][bj][m][0], b = acc[ai][bj][m][1];
                        float s = (a[0] * a[0] + a[1] * a[1]) + (a[2] * a[2] + a[3] * a[3]) + (b[0] * b[0] + b[1] * b[1]) + (b[2] * b[2] + b[3] * b[3]);
                        s += shx(s, 16, fq * 16 + fr); s += shx(s, 32, fq * 16 + fr);
                        if (fq == 0) xch[((ai * 128 + rl0 + m * 16) * 2 + bj) * 4 + wc] = s;
                    }
            LDS_WAIT(); __builtin_amdgcn_s_barrier(); asm volatile("" ::: "memory");
            const float* gsrc = (pn < 4) ? qg : kg;
            const f32x4 g0 = *(const f32x4*)(gsrc + cl0), g1 = *(const f32x4*)(gsrc + cl0 + 4);
#pragma unroll
            for (int ai = 0; ai < 2; ++ai)
#pragma unroll
                for (int m = 0; m < 4; ++m) {
                    const int rl = ai * 128 + rl0 + m * 16, row = pm * 256 + rl;
#pragma unroll
                    for (int bj = 0; bj < 2; ++bj) {
                        const f32x4 pp = *(const LAS f32x4*)(xch + (rl * 2 + bj) * 4);
                        const float rs = rsqrtf(((pp[0] + pp[1]) + (pp[2] + pp[3])) * (1.f / HD) + EPS);
                        f32x4 v0 = acc[ai][bj][m][0] * rs * g0, v1 = acc[ai][bj][m][1] * rs * g1;
                        if (lat) {
                            const int t = (row - NCTX) & (LS - 1);
                            const f32x4 c0 = *(const f32x4*)(rope + ((size_t)t * 64 + (cl0 >> 1)) * 2), c1 = *(const f32x4*)(rope + ((size_t)t * 64 + (cl0 >> 1) + 2) * 2);
                            f32x4 w0, w1;
                            w0[0] = v0[0] * c0[0] - v0[1] * c0[1]; w0[1] = v0[0] * c0[1] + v0[1] * c0[0]; w0[2] = v0[2] * c0[2] - v0[3] * c0[3]; w0[3] = v0[2] * c0[3] + v0[3] * c0[2];
                            w1[0] = v1[0] * c1[0] - v1[1] * c1[1]; w1[1] = v1[0] * c1[1] + v1[1] * c1[0]; w1[2] = v1[2] * c1[2] - v1[3] * c1[3]; w1[3] = v1[2] * c1[3] + v1[3] * c1[2];
                            v0 = w0; v1 = w1;
                        }
                        u32x4 w; w.x = cvt_pk(v0[0], v0[1]); w.y = cvt_pk(v0[2], v0[3]); w.z = cvt_pk(v1[0], v1[1]); w.w = cvt_pk(v1[2], v1[3]);
                        const int col = pn * 256 + bj * 128 + cl0;
                        if (pn < 4 || !lat) *(u32x4*)(P + (size_t)row * DIN + col) = w;
                        if (pn >= 4) {
                            const int kc = col - OFF_K;
                            if (!lat) { float* o = out + OUT_NK + ((size_t)(pm * 2 + layer) * CS + rl) * DKV + kc; *(f32x4*)o = v0; *(f32x4*)(o + 4) = v1; }
                            else { const int b = (pm - 16) >> 2, t = ((pm - 16) & 3) * 256 + rl; *(u32x4*)(KLl + ((size_t)b * KVL + t) * DKV + kc) = w; }
                        }
                    }
                    asm volatile("" ::: "memory");
                }
        } else {
            const bool is_v = pn < 8, act = (pn >= 8 && pn < 12) || pn >= 24;
#pragma unroll
            for (int ai = 0; ai < 2; ++ai)
#pragma unroll
                for (int m = 0; m < 4; ++m) {
                    const int rl = ai * 128 + rl0 + m * 16, row = pm * 256 + rl;
#pragma unroll
                    for (int bj = 0; bj < 2; ++bj) {
                        f32x4 v0 = acc[ai][bj][m][0], v1 = acc[ai][bj][m][1];
                        if (act) {
#pragma unroll
                            for (int e = 0; e < 4; ++e) { v0[e] = silu_f(v0[e]); v1[e] = silu_f(v1[e]); }
                        }
                        u32x4 w; w.x = cvt_pk(v0[0], v0[1]); w.y = cvt_pk(v0[2], v0[3]); w.z = cvt_pk(v1[0], v1[1]); w.w = cvt_pk(v1[2], v1[3]);
                        const int col = pn * 256 + bj * 128 + cl0;
                        if (!is_v || !lat) *(u32x4*)(P + (size_t)row * DIN + col) = w;
                        if (is_v) {
                            const int vc = col - OFF_V;
                            if (!lat) { float* o = out + OUT_NV + ((size_t)(pm * 2 + layer) * CS + rl) * DKV + vc; *(f32x4*)o = v0; *(f32x4*)(o + 4) = v1; }
                            else { const int b = (pm - 16) >> 2, t = ((pm - 16) & 3) * 256 + rl; *(u32x4*)(VLl + ((size_t)b * KVL + t) * DKV + vc) = w; }
                        }
                    }
                    asm volatile("" ::: "memory");
                }
        }
    }
};
struct EpiOutProj {
    static constexpr bool PERM = true;
    const float* xc; const float* xl; float* xo; const float* modf;
    __device__ __forceinline__ void operator()(f32x4 (&acc)[2][2][4][2], const pg8::Unit& u, int wr, int wc, int fr, int fq) const {
        const int pn = u.pn, pm = u.pm;
        const bool lat = pm >= 16;
        const int j = lat ? 1 + ((pm - 16) >> 2) : 0;
        const float* gate = modf + (size_t)j * 3 * DM + 2 * DM;
        const float* xin = lat ? xl - (size_t)NCTX * DM : xc;
        asm volatile("" : "+v"(fr), "+v"(fq));
        const int rl0 = wr * 64 + fr, cl0 = wc * 32 + 8 * fq;
#pragma unroll
        for (int bj = 0; bj < 2; ++bj) {
            const int col = pn * 256 + bj * 128 + cl0;
            const f32x4 g0 = *(const f32x4*)(gate + col), g1 = *(const f32x4*)(gate + col + 4);
#pragma unroll
            for (int ai = 0; ai < 2; ++ai)
#pragma unroll
                for (int m = 0; m < 4; ++m) {
                    const size_t off = (size_t)(pm * 256 + ai * 128 + rl0 + m * 16) * DM + col;
                    const f32x4 x0 = *(const f32x4*)(xin + off), x1 = *(const f32x4*)(xin + off + 4);
                    *(f32x4*)(xo + off) = x0 + g0 * acc[ai][bj][m][0]; *(f32x4*)(xo + off + 4) = x1 + g1 * acc[ai][bj][m][1];
                }
        }
    }
};

__device__ __forceinline__ void p0_transpose_item(const float* W, int K, int N, bf16_t* WT, LAS float* scr, int item, int lane) {
    const int nblk = N / 32, kb = item / nblk, nb = item % nblk, k0 = 64 * kb, n0 = 32 * nb;
#pragma unroll 8
    for (int i = 0; i < 32; ++i) { const int kk = 2 * i + (lane >> 5); scr[kk * 33 + (lane & 31)] = W[(size_t)(k0 + kk) * N + n0 + (lane & 31)]; }
    LDS_WAIT();
    const int c = lane & 7;
#pragma unroll
    for (int j = 0; j < 4; ++j) { const int n = (lane >> 3) + 8 * j; const LAS float* s = scr + (8 * c) * 33 + n;
        u32x4 o; o.x = pk2(s[0 * 33], s[1 * 33]); o.y = pk2(s[2 * 33], s[3 * 33]); o.z = pk2(s[4 * 33], s[5 * 33]); o.w = pk2(s[6 * 33], s[7 * 33]);
        *(u32x4*)(WT + (size_t)(n0 + n) * K + k0 + 8 * c) = o; }
    LDS_WAIT();
}

template <int DIR>
__device__ __forceinline__ void filter_item(const Params& p, int l, int L, int ci, bf16_t* T, LAS float* scr) {
    int tid = threadIdx.x; asm volatile("" : "+v"(tid));
    const float* w1 = p.in[14] + l * 33 * 64; const float* b1 = p.in[15] + l * 64; const float* w2 = p.in[16] + l * 64 * 64; const float* b2 = p.in[17] + l * 64;
    const float* w3 = p.in[18] + (size_t)l * 64 * 2048; const float* freq = p.in[19] + l * 64;
    LAS float* zf = scr;
    LAS float* h1 = scr + 32 * 33;
    LAS float* h2t = h1 + 32 * 64;
    const int tbase = DIR == 0 ? 1 + 32 * ci : 32 * ci;
    for (int idx = tid; idx < 32 * 33; idx += NT) {
        const int tt = idx / 33, f = idx % 33; const float t = (float)(tbase + tt);
        const float t_norm = t / (float)(L - 1), w = 2.0f * 3.14159265358979323846f * t / (float)L;
        float v;
        if (f == 0) v = t_norm;
        else { const int i = (f - 1) & 15; const float band = 1e-4f + (float)i * ((15.f - 1e-4f) / 15.f); v = f <= 16 ? cosf(w * band) : -sinf(w * band); }
        zf[idx] = v;
    }
    __syncthreads();
    for (int idx = tid; idx < 32 * 64; idx += NT) {
        const int tt = idx >> 6, j = idx & 63; float a = b1[j];
        for (int f = 0; f < 33; ++f) a += zf[tt * 33 + f] * w1[f * 64 + j];
        h1[idx] = sinf(freq[j] * a);
    }
    __syncthreads();
    for (int idx = tid; idx < 32 * 64; idx += NT) {
        const int tt = idx >> 6, j = idx & 63; float a = b2[j];
        for (int i = 0; i < 64; ++i) a += h1[tt * 64 + i] * w2[i * 64 + j];
        h2t[j * 32 + tt] = sinf(freq[j] * a);
    }
    __syncthreads();
    const int c = tid * 2;
    float acc0[32], acc1[32];
#pragma unroll
    for (int tt = 0; tt < 32; ++tt) { acc0[tt] = 0.f; acc1[tt] = 0.f; }
    float e0 = 0.f, e1 = 0.f;
    const bool extra = (DIR == 1 && ci == 0);
    for (int j = 0; j < 64; ++j) {
        const f32x2 wv = *(const f32x2*)(w3 + (size_t)j * 2048 + DIR * 1024 + c);
#pragma unroll
        for (int q = 0; q < 8; ++q) {
            const f32x4 hv = *(const LAS f32x4*)(h2t + j * 32 + q * 4);
#pragma unroll
            for (int e = 0; e < 4; ++e) { acc0[q * 4 + e] += hv[e] * wv[0]; acc1[q * 4 + e] += hv[e] * wv[1]; }
        }
        if (extra) { const f32x2 wf = *(const f32x2*)(w3 + (size_t)j * 2048 + c); const float h0 = h2t[j * 32]; e0 += h0 * wf[0]; e1 += h0 * wf[1]; }
    }
    const float max_decay = logf(1e-2f) / 0.3f, min_decay = logf(1e-2f) / 1.5f;
    const float d0 = fabsf(min_decay + (float)c * ((max_decay - min_decay) / 1023.f)), d1 = fabsf(min_decay + (float)(c + 1) * ((max_decay - min_decay) / 1023.f));
#pragma unroll
    for (int tt = 0; tt < 32; ++tt) {
        const int t = tbase + tt; const float t_norm = (float)t / (float)(L - 1);
        float v0 = acc0[tt] * (__expf(-t_norm * d0) + 0.05f), v1 = acc1[tt] * (__expf(-t_norm * d1) + 0.05f);
        if (DIR == 0 && t >= L) { v0 = 0.f; v1 = 0.f; }
        if (extra && tt == 0) { v0 += e0 * 1.05f + p.in[20][l * DHY + c]; v1 += e1 * 1.05f + p.in[20][l * DHY + c + 1]; }
        acc0[tt] = v0; acc1[tt] = v1;
    }
    const int n0 = DIR == 0 ? L - 32 - 32 * ci : L + 32 * ci;
    bf16_t* r0 = T + (size_t)c * (2 * L) + n0; bf16_t* r1 = r0 + 2 * L;
#pragma unroll
    for (int q = 0; q < 4; ++q) {
        u32x4 a, b;
        if (DIR == 0) {
            a.x = pk2(acc0[31 - (8 * q + 0)], acc0[31 - (8 * q + 1)]); a.y = pk2(acc0[31 - (8 * q + 2)], acc0[31 - (8 * q + 3)]); a.z = pk2(acc0[31 - (8 * q + 4)], acc0[31 - (8 * q + 5)]); a.w = pk2(acc0[31 - (8 * q + 6)], acc0[31 - (8 * q + 7)]);
            b.x = pk2(acc1[31 - (8 * q + 0)], acc1[31 - (8 * q + 1)]); b.y = pk2(acc1[31 - (8 * q + 2)], acc1[31 - (8 * q + 3)]); b.z = pk2(acc1[31 - (8 * q + 4)], acc1[31 - (8 * q + 5)]); b.w = pk2(acc1[31 - (8 * q + 6)], acc1[31 - (8 * q + 7)]);
        } else {
            a.x = pk2(acc0[8 * q + 0], acc0[8 * q + 1]); a.y = pk2(acc0[8 * q + 2], acc0[8 * q + 3]); a.z = pk2(acc0[8 * q + 4], acc0[8 * q + 5]); a.w = pk2(acc0[8 * q + 6], acc0[8 * q + 7]);
            b.x = pk2(acc1[8 * q + 0], acc1[8 * q + 1]); b.y = pk2(acc1[8 * q + 2], acc1[8 * q + 3]); b.z = pk2(acc1[8 * q + 4], acc1[8 * q + 5]); b.w = pk2(acc1[8 * q + 6], acc1[8 * q + 7]);
        }
        *(u32x4*)(r0 + 8 * q) = a; *(u32x4*)(r1 + 8 * q) = b;
    }
    __syncthreads();
}

namespace att {
using s16x4 = __attribute__((ext_vector_type(4))) short;
using f32x16 = __attribute__((ext_vector_type(16))) float;
constexpr int D = 128, QBLK = 32, KVBLK = 64;
constexpr float SCALE = 0.088388347648318440f, THR = 8.f;
constexpr size_t SHM_V = KVBLK * D * 2, SHM_K = KVBLK * D * 2, SHM_ATTN = 2 * SHM_V + 2 * SHM_K + NW * 64 * 4;
#define KSWZ(row, colB) ((row) * 256 + ((colB) ^ (((row) & 7) << 4)))
#define SBAR() __builtin_amdgcn_sched_barrier(0)
__device__ __forceinline__ int crow(int r, int hi) { return (r & 3) + 8 * (r >> 2) + 4 * hi; }
__device__ __forceinline__ void partialSM(f32x16& p0, f32x16& p1, float& m_reg, float& mn, float& alpha) {
  constexpr float C = SCALE * 1.4426950408889634f;
  float pmax = p0[0];
#pragma unroll
  for (int r = 1; r < 16; ++r) pmax = fmaxf(pmax, p0[r]);
#pragma unroll
  for (int r = 0; r < 16; ++r) pmax = fmaxf(pmax, p1[r]);
  { auto rr = __builtin_amdgcn_permlane32_swap(__float_as_uint(pmax), __float_as_uint(pmax), false, false);
    pmax = fmaxf(__uint_as_float(rr[0]), __uint_as_float(rr[1])); }
  if (__builtin_expect(__all(pmax - m_reg <= THR / SCALE), 1)) { mn = m_reg; alpha = 1.f; }
  else { mn = fmaxf(m_reg, pmax); alpha = __builtin_amdgcn_exp2f((m_reg - mn) * C); m_reg = mn; }
  float mnC = -mn * C;
#pragma unroll
  for (int r = 0; r < 16; ++r) p0[r] = fmaf(p0[r], C, mnC);
#pragma unroll
  for (int r = 0; r < 16; ++r) p1[r] = fmaf(p1[r], C, mnC);
#pragma unroll
  for (int r = 0; r < 16; ++r) p0[r] = __builtin_amdgcn_exp2f(p0[r]);
}
__device__ __forceinline__ void finishSM(f32x16& p0, f32x16& p1, float alpha, float& l_reg, bf16x8& pa0, bf16x8& pa1, bf16x8& pa2, bf16x8& pa3) {
#pragma unroll
  for (int r = 0; r < 16; ++r) p1[r] = __builtin_amdgcn_exp2f(p1[r]);
  float ps = 0;
#pragma unroll
  for (int r = 0; r < 16; ++r) ps += p0[r];
#pragma unroll
  for (int r = 0; r < 16; ++r) ps += p1[r];
  { auto rr = __builtin_amdgcn_permlane32_swap(__float_as_uint(ps), __float_as_uint(ps), false, false);
    ps = __uint_as_float(rr[0]) + __uint_as_float(rr[1]); }
  l_reg = l_reg * alpha + ps;
#define PK4(P, BASE, OUT) do { unsigned a0 = cvt_pk(P[BASE + 0], P[BASE + 1]), a1 = cvt_pk(P[BASE + 2], P[BASE + 3]);   \
    unsigned b0 = cvt_pk(P[BASE + 4], P[BASE + 5]), b1 = cvt_pk(P[BASE + 6], P[BASE + 7]);                              \
    auto r0 = __builtin_amdgcn_permlane32_swap(a0, b0, false, false); auto r1 = __builtin_amdgcn_permlane32_swap(a1, b1, false, false); \
    u32x4 w = {r0[0], r1[0], r0[1], r1[1]}; OUT = *reinterpret_cast<bf16x8*>(&w); } while (0)
  PK4(p0, 0, pa0); PK4(p0, 8, pa1); PK4(p1, 0, pa2); PK4(p1, 8, pa3);
#undef PK4
}
__device__ __forceinline__ void qkt(f32x16& p0, f32x16& p1, const bf16_t* Ks, const bf16x8* qr, int r32, int hi) {
  p0 = f32x16{}; p1 = f32x16{};
#pragma unroll
  for (int d0 = 0; d0 < 8; ++d0) { int cb = (d0 * 16 + hi * 8) * 2;
    bf16x8 b0 = *reinterpret_cast<const bf16x8*>((const char*)Ks + KSWZ(r32, cb));
    bf16x8 b1 = *reinterpret_cast<const bf16x8*>((const char*)Ks + KSWZ(32 + r32, cb));
    p0 = __builtin_amdgcn_mfma_f32_32x32x16_bf16(b0, qr[d0], p0, 0, 0, 0);
    p1 = __builtin_amdgcn_mfma_f32_32x32x16_bf16(b1, qr[d0], p1, 0, 0, 0); }
}
__device__ __forceinline__ int v_st(int k, int c) { const int kk = (k & ~0xC) | ((k & 4) << 1) | ((k & 8) >> 1); return ((kk >> 3) * 4 + (c >> 5)) * 512 + ((kk & 7) * 32 + (c & 31)) * 2; }
__device__ __forceinline__ int v_rd_base(int lane) { return ((lane & 3) << 3) | (((lane >> 2) & 3) << 6) | (((lane >> 4) & 1) << 5) | (((lane >> 5) & 1) << 8); }
constexpr int v_rd_off(int d0, int ks, int half) { return d0 * 512 + ks * 4096 + half * 2048; }
template <int OFF> __device__ __forceinline__ s16x4 tr_read(int vb) {
  s16x4 r; asm volatile("ds_read_b64_tr_b16 %0, %1 offset:%2" : "=&v"(r) : "v"(vb), "i"(OFF) : "memory"); return r;
}
template <int D0> __device__ __forceinline__ void pv_one(f32x16& od, int vb, bf16x8 pa0, bf16x8 pa1, bf16x8 pa2, bf16x8 pa3) {
  const s16x4 l0 = tr_read<v_rd_off(D0, 0, 0)>(vb), h0 = tr_read<v_rd_off(D0, 0, 1)>(vb), l1 = tr_read<v_rd_off(D0, 1, 0)>(vb), h1 = tr_read<v_rd_off(D0, 1, 1)>(vb);
  const s16x4 l2 = tr_read<v_rd_off(D0, 2, 0)>(vb), h2 = tr_read<v_rd_off(D0, 2, 1)>(vb), l3 = tr_read<v_rd_off(D0, 3, 0)>(vb), h3 = tr_read<v_rd_off(D0, 3, 1)>(vb);
  asm volatile("s_waitcnt lgkmcnt(0)" ::: "memory"); SBAR();
#define PK(L, H) (bf16x8){L[0], L[1], L[2], L[3], H[0], H[1], H[2], H[3]}
  od = __builtin_amdgcn_mfma_f32_32x32x16_bf16(pa0, PK(l0, h0), od, 0, 0, 0);
  od = __builtin_amdgcn_mfma_f32_32x32x16_bf16(pa1, PK(l1, h1), od, 0, 0, 0);
  od = __builtin_amdgcn_mfma_f32_32x32x16_bf16(pa2, PK(l2, h2), od, 0, 0, 0);
  od = __builtin_amdgcn_mfma_f32_32x32x16_bf16(pa3, PK(l3, h3), od, 0, 0, 0);
#undef PK
}
__device__ __forceinline__ void pv_d0(f32x16* o, int vb, bf16x8 pa0, bf16x8 pa1, bf16x8 pa2, bf16x8 pa3) {
  pv_one<0>(o[0], vb, pa0, pa1, pa2, pa3); pv_one<1>(o[1], vb, pa0, pa1, pa2, pa3); pv_one<2>(o[2], vb, pa0, pa1, pa2, pa3); pv_one<3>(o[3], vb, pa0, pa1, pa2, pa3);
}
__device__ __forceinline__ void attn_body(const bf16_t* __restrict__ Qb, int ldq, const bf16_t* __restrict__ Kh, const bf16_t* __restrict__ Vh, int ldk,
                                          const bf16_t* __restrict__ Gb, int ldg, bf16_t* __restrict__ Ob, int ldo, int seq, char* lds) {
  int tid = threadIdx.x; asm volatile("" : "+v"(tid));
  const int wid = tid >> 6, lane = tid & 63, r32 = lane & 31, hi = lane >> 5;
  bf16_t* V_lds = (bf16_t*)lds; bf16_t* K_lds = (bf16_t*)(lds + 2 * SHM_V);
  float* wsf = (float*)(lds + 2 * SHM_V + 2 * SHM_K) + wid * 64; float* li_l = wsf; float* al_l = wsf + 32;
  float m_reg = -1e30f, l_reg = 0; f32x16 o[4] = {}; bf16x8 qr[8];
  const bf16_t* Qw = Qb + (long)(wid * QBLK + r32) * ldq + hi * 8;
#pragma unroll
  for (int d0 = 0; d0 < 8; ++d0) qr[d0] = *reinterpret_cast<const bf16x8*>(Qw + d0 * 16);
  const int sr = tid >> 4, sc = (tid & 15) * 8, vst0 = v_st(sr, sc), vst1 = v_st(32 + sr, sc);
  const int vb0 = (int)(uintptr_t)V_lds + v_rd_base(lane);
  struct { bf16x8 vs0, vs1, ks0, ks1; } sr_[2];
  const unsigned kvoff0 = (unsigned)(sr * ldk + sc) * 2u, kvoff1 = kvoff0 + (unsigned)(64 * ldk);
#define SLOAD(i, k0) do { const char* vb_ = (const char*)Vh + (size_t)(k0) * ldk * 2; const char* kb_ = (const char*)Kh + (size_t)(k0) * ldk * 2; \
    sr_[i].vs0 = *reinterpret_cast<const bf16x8*>(vb_ + kvoff0); sr_[i].vs1 = *reinterpret_cast<const bf16x8*>(vb_ + kvoff1); \
    sr_[i].ks0 = *reinterpret_cast<const bf16x8*>(kb_ + kvoff0); sr_[i].ks1 = *reinterpret_cast<const bf16x8*>(kb_ + kvoff1); } while (0)
#define SWRITE(b, i) do { *(bf16x8*)((char*)V_lds + (b) * SHM_V + vst0) = sr_[i].vs0;          \
    *(bf16x8*)((char*)V_lds + (b) * SHM_V + vst1) = sr_[i].vs1; int kc = sc * 2;               \
    *(bf16x8*)((char*)K_lds + (b) * SHM_K + KSWZ(sr, kc)) = sr_[i].ks0;                       \
    *(bf16x8*)((char*)K_lds + (b) * SHM_K + KSWZ(32 + sr, kc)) = sr_[i].ks1; } while (0)
#define SWAIT() asm volatile("s_waitcnt vmcnt(4)" ::: "memory")
#define RESC(a) do { if (__any((a) < 1.f)) { if (hi == 0) al_l[r32] = (a); asm volatile("s_waitcnt lgkmcnt(0)" ::: "memory"); \
    _Pragma("unroll") for (int d = 0; d < 4; ++d) _Pragma("unroll") for (int r = 0; r < 16; ++r) o[d][r] *= al_l[crow(r, hi)]; } } while (0)
  f32x16 pA0, pA1, pB0, pB1; float mnA, mnB, alA, alB; bf16x8 pa0, pa1, pa2, pa3; const int NTL = seq / KVBLK;
  constexpr int SE = 0, SO = 1;
  SLOAD(SE, 0); asm volatile("s_waitcnt vmcnt(0)" ::: "memory"); SWRITE(0, SE); __syncthreads();
  qkt(pA0, pA1, K_lds, qr, r32, hi); partialSM(pA0, pA1, m_reg, mnA, alA);
  SLOAD(SO, KVBLK); if (2 < NTL) SLOAD(SE, 2 * KVBLK);
  SWAIT(); SWRITE(1, SO); __syncthreads();
  for (int j = 1; j + 1 < NTL; j += 2) {
    SBAR(); qkt(pB0, pB1, (bf16_t*)((char*)K_lds + SHM_K), qr, r32, hi);
    finishSM(pA0, pA1, alA, l_reg, pa0, pa1, pa2, pa3); SBAR();
    SLOAD(SO, (j + 2) * KVBLK); SBAR();
    pv_d0(o, vb0, pa0, pa1, pa2, pa3); partialSM(pB0, pB1, m_reg, mnB, alB);
    __syncthreads(); SWAIT(); SWRITE(0, SE);
    RESC(alB); __syncthreads();
    SBAR(); qkt(pA0, pA1, K_lds, qr, r32, hi);
    finishSM(pB0, pB1, alB, l_reg, pa0, pa1, pa2, pa3); SBAR();
    if (j + 3 < NTL) SLOAD(SE, (j + 3) * KVBLK); SBAR();
    pv_d0(o, vb0 + (int)SHM_V, pa0, pa1, pa2, pa3); partialSM(pA0, pA1, m_reg, mnA, alA);
    __syncthreads(); SWAIT(); SWRITE(1, SO);
    RESC(alA); __syncthreads();
  }
  SBAR(); qkt(pB0, pB1, (bf16_t*)((char*)K_lds + SHM_K), qr, r32, hi);
  finishSM(pA0, pA1, alA, l_reg, pa0, pa1, pa2, pa3); SBAR();
  pv_d0(o, vb0, pa0, pa1, pa2, pa3); partialSM(pB0, pB1, m_reg, mnB, alB);
  __syncthreads(); RESC(alB);
  finishSM(pB0, pB1, alB, l_reg, pa0, pa1, pa2, pa3); SBAR();
  pv_d0(o, vb0 + (int)SHM_V, pa0, pa1, pa2, pa3);
  if (hi == 0) li_l[r32] = l_reg; asm volatile("s_waitcnt lgkmcnt(0)" ::: "memory");
  float rli[16];
#pragma unroll
  for (int r = 0; r < 16; ++r) rli[r] = __builtin_amdgcn_rcpf(li_l[crow(r, hi)]);
  bf16_t* Ow = Ob + (long)(wid * QBLK) * ldo; const bf16_t* Gw = Gb + (long)(wid * QBLK) * ldg;
#pragma unroll
  for (int r = 0; r < 16; ++r) { const int orow = crow(r, hi);
#pragma unroll
    for (int d0 = 0; d0 < 4; ++d0) Ow[(long)orow * ldo + d0 * 32 + r32] = (bf16_t)f2bf(o[d0][r] * rli[r] * bf2f(Gw[(long)orow * ldg + d0 * 32 + r32])); }
  __syncthreads();
#undef SLOAD
#undef SWRITE
#undef SWAIT
#undef RESC
}
#undef KSWZ
#undef SBAR
}

namespace hy {
using f32x16 = __attribute__((ext_vector_type(16))) float;
constexpr int Z_OFF = 0, T_OFF = 65536, TW = 8448, ZERO_OFF = T_OFF + 8 * TW;
template <int L>
__device__ __forceinline__ void unit(const Params& p, int layer, int base, int cg, LAS unsigned char* lds, const bf16_t* P, bf16_t* HM, const bf16_t* Tl) {
    constexpr int NB = L / 32, NP = L / 256, C1OFF = 4 * L + 68;
    int tid = threadIdx.x; asm volatile("" : "+v"(tid));
    const int lane = tid & 63, wave = __builtin_amdgcn_readfirstlane(tid >> 6);
    const float* cw = p.in[12] + (size_t)layer * 3 * 3072; const float* cb = p.in[13] + layer * 3072;
    {
        const int q = tid >> 2, oct = tid & 3, n = q >> 2, c = q & 3, T0 = n * 32 + c * 8, ch0 = cg * 32 + oct * 8;
        if (tid < 16) *(LAS unsigned*)(lds + ZERO_OFF + tid * 4) = 0u;
        const bf16_t* src = P + (size_t)(base + T0) * DIN + OFF_HY + ch0;
        const bool has_prev = (T0 & (L - 1)) != 0, has_next = ((T0 + 8) & (L - 1)) != 0;
        u32x4 r1[10], r2[10];
#pragma unroll
        for (int j = 0; j < 10; ++j) {
            const bool ok = (j == 0) ? has_prev : (j == 9 ? has_next : true);
            if (ok) { r1[j] = *(const u32x4*)(src + (long)(j - 1) * DIN + DHY); r2[j] = *(const u32x4*)(src + (long)(j - 1) * DIN + 2 * DHY); }
            else { r1[j] = (u32x4){0u, 0u, 0u, 0u}; r2[j] = (u32x4){0u, 0u, 0u, 0u}; }
        }
#pragma unroll
        for (int cc = 0; cc < 8; ++cc) {
            const int ch = ch0 + cc;
            const float w10 = cw[DHY + ch], w11 = cw[3072 + DHY + ch], w12 = cw[2 * 3072 + DHY + ch], b1 = cb[DHY + ch];
            const float w20 = cw[2 * DHY + ch], w21 = cw[3072 + 2 * DHY + ch], w22 = cw[2 * 3072 + 2 * DHY + ch], b2 = cb[2 * DHY + ch];
            float x1[10], x2[10];
#pragma unroll
            for (int j = 0; j < 10; ++j) { const unsigned a = r1[j][cc >> 1], b = r2[j][cc >> 1]; x1[j] = (cc & 1) ? bfhi(a) : bflo(a); x2[j] = (cc & 1) ? bfhi(b) : bflo(b); }
            float z[8];
#pragma unroll
            for (int e = 0; e < 8; ++e) { const float u1 = b1 + w10 * x1[e] + w11 * x1[e + 1] + w12 * x1[e + 2], u2 = b2 + w20 * x2[e] + w21 * x2[e + 1] + w22 * x2[e + 2]; z[e] = u1 * u2; }
            u32x4 w; w.x = cvt_pk(z[0], z[1]); w.y = cvt_pk(z[2], z[3]); w.z = cvt_pk(z[4], z[5]); w.w = cvt_pk(z[6], z[7]);
            *(LAS u32x4*)(lds + Z_OFF + (oct * 8 + cc) * 2048 + n * 64 + ((c ^ ((n >> 2) & 3)) << 4)) = w;
        }
    }
    __syncthreads();
    {
        LAS unsigned char* tw = lds + T_OFF + wave * TW;
        const int r = lane & 31, h = lane >> 5, e = r & 1;
        for (int ci = 0; ci < 4; ++ci) {
            const int chl = wave * 4 + ci, ch = cg * 32 + chl;
            const unsigned char* Tsrc = (const unsigned char*)(Tl + (size_t)ch * (2 * L));
            u32x4 d[NP];
#pragma unroll
            for (int i = 0; i < NP; ++i) d[i] = *(const u32x4*)(Tsrc + i * 1024 + lane * 16);
#pragma unroll
            for (int i = 0; i < NP; ++i) {
                *(LAS u32x4*)(tw + i * 1024 + lane * 16) = d[i];
                unsigned nx = (unsigned)__builtin_amdgcn_ds_bpermute(((lane + 1) & 63) << 2, (int)d[i].x);
                const unsigned nfirst = (i + 1 < NP) ? (unsigned)__builtin_amdgcn_readlane((int)d[(i + 1 < NP) ? i + 1 : i].x, 0) : 0u;
                if (lane == 63) nx = nfirst;
                LAS unsigned* o = (LAS unsigned*)(tw + C1OFF + i * 1024 + lane * 16);
                o[0] = __builtin_amdgcn_alignbit(d[i].y, d[i].x, 16); o[1] = __builtin_amdgcn_alignbit(d[i].z, d[i].y, 16);
                o[2] = __builtin_amdgcn_alignbit(d[i].w, d[i].z, 16); o[3] = __builtin_amdgcn_alignbit(nx, d[i].w, 16);
            }
            LDS_WAIT(); __builtin_amdgcn_wave_barrier();
            const LAS unsigned char* aBase = tw + e * C1OFF + ((((L - r - e) >> 1) + 4 * h) << 2);
            const LAS unsigned char* zc = lds + Z_OFF + chl * 2048;
            f32x16 acc0 = {}, acc1 = {};
#pragma unroll 3
            for (int k = -(NB - 1); k <= NB - 1; ++k) {
                const int np = r - k;
                const bool valid = (L == 1024) ? ((unsigned)np < 32u) : ((unsigned)((r & 7) - k) < 8u);
                const int c0 = h ^ ((np >> 2) & 3);
                const LAS unsigned char* zp = zc + np * 64;
                const LAS unsigned char* z0 = valid ? zp + (c0 << 4) : lds + ZERO_OFF;
                const LAS unsigned char* z1 = valid ? zp + ((c0 ^ 2) << 4) : lds + ZERO_OFF;
                const LAS unsigned* ap = (const LAS unsigned*)(aBase - 64 * k);
                const u32x4 a0 = {ap[0], ap[1], ap[2], ap[3]}, a1 = {ap[8], ap[9], ap[10], ap[11]};
                const bf16x8 b0 = *(const LAS bf16x8*)z0, b1 = *(const LAS bf16x8*)z1;
                acc0 = __builtin_amdgcn_mfma_f32_32x32x16_bf16(__builtin_bit_cast(bf16x8, a0), b0, acc0, 0, 0, 0);
                acc1 = __builtin_amdgcn_mfma_f32_32x32x16_bf16(__builtin_bit_cast(bf16x8, a1), b1, acc1, 0, 0, 0);
            }
#pragma unroll
            for (int q = 0; q < 4; ++q) {
                u32x2 w; w.x = cvt_pk(acc0[4 * q] + acc1[4 * q], acc0[4 * q + 1] + acc1[4 * q + 1]); w.y = cvt_pk(acc0[4 * q + 2] + acc1[4 * q + 2], acc0[4 * q + 3] + acc1[4 * q + 3]);
                *(LAS u32x2*)(lds + Z_OFF + chl * 2048 + r * 64 + ((q ^ ((r >> 2) & 3)) << 4) + h * 8) = w;
            }
            LDS_WAIT(); __builtin_amdgcn_wave_barrier();
        }
    }
    __syncthreads();
    {
        const int oct = tid & 3, ch0 = cg * 32 + oct * 8;
        f32x4 w0[2], w1[2], w2[2], bb[2];
#pragma unroll
        for (int i = 0; i < 2; ++i) { w0[i] = *(const f32x4*)(cw + ch0 + 4 * i); w1[i] = *(const f32x4*)(cw + 3072 + ch0 + 4 * i); w2[i] = *(const f32x4*)(cw + 2 * 3072 + ch0 + 4 * i); bb[i] = *(const f32x4*)(cb + ch0 + 4 * i); }
#pragma unroll 2
        for (int it = 0; it < 8; ++it) {
            const int T = (tid >> 2) + 128 * it, n = T >> 5, i = T & 31;
            const bf16_t* src = P + (size_t)(base + T) * DIN + OFF_HY + ch0;
            const bool has_prev = (T & (L - 1)) != 0, has_next = ((T + 1) & (L - 1)) != 0;
            const u32x4 xc = *(const u32x4*)src;
            u32x4 xp = {0u, 0u, 0u, 0u}, xn = {0u, 0u, 0u, 0u};
            if (has_prev) xp = *(const u32x4*)(src - DIN);
            if (has_next) xn = *(const u32x4*)(src + DIN);
            const u32x4 gh = *(const u32x4*)(P + (size_t)(base + T) * DIN + OFF_GH + ch0);
            const LAS unsigned char* yb = lds + Z_OFF + (oct * 8) * 2048 + n * 64 + (((i >> 3) ^ ((n >> 2) & 3)) << 4) + (i & 7) * 2;
            float o[8];
#pragma unroll
            for (int cc = 0; cc < 8; ++cc) {
                const unsigned a = xp[cc >> 1], b = xc[cc >> 1], c2 = xn[cc >> 1], g = gh[cc >> 1];
                const float fp = (cc & 1) ? bfhi(a) : bflo(a), fc = (cc & 1) ? bfhi(b) : bflo(b), fn = (cc & 1) ? bfhi(c2) : bflo(c2), fg = (cc & 1) ? bfhi(g) : bflo(g);
                const float x0 = bb[cc >> 2][cc & 3] + w0[cc >> 2][cc & 3] * fp + w1[cc >> 2][cc & 3] * fc + w2[cc >> 2][cc & 3] * fn;
                const float y = bf2f(*(const LAS unsigned short*)(yb + cc * 2048));
                o[cc] = x0 * y * fg;
            }
            u32x4 w; w.x = cvt_pk(o[0], o[1]); w.y = cvt_pk(o[2], o[3]); w.z = cvt_pk(o[4], o[5]); w.w = cvt_pk(o[6], o[7]);
            *(u32x4*)(HM + (size_t)(base + T) * DM + DHY + ch0) = w;
        }
    }
    __syncthreads();
}
}

#define XB_TMO      128
#define XB_XCNT(j)  (256  + 64 * (j))
#define XB_XSUB(j)  (1280 + 64 * (j))
#define XB_XGEN(j)  (2304 + 64 * (j))
#define XB_TOP      3328
#define XB_TOPGEN   3392
#define XCD_BAR_WORDS 3456
#define XB_SPIN_CAP (1u << 18)
__device__ __forceinline__ unsigned xb_ld(unsigned* p)              { return __hip_atomic_load(p, __ATOMIC_RELAXED, __HIP_MEMORY_SCOPE_AGENT); }
__device__ __forceinline__ unsigned xb_add(unsigned* p, unsigned v) { return __hip_atomic_fetch_add(p, v, __ATOMIC_RELAXED, __HIP_MEMORY_SCOPE_AGENT); }
__device__ __forceinline__ unsigned xb_xcc_id() { return (unsigned)__builtin_amdgcn_s_getreg((3 << 11) | 20) & 0xFu; }
#define XB_SPIN(cond, bar) do { unsigned _sp = 0; while (cond) { __builtin_amdgcn_s_sleep(1); \
    if ((++_sp & 255u) == 0u) { if (xb_ld(&(bar)[XB_TMO])) break; if (_sp > XB_SPIN_CAP) { atomicAdd(&(bar)[XB_TMO], 1u); break; } } } } while (0)
struct XcdBarrier { unsigned* bar; unsigned x; volatile LAS unsigned* st; };
__device__ __forceinline__ XcdBarrier xcd_barrier_post(unsigned* bar, volatile LAS unsigned* st) {
    XcdBarrier b; b.bar = bar; b.x = xb_xcc_id(); b.st = st;
    if (threadIdx.x == 0) (void)xb_add(&bar[XB_XCNT(b.x)], 1u);
    return b;
}
__device__ __forceinline__ void xcd_barrier_complete(unsigned* bar, unsigned x, unsigned& nloc, unsigned& nx) {
    const unsigned G = gridDim.x * gridDim.y * gridDim.z;
    unsigned sum, cnt, mine, sp = 0u;
    for (;;) {
        sum = 0u; cnt = 0u; mine = 0u;
#pragma unroll
        for (unsigned j = 0; j < 16; ++j) { const unsigned c = xb_ld(&bar[XB_XCNT(j)]); sum += c; cnt += (c > 0u) ? 1u : 0u; mine = (j == x) ? c : mine; }
        if (sum == G) break;
        __builtin_amdgcn_s_sleep(1);
        if ((++sp & 255u) == 0u) { if (xb_ld(&bar[XB_TMO])) break; if (sp > XB_SPIN_CAP) { atomicAdd(&bar[XB_TMO], 1u); break; } }
    }
    nloc = mine > 0u ? mine : 1u; nx = cnt > 0u ? cnt : 1u;
}
__device__ __forceinline__ void xcd_barrier(const XcdBarrier& b) {
    asm volatile("s_waitcnt vmcnt(0)" ::: "memory");
    __syncthreads();
    int t0_ = threadIdx.x; asm volatile("" : "+v"(t0_));
    if (t0_ == 0) {
        unsigned* bar = b.bar;
        __builtin_amdgcn_s_waitcnt(0);
        unsigned nloc = b.st[0], nx = b.st[1];
        if (nloc == 0u) { xcd_barrier_complete(bar, b.x, nloc, nx); b.st[0] = nloc; b.st[1] = nx; }
        const unsigned old = xb_add(&bar[XB_XSUB(b.x)], 1u);
        const unsigned gen = old / nloc;
        if (old + 1u == (gen + 1u) * nloc) {
            __builtin_amdgcn_fence(__ATOMIC_RELEASE, "agent");
            asm volatile("s_waitcnt vmcnt(0)" ::: "memory");
            const unsigned og = xb_add(&bar[XB_TOP], 1u);
            const unsigned tg = og / nx;
            if (og + 1u == (tg + 1u) * nx) xb_add(&bar[XB_TOPGEN], 1u);
            else XB_SPIN(xb_ld(&bar[XB_TOPGEN]) == tg, bar);
            __builtin_amdgcn_fence(__ATOMIC_ACQUIRE, "agent");
            xb_add(&bar[XB_XGEN(b.x)], 1u);
            asm volatile("s_waitcnt vmcnt(0)" ::: "memory");
        } else {
            XB_SPIN(xb_ld(&bar[XB_XGEN(b.x)]) == gen, bar);
            __builtin_amdgcn_fence(__ATOMIC_ACQUIRE, "agent");
            asm volatile("s_waitcnt vmcnt(0)" ::: "memory");
        }
    }
    __syncthreads();
}

__global__ void __launch_bounds__(NT, 2) fwd_megakernel(Params p) {
    extern __shared__ __attribute__((aligned(16))) unsigned char lds_raw[];
    LAS unsigned char* lds = (LAS unsigned char*)lds_raw;
    if (threadIdx.x < 2) ((volatile LAS unsigned*)(lds + MISC_OFF))[threadIdx.x] = 0u;
    __syncthreads();
    (void)xcd_barrier_post((unsigned*)(p.ws + WS_BAR), (volatile LAS unsigned*)(lds + MISC_OFF));
#define GRID_SYNC() do { XcdBarrier gb_; gb_.bar = (unsigned*)(p.ws + WS_BAR); gb_.x = xb_xcc_id(); gb_.st = (volatile LAS unsigned*)(lds + MISC_OFF); xcd_barrier(gb_); } while (0)
    const int wave = __builtin_amdgcn_readfirstlane(threadIdx.x >> 6);
    const int G = gridDim.x, bx = blockIdx.x, vcu = (G % 8 == 0) ? (bx % 8) * (G / 8) + bx / 8 : bx;
    const int gw = wave * G + vcu, NGW = G * NW;
#define PHASE_IDS() int tid = threadIdx.x; asm volatile("" : "+v"(tid)); const int lane = tid & 63; (void)lane; int gwp = gw; asm volatile("" : "+s"(gwp)); (void)gwp
#define WS_PTRS() unsigned char* ws = p.ws; asm volatile("" : "+s"(ws)); \
    bf16_t* WinT = (bf16_t*)(ws + WS_WIN); bf16_t* WoutT = (bf16_t*)(ws + WS_WOUT); bf16_t* HM = (bf16_t*)(ws + WS_HM); bf16_t* P = (bf16_t*)(ws + WS_P); \
    bf16_t* KL = (bf16_t*)(ws + WS_KL); bf16_t* VL = (bf16_t*)(ws + WS_VL); float* XB = (float*)(ws + WS_XB); \
    float* modp = (float*)(ws + WS_MODP); float* modf = (float*)(ws + WS_MODF); bf16_t* Tt = (bf16_t*)(ws + WS_T); float* rope = (float*)(ws + WS_ROPE); \
    const float* x_prompt = p.in[0]; const float* x_sample = p.in[1]; \
    (void)WinT; (void)WoutT; (void)HM; (void)P; (void)KL; (void)VL; (void)XB; (void)modp; (void)modf; (void)Tt; (void)rope; (void)x_prompt; (void)x_sample

    for (int rep = 0; rep < 1 + DUP_P0; ++rep) {
        PHASE_IDS(); WS_PTRS();
        LAS float* scr = (LAS float*)(lds + wave * 8448);
        LAS float* sc = (LAS float*)(lds + 8 * 8448);
        LAS float* fscr = (LAS float*)(lds + 8 * 8448 + 3 * DM * 4);
        for (int i = tid; i < DM; i += NT) { sc[i] = silu_f(p.in[5][i]); sc[DM + i] = silu_f(p.in[4][i]); sc[2 * DM + i] = silu_f(p.in[4][DM + i]); }
        __syncthreads();
        for (int fi = vcu; fi < 160; fi += G) {
            const int l = fi / 80; int r = fi % 80; int L, dir, ci; bf16_t* T = Tt + (size_t)l * T_LAYER;
            if (r < 16) { L = 256; dir = r / 8; ci = r % 8; } else { r -= 16; L = 1024; dir = r / 32; ci = r % 32; T += (size_t)DHY * 512; }
            if (dir == 0) filter_item<0>(p, l, L, ci, T, fscr); else filter_item<1>(p, l, L, ci, T, fscr);
        }
        constexpr int I_GEMV = 2 * 24 * MODP;
        constexpr int I_WIN = (DM / 64) * (DIN / 32), I_WOUT = (DM / 64) * (DM / 32);
        constexpr int I_CACHE = 2 * 2 * 2 * PAST, I_ROPE = LS;
        constexpr int I_TOTAL = I_GEMV + 2 * I_WIN + 2 * I_WOUT + I_CACHE + I_ROPE;
        for (int it = gwp; it < I_TOTAL; it += NGW) {
            int r = it;
            if (r < I_GEMV) {
                const int kc = r % MODP, nc = (r / MODP) % 24, l = r / (MODP * 24);
                const float* w = p.in[7] + ((size_t)l * DM + kc * 256) * (3 * DM) + nc * 256 + lane * 4;
                f32x4 a0 = {0.f, 0.f, 0.f, 0.f}, a1 = a0, a2 = a0;
#pragma unroll 8
                for (int k = 0; k < 256; ++k) {
                    const f32x4 wv = *(const f32x4*)(w + (size_t)k * (3 * DM));
                    const int kk = kc * 256 + k;
                    a0 += wv * sc[kk]; a1 += wv * sc[DM + kk]; a2 += wv * sc[2 * DM + kk];
                }
                float* o = modp + ((size_t)(l * MODP + kc) * 3) * (3 * DM) + nc * 256 + lane * 4;
                *(f32x4*)o = a0; *(f32x4*)(o + 3 * DM) = a1; *(f32x4*)(o + 2 * 3 * DM) = a2;
                continue;
            }
            r -= I_GEMV;
            if (r < 2 * I_WIN) { const int l = r / I_WIN; p0_transpose_item(p.in[9] + (size_t)l * DM * DIN, DM, DIN, WinT + (size_t)l * DIN * DM, scr, r % I_WIN, lane); continue; }
            r -= 2 * I_WIN;
            if (r < 2 * I_WOUT) { const int l = r / I_WOUT; p0_transpose_item(p.in[21] + (size_t)l * DM * DM, DM, DM, WoutT + (size_t)l * DM * DM, scr, r % I_WOUT, lane); continue; }
            r -= 2 * I_WOUT;
            if (r < I_CACHE) {
                const int s = r % PAST, l = (r / PAST) & 1, b = (r / (2 * PAST)) & 1, which = r / (4 * PAST);
                const float* src = p.in[2 + which] + (((size_t)b * 2 + l) * PAST + s) * DKV + lane * 8;
                const f32x4 v0 = *(const f32x4*)src, v1 = *(const f32x4*)(src + 4);
                u32x4 w; w.x = pk2(v0[0], v0[1]); w.y = pk2(v0[2], v0[3]); w.z = pk2(v1[0], v1[1]); w.w = pk2(v1[2], v1[3]);
                bf16_t* dst = (which ? VL : KL) + (((size_t)l * 2 + b) * KVL + LS + s) * DKV + lane * 8;
                *(u32x4*)dst = w;
                continue;
            }
            r -= I_CACHE;
            {
                const int t = r; const float rowp = (float)(t / 64), colp = (float)(t % 64);
                const float invf = powf(10000.f, -(float)(lane & 31) / 32.f);
                const float ang = (lane < 32 ? rowp : colp) * invf;
                *(f32x2*)(rope + ((size_t)t * 64 + lane) * 2) = (f32x2){cosf(ang), sinf(ang)};
            }
        }
    GRID_SYNC();
    }

    {
        PHASE_IDS(); WS_PTRS();
        const int idx = vcu * NT + tid;
        if (idx < 2 * 3 * 3 * DM) {
            const int n = idx % (3 * DM), j = (idx / (3 * DM)) % 3, l = idx / (9 * DM); float sacc = p.in[8][l * 3 * DM + n];
#pragma unroll
            for (int q = 0; q < MODP; ++q) sacc += modp[((size_t)(l * MODP + q) * 3 + j) * (3 * DM) + n];
            modf[idx] = sacc;
        }
    }
    GRID_SYNC();

    for (int layer = 0; layer < 2; ++layer) {
        for (int rep = 0; rep < 1 + DUP_PA; ++rep) {
            PHASE_IDS(); WS_PTRS();
            const float* ng = p.in[6] + layer * DM;
            for (int row = gwp; row < NTOK; row += NGW) {
                const float* xr = layer == 0 ? (row < NCTX ? x_prompt + (size_t)row * DM : x_sample + (size_t)(row - NCTX) * DM) : XB + (size_t)row * DM;
                const int j = row < NCTX ? 0 : 1 + (row - NCTX) / LS;
                const float* mrow = modf + ((size_t)layer * 3 + j) * (3 * DM);
                f32x4 v[8]; float ss = 0.f;
#pragma unroll
                for (int i = 0; i < 8; ++i) { v[i] = *(const f32x4*)(xr + 4 * lane + 256 * i); ss += (v[i][0] * v[i][0] + v[i][1] * v[i][1]) + (v[i][2] * v[i][2] + v[i][3] * v[i][3]); }
                ss = wave_sum(ss, lane);
                const float rs = rsqrtf(ss * (1.f / DM) + EPS);
#pragma unroll
                for (int i = 0; i < 8; ++i) {
                    const int col = 4 * lane + 256 * i;
                    const f32x4 gg = *(const f32x4*)(ng + col);
                    const f32x4 sh = *(const f32x4*)(mrow + col), scl = *(const f32x4*)(mrow + DM + col);
                    const f32x4 h = v[i] * rs * gg * (scl + 1.f) + sh;
                    u32x2 w; w.x = pk2(h[0], h[1]); w.y = pk2(h[2], h[3]);
                    *(u32x2*)(HM + (size_t)row * DM + col) = w;
                }
            }
        GRID_SYNC();
        }

        for (int rep = 0; rep < 1 + DUP_PB; ++rep) {
            WS_PTRS();
            pg8::Gemm g{HM, WinT + (size_t)layer * DIN * DM, NTOK, DIN, DM};
            pg8::StaticOrder S; S.init(NTOK, DIN, G, bx);
            EpiInProj E{P, KL + (size_t)layer * 2 * KVL * DKV, VL + (size_t)layer * 2 * KVL * DKV, p.out, p.in[10] + layer * HD, p.in[11] + layer * HD, rope, (LAS float*)(lds + XCH_OFF), layer};
            pg8::gemm_phase<EpiInProj, pg8::StaticOrder>(lds, g, S, E);
        GRID_SYNC();
        }

        for (int rep = 0; rep < 1 + DUP_PC; ++rep) {
            WS_PTRS();
            const bf16_t* KLl = KL + (size_t)layer * 2 * KVL * DKV; const bf16_t* VLl = VL + (size_t)layer * 2 * KVL * DKV;
            const bf16_t* T256 = Tt + (size_t)layer * T_LAYER; const bf16_t* T1024 = T256 + (size_t)DHY * 512;
            for (int slot = bx; slot < 448; slot += G) {
                if (slot < 192) {
                    const bf16_t *Qb, *Kh, *Vh, *Gb; bf16_t* Ob; int ldk, seq;
                    if (slot < 64) { const int b = slot >> 5, h = (slot >> 2) & 7, qb = slot & 3, kv = h >> 1; const size_t tok0 = NCTX + b * LS + qb * 256;
                        Qb = P + tok0 * DIN + h * HD; Gb = P + tok0 * DIN + OFF_GA + h * HD; Ob = HM + tok0 * DM + h * HD;
                        Kh = KLl + (size_t)b * KVL * DKV + kv * HD; Vh = VLl + (size_t)b * KVL * DKV + kv * HD; ldk = DKV; seq = KVL; }
                    else { const int u = slot - 64, b = u >> 3, h = u & 7, kv = h >> 1; const size_t tok0 = (size_t)b * CS;
                        Qb = P + tok0 * DIN + h * HD; Gb = P + tok0 * DIN + OFF_GA + h * HD; Ob = HM + tok0 * DM + h * HD;
                        Kh = P + tok0 * DIN + OFF_K + kv * HD; Vh = P + tok0 * DIN + OFF_V + kv * HD; ldk = DIN; seq = CS; }
                    for (int r2 = 0; r2 < 1 + DUP_ATT; ++r2) att::attn_body(Qb, DIN, Kh, Vh, ldk, Gb, DIN, Ob, DM, seq, (char*)lds_raw);
                } else if (slot < 256) { const int u = slot - 192; for (int r2 = 0; r2 < 1 + DUP_HY; ++r2) hy::unit<1024>(p, layer, (4 + (u >> 5)) * 1024, u & 31, lds, P, HM, T1024); }
                else if (slot >= 320) { const int u = slot - 320; for (int r2 = 0; r2 < 1 + DUP_HY; ++r2) hy::unit<256>(p, layer, (u >> 5) * 1024, u & 31, lds, P, HM, T256); }
            }
        GRID_SYNC();
        }

        for (int rep = 0; rep < 1 + (layer == 0 ? DUP_PD : 0); ++rep) {
            WS_PTRS();
            pg8::Gemm g{HM, WoutT + (size_t)layer * DM * DM, NTOK, DM, DM};
            pg8::StaticOrder S; S.init(NTOK, DM, G, bx);
            EpiOutProj E{layer == 0 ? x_prompt : XB, layer == 0 ? x_sample : XB + (size_t)NCTX * DM, XB, modf + (size_t)layer * 3 * 3 * DM};
            pg8::gemm_phase<EpiOutProj, pg8::StaticOrder>(lds, g, S, E);
        GRID_SYNC();
        }
    }

    for (int r3 = 0; r3 < DUP_SYNC; ++r3) GRID_SYNC();
    {
        PHASE_IDS(); WS_PTRS();
        const float* fg = p.in[22];
        for (int row = gwp; row < NTOK; row += NGW) {
            const float* xr = XB + (size_t)row * DM;
            f32x4 v[8]; float ss = 0.f;
#pragma unroll
            for (int i = 0; i < 8; ++i) { v[i] = *(const f32x4*)(xr + 4 * lane + 256 * i); ss += (v[i][0] * v[i][0] + v[i][1] * v[i][1]) + (v[i][2] * v[i][2] + v[i][3] * v[i][3]); }
            ss = wave_sum(ss, lane);
            const float rs = rsqrtf(ss * (1.f / DM) + EPS);
#pragma unroll
            for (int i = 0; i < 8; ++i) { const int col = 4 * lane + 256 * i; *(f32x4*)(p.out + (size_t)row * DM + col) = v[i] * rs * *(const f32x4*)(fg + col); }
        }
    }
}

extern "C" void kernel_launch(void* const* d_in, const int* in_sizes, int n_in, void* d_out, int out_size, void* d_ws, size_t ws_size, hipStream_t stream) {
    static int grid = 0;
    if (grid == 0) {
        if (n_in != 23 || ws_size < WS_END) { fprintf(stderr, "kernel_launch: n_in %d ws %zu (need %zu)\n", n_in, ws_size, (size_t)WS_END); grid = -1; return; }
        int dev = 0, cus = 0, per_cu = 0;
        if (hipGetDevice(&dev) != hipSuccess || hipDeviceGetAttribute(&cus, hipDeviceAttributeMultiprocessorCount, dev) != hipSuccess) { grid = -1; return; }
        if (hipFuncSetAttribute((const void*)fwd_megakernel, hipFuncAttributeMaxDynamicSharedMemorySize, LDS_BYTES) != hipSuccess) { fprintf(stderr, "kernel_launch: hipFuncSetAttribute failed\n"); grid = -1; return; }
        if (hipOccupancyMaxActiveBlocksPerMultiprocessor(&per_cu, (const void*)fwd_megakernel, NT, LDS_BYTES) != hipSuccess || per_cu < 1) { fprintf(stderr, "kernel_launch: occupancy query says %d\n", per_cu); grid = -1; return; }
        grid = cus;
    }
    if (grid < 0) return;
    Params prm{};
    for (int i = 0; i < 23; ++i) prm.in[i] = (const float*)d_in[i];
    prm.out = (float*)d_out; prm.ws = (unsigned char*)d_ws;
    if (hipMemsetAsync((char*)d_ws + WS_BAR, 0, 16384, stream) != hipSuccess) { fprintf(stderr, "kernel_launch: memset failed\n"); return; }
    void* args[] = {&prm};
    hipError_t e = hipLaunchCooperativeKernel((const void*)fwd_megakernel, dim3(grid), dim3(NT), args, LDS_BYTES, stream);
    if (e != hipSuccess) fprintf(stderr, "cooperative launch failed: %s (grid %d)\n", hipGetErrorString(e), grid);
}
```

```cpp
#include <hip/hip_runtime.h>
#include <hip/hip_cooperative_groups.h>
#include <cstdio>
#include <cstdint>
namespace cg = cooperative_groups;

#define LAS __attribute__((address_space(3)))
#define GAS __attribute__((address_space(1)))
typedef unsigned short bf16_t;
typedef short bf16x8 __attribute__((ext_vector_type(8)));
typedef float f32x4 __attribute__((ext_vector_type(4)));
typedef float f32x2 __attribute__((ext_vector_type(2)));
typedef unsigned u32x4 __attribute__((ext_vector_type(4)));
typedef unsigned u32x2 __attribute__((ext_vector_type(2)));

constexpr int DM = 2048, NCTX = 4096, NLAT = 2048, NTOK = 6144, DIN = 7168;
constexpr int CS = 256, LS = 1024, PAST = 512, KVL = LS + PAST;
constexpr int HD = 128, NKV = 4, DHY = 1024, DKV = 512;
constexpr int OFF_K = 1024, OFF_V = 1536, OFF_GA = 2048, OFF_HY = 3072, OFF_GH = 6144;
constexpr float EPS = 1e-6f;
constexpr size_t OUT_NK = (size_t)NTOK * DM, OUT_NV = OUT_NK + (size_t)16 * 2 * CS * DKV;
constexpr int NW = 8, NT = NW * 64;
#define DUP_P0 0
#define DUP_PA 0
#define DUP_PB 0
#define DUP_PC 0
#define DUP_PD 0
#define DUP_ATT 0
#define DUP_HY 0
#define DUP_SYNC 0
#define DUP_EPI 0
constexpr int MODP = 32;
constexpr int RIF = 3;

constexpr size_t al256(size_t x) { return (x + 255) / 256 * 256; }
constexpr size_t WS_WIN = 0;
constexpr size_t WS_WOUT = WS_WIN + (size_t)2 * DIN * DM * 2;
constexpr size_t WS_HM = WS_WOUT + (size_t)2 * DM * DM * 2;
constexpr size_t WS_P = WS_HM + (size_t)NTOK * DM * 2;
constexpr size_t WS_KL = WS_P + (size_t)NTOK * DIN * 2;
constexpr size_t WS_VL = WS_KL + (size_t)2 * 2 * KVL * DKV * 2;
constexpr size_t WS_XB = WS_VL + (size_t)2 * 2 * KVL * DKV * 2;
constexpr size_t WS_MODP = WS_XB + (size_t)NTOK * DM * 4;
constexpr size_t WS_MODF = WS_MODP + (size_t)2 * MODP * 3 * 3 * DM * 4;
constexpr size_t WS_T = WS_MODF + (size_t)2 * 3 * 3 * DM * 4;
constexpr size_t T_LAYER = (size_t)DHY * (512 + 2048);
constexpr size_t WS_ROPE = WS_T + 2 * T_LAYER * 2;
constexpr size_t WS_OPART = WS_ROPE + (size_t)LS * 64 * 2 * 4;
constexpr size_t WS_ML = WS_OPART + (size_t)64 * 2 * 256 * 128 * 4;
constexpr size_t WS_BAR = WS_ML + (size_t)64 * 2 * 256 * 2 * 4;
constexpr size_t WS_END = WS_BAR + 16384;

constexpr int RING_BYTES = 131072, XCH_OFF = RING_BYTES, MISC_OFF = XCH_OFF + 8192, LDS_BYTES = 147456;

struct Params {
    const float* in[23];
    float* out;
    unsigned char* ws;
};

__device__ __forceinline__ unsigned f2bf(float f) { unsigned u = __builtin_bit_cast(unsigned, f); return (u + 0x7fffu + ((u >> 16) & 1u)) >> 16; }
__device__ __forceinline__ unsigned pk2(float lo, float hi) { return f2bf(lo) | (f2bf(hi) << 16); }
__device__ __forceinline__ float bf2f(unsigned short v) { return __builtin_bit_cast(float, (unsigned)v << 16); }
__device__ __forceinline__ float bflo(unsigned v) { return __builtin_bit_cast(float, v << 16); }
__device__ __forceinline__ float bfhi(unsigned v) { return __builtin_bit_cast(float, v & 0xffff0000u); }
__device__ __forceinline__ float silu_f(float x) { return x * __builtin_amdgcn_rcpf(1.f + __expf(-x)); }
__device__ __forceinline__ unsigned cvt_pk(float lo, float hi) { unsigned r; asm volatile("v_cvt_pk_bf16_f32 %0, %1, %2" : "=v"(r) : "v"(lo), "v"(hi)); return r; }
__device__ __forceinline__ float shx(float v, int m, int lane) { return __builtin_bit_cast(float, __builtin_amdgcn_ds_bpermute((lane ^ m) << 2, __builtin_bit_cast(int, v))); }
__device__ __forceinline__ float wave_sum(float v, int lane) {
#pragma unroll
    for (int o = 1; o < 64; o <<= 1) v += shx(v, o, lane);
    return v;
}
#define LDS_WAIT() asm volatile("s_waitcnt lgkmcnt(0)" ::: "memory")

namespace pg8 {
constexpr int BM = 256, BK = 64, HALF = 128, HTB = HALF * BK * 2, STAGE_BYTES = 8 * HTB, NXCD = 8, WGM = 8;
__host__ __device__ __forceinline__ int lds_byte(int r, int c) { const int st = (r >> 4) * 2 + (c >> 5), rr = r & 15, cc = c & 31, ob = rr * 64 + cc * 2; return st * 1024 + (ob ^ (((ob >> 9) & 1) << 5)); }
__host__ __device__ __forceinline__ void stage_rc(int b, int& R, int& C) { const int st = b / 1024, sb = b % 1024, swz = sb ^ (((sb >> 9) & 1) << 5); R = (st >> 1) * 16 + swz / 64; C = (st & 1) * 32 + (swz % 64) / 2; }
__host__ __device__ __forceinline__ int perm32(int rho) { const int n = rho >> 4, i = rho & 15; return 8 * (i >> 2) + 4 * n + (i & 3); }
struct Unit { int pm, pn; };
struct Gemm { const bf16_t* A; const bf16_t* Bt; int M, N, K; };
struct StaticOrder {
    int nM, nN, nwg, G, c;
    __device__ void init(int M, int N, int G_, int c_) { nM = M / BM; nN = N / BM; nwg = nM * nN; G = G_; c = c_; }
    __device__ bool next(int i, Unit& u) const {
        const long L = (long)i * G + c; if (L >= nwg) return false;
        int wgid = (int)L; { const int q = nwg / NXCD, r = nwg % NXCD, xcd = wgid % NXCD, off = wgid / NXCD; wgid = (xcd < r ? xcd * (q + 1) : r * (q + 1) + (xcd - r) * q) + off; }
        const int nig = WGM * nN, gid = wgid / nig, fm = gid * WGM, gsz = (nM - fm) < WGM ? (nM - fm) : WGM;
        u.pm = fm + ((wgid % nig) % gsz); u.pn = (wgid % nig) / gsz; return true;
    }
};
template <class Epi, class Sched>
__device__ __forceinline__ void gemm_phase(LAS unsigned char* lds, const Gemm g, const Sched& S, const Epi& E) {
    int tid = threadIdx.x; asm volatile("" : "+v"(tid));
    const int wid = __builtin_amdgcn_readfirstlane(tid >> 6), lane = tid & 63, wr = wid >> 2, wc = wid & 3, fr = lane & 15, fq = lane >> 4;
    const int K = g.K, nt = K / BK;
    unsigned voffA[2], voffB[2];
#pragma unroll
    for (int i = 0; i < 2; ++i) { int R, C; stage_rc(tid * 16 + i * 8192, R, C); const int Rb = Epi::PERM ? ((R & ~31) + perm32(R & 31)) : R;
        voffA[i] = (unsigned)(R * K + C) * 2u; voffB[i] = (unsigned)(Rb * K + C) * 2u; }
    const size_t kstep = (size_t)(BK * 2);
    const size_t hstep = (size_t)HALF * K * 2;
    const size_t tstep = 2 * hstep;
    const unsigned ldsw = (unsigned)wid * 1024u;
    const int aoff = lds_byte(wr * 64 + fr, fq * 8), boff = lds_byte(wc * 32 + fr, fq * 8);
#define PG8_SA(b, h) (((b) * 2 + (h)) * HTB)
#define PG8_SB(b, h) ((4 + (b) * 2 + (h)) * HTB)
#define PG8_STAGE(bufoff, gbase, voff) do { _Pragma("unroll") for (int _i = 0; _i < 2; ++_i) \
        __builtin_amdgcn_global_load_lds((const unsigned*)((const char*)(gbase) + (voff)[_i]), (LAS unsigned*)(lds + (bufoff) + ldsw + _i * 8192), 16, 0, 0); } while (0)
#define PG8_LDA(dst, b, h) do { _Pragma("unroll") for (int m = 0; m < 4; ++m) _Pragma("unroll") for (int k = 0; k < 2; ++k) dst[m][k] = *(const LAS bf16x8*)(lds + PG8_SA(b, h) + aoff + m * 2048 + k * 1024); } while (0)
#define PG8_LDB(dst, b, h) do { _Pragma("unroll") for (int n = 0; n < 2; ++n) _Pragma("unroll") for (int k = 0; k < 2; ++k) dst[n][k] = *(const LAS bf16x8*)(lds + PG8_SB(b, h) + boff + n * 2048 + k * 1024); } while (0)
#define PG8_MMA(ai, bj, At, Bt) do { __builtin_amdgcn_s_setprio(1); _Pragma("unroll") for (int m = 0; m < 4; ++m) _Pragma("unroll") for (int n = 0; n < 2; ++n) _Pragma("unroll") for (int k = 0; k < 2; ++k) \
        acc[ai][bj][m][n] = __builtin_amdgcn_mfma_f32_16x16x32_bf16(Bt[n][k], At[m][k], acc[ai][bj][m][n], 0, 0, 0); __builtin_amdgcn_s_setprio(0); } while (0)
#define PG8_WAIT_V(n) asm volatile("s_waitcnt vmcnt(" #n ")" ::: "memory")
#define PG8_WAIT_L(n) asm volatile("s_waitcnt lgkmcnt(" #n ")" ::: "memory")
#define PG8_BAR __builtin_amdgcn_s_barrier()
#define PG8_SCHED __builtin_amdgcn_sched_barrier(0)
    Unit cur, nxt; int ui = 0;
    if (!S.next(0, cur)) return;
    f32x4 acc[2][2][4][2];
#pragma unroll
    for (int a = 0; a < 2; ++a)
#pragma unroll
        for (int b = 0; b < 2; ++b)
#pragma unroll
            for (int m = 0; m < 4; ++m)
#pragma unroll
                for (int n = 0; n < 2; ++n) acc[a][b][m][n] = (f32x4){0.f, 0.f, 0.f, 0.f};
    bf16x8 At[4][2], B0[2][2], B1[2][2];
    const char* cA = (const char*)g.A + (size_t)cur.pm * tstep; const char* cB = (const char*)g.Bt + (size_t)cur.pn * tstep;
    PG8_STAGE(PG8_SB(0, 0), cB, voffB); PG8_STAGE(PG8_SB(0, 1), cB + hstep, voffB); PG8_STAGE(PG8_SA(0, 0), cA, voffA); PG8_STAGE(PG8_SA(0, 1), cA + hstep, voffA);
    if (wr == 1) PG8_BAR;
    PG8_WAIT_V(2); PG8_BAR;
    PG8_STAGE(PG8_SB(1, 0), cB + kstep, voffB); PG8_STAGE(PG8_SA(1, 0), cA + kstep, voffA); PG8_STAGE(PG8_SB(1, 1), cB + hstep + kstep, voffB);
    PG8_WAIT_V(6); PG8_BAR;
    for (;;) {
        const bool has_next = S.next(ui + 1, nxt);
        const char* nA = has_next ? (const char*)g.A + (size_t)nxt.pm * tstep : cA; const char* nB = has_next ? (const char*)g.Bt + (size_t)nxt.pn * tstep : cB;
        for (int t = 0; t < nt; t += 2) {
            const bool last = (t == nt - 2);
            const char* a1 = cA + (size_t)(t + 1) * kstep;
            const char* a2 = last ? nA : cA + (size_t)(t + 2) * kstep; const char* b2 = last ? nB : cB + (size_t)(t + 2) * kstep;
            const char* a3 = a2 + kstep; const char* b3 = b2 + kstep;
            PG8_LDB(B0, 0, 0); PG8_LDB(B1, 0, 1); PG8_SCHED; PG8_LDA(At, 0, 0); PG8_STAGE(PG8_SA(1, 1), a1 + hstep, voffA);
            PG8_WAIT_V(8); PG8_WAIT_L(0); PG8_BAR; PG8_MMA(0, 0, At, B0); PG8_MMA(0, 1, At, B1); PG8_BAR; PG8_SCHED;
            PG8_LDA(At, 0, 1); PG8_STAGE(PG8_SB(0, 0), b2, voffB); PG8_STAGE(PG8_SB(0, 1), b2 + hstep, voffB); PG8_STAGE(PG8_SA(0, 0), a2, voffA);
            PG8_WAIT_V(8); PG8_WAIT_L(0); PG8_BAR; PG8_MMA(1, 0, At, B0); PG8_MMA(1, 1, At, B1); PG8_BAR; PG8_SCHED;
            PG8_LDB(B0, 1, 0); PG8_LDB(B1, 1, 1); PG8_SCHED; PG8_LDA(At, 1, 0); PG8_STAGE(PG8_SA(0, 1), a2 + hstep, voffA);
            PG8_WAIT_V(8); PG8_WAIT_L(0); PG8_BAR; PG8_MMA(0, 0, At, B0); PG8_MMA(0, 1, At, B1); PG8_BAR; PG8_SCHED;
            PG8_LDA(At, 1, 1); PG8_STAGE(PG8_SB(1, 0), b3, voffB); PG8_STAGE(PG8_SB(1, 1), b3 + hstep, voffB); PG8_STAGE(PG8_SA(1, 0), a3, voffA);
            PG8_WAIT_V(8); PG8_WAIT_L(0); PG8_BAR; PG8_MMA(1, 0, At, B0); PG8_MMA(1, 1, At, B1); PG8_BAR; PG8_SCHED;
        }
        if (wr == 0) PG8_BAR;
        for (int r4 = 0; r4 < 1 + DUP_EPI; ++r4) { E(acc, cur, wr, wc, fr, fq); if (DUP_EPI) __builtin_amdgcn_s_barrier(); }
        if (!has_next) break;
#pragma unroll
        for (int a = 0; a < 2; ++a)
#pragma unroll
            for (int b = 0; b < 2; ++b)
#pragma unroll
                for (int m = 0; m < 4; ++m)
#pragma unroll
                    for (int n = 0; n < 2; ++n) acc[a][b][m][n] = (f32x4){0.f, 0.f, 0.f, 0.f};
        cur = nxt; cA = nA; cB = nB; ++ui;
        if (wr == 1) PG8_BAR;
    }
    PG8_WAIT_V(0);
    PG8_BAR;
#undef PG8_SA
#undef PG8_SB
#undef PG8_STAGE
#undef PG8_LDA
#undef PG8_LDB
#undef PG8_MMA
#undef PG8_WAIT_V
#undef PG8_WAIT_L
#undef PG8_BAR
#undef PG8_SCHED
}
}

struct EpiInProj {
    static constexpr bool PERM = true;
    bf16_t* P; bf16_t* KLl; bf16_t* VLl;
    float* out; const float* qg; const float* kg; const float* rope; LAS float* xch; int layer;
    __device__ __forceinline__ void operator()(f32x4 (&acc)[2][2][4][2], const pg8::Unit& u, int wr, int wc, int fr, int fq) const {
        const int pn = u.pn, pm = u.pm;
        const bool lat = pm >= 16;
        asm volatile("" : "+v"(fr), "+v"(fq));
        const int rl0 = wr * 64 + fr, cl0 = wc * 32 + 8 * fq;
        if (pn < 6) {
#pragma unroll
            for (int ai = 0; ai < 2; ++ai)
#pragma unroll
                for (int m = 0; m < 4; ++m)
#pragma unroll
                    for (int bj = 0; bj < 2; ++bj) {
                        const f32x4 a = acc[ai][bj][m][0], b = acc[ai][bj][m][1];
                        float s = (a[0] * a[0] + a[1] * a[1]) + (a[2] * a[2] + a[3] * a[3]) + (b[0] * b[0] + b[1] * b[1]) + (b[2] * b[2] + b[3] * b[3]);
                        s += shx(s, 16, fq * 16 + fr); s += shx(s, 32, fq * 16 + fr);
                        if (fq == 0) xch[((ai * 128 + rl0 + m * 16) * 2 + bj) * 4 + wc] = s;
                    }
            LDS_WAIT(); __builtin_amdgcn_s_barrier(); asm volatile("" ::: "memory");
            const float* gsrc = (pn < 4) ? qg : kg;
            const f32x4 g0 = *(const f32x4*)(gsrc + cl0), g1 = *(const f32x4*)(gsrc + cl0 + 4);
#pragma unroll
            for (int ai = 0; ai < 2; ++ai)
#pragma unroll
                for (int m = 0; m < 4; ++m) {
                    const int rl = ai * 128 + rl0 + m * 16, row = pm * 256 + rl;
#pragma unroll
                    for (int bj = 0; bj < 2; ++bj) {
                        const f32x4 pp = *(const LAS f32x4*)(xch + (rl * 2 + bj) * 4);
                        const float rs = rsqrtf(((pp[0] + pp[1]) + (pp[2] + pp[3])) * (1.f / HD) + EPS);
                        f32x4 v0 = acc[ai][bj][m][0] * rs * g0, v1 = acc[ai][bj][m][1] * rs * g1;
                        if (lat) {
                            const int t = (row - NCTX) & (LS - 1);
                            const f32x4 c0 = *(const f32x4*)(rope + ((size_t)t * 64 + (cl0 >> 1)) * 2), c1 = *(const f32x4*)(rope + ((size_t)t * 64 + (cl0 >> 1) + 2) * 2);
                            f32x4 w0, w1;
                            w0[0] = v0[0] * c0[0] - v0[1] * c0[1]; w0[1] = v0[0] * c0[1] + v0[1] * c0[0]; w0[2] = v0[2] * c0[2] - v0[3] * c0[3]; w0[3] = v0[2] * c0[3] + v0[3] * c0[2];
                            w1[0] = v1[0] * c1[0] - v1[1] * c1[1]; w1[1] = v1[0] * c1[1] + v1[1] * c1[0]; w1[2] = v1[2] * c1[2] - v1[3] * c1[3]; w1[3] = v1[2] * c1[3] + v1[3] * c1[2];
                            v0 = w0; v1 = w1;
                        }
                        u32x4 w; w.x = cvt_pk(v0[0], v0[1]); w.y = cvt_pk(v0[2], v0[3]); w.z = cvt_pk(v1[0], v1[1]); w.w = cvt_pk(v1[2], v1[3]);
                        const int col = pn * 256 + bj * 128 + cl0;
                        if (pn < 4 || !lat) *(u32x4*)(P + (size_t)row * DIN + col) = w;
                        if (pn >= 4) {
                            const int kc = col - OFF_K;
                            if (!lat) { float* o = out + OUT_NK + ((size_t)(pm * 2 + layer) * CS + rl) * DKV + kc; *(f32x4*)o = v0; *(f32x4*)(o + 4) = v1; }
                            else { const int b = (pm - 16) >> 2, t = ((pm - 16) & 3) * 256 + rl; *(u32x4*)(KLl + ((size_t)b * KVL + t) * DKV + kc) = w; }
                        }
                    }
                    asm volatile("" ::: "memory");
                }
        } else {
            const bool is_v = pn < 8, act = (pn >= 8 && pn < 12) || pn >= 24;
#pragma unroll
            for (int ai = 0; ai < 2; ++ai)
#pragma unroll
                for (int m = 0; m < 4; ++m) {
                    const int rl = ai * 128 + rl0 + m * 16, row = pm * 256 + rl;
#pragma unroll
                    for (int bj = 0; bj < 2; ++bj) {
                        f32x4 v0 = acc[ai][bj][m][0], v1 = acc[ai][bj][m][1];
                        if (act) {
#pragma unroll
                            for (int e = 0; e < 4; ++e) { v0[e] = silu_f(v0[e]); v1[e] = silu_f(v1[e]); }
                        }
                        u32x4 w; w.x = cvt_pk(v0[0], v0[1]); w.y = cvt_pk(v0[2], v0[3]); w.z = cvt_pk(v1[0], v1[1]); w.w = cvt_pk(v1[2], v1[3]);
                        const int col = pn * 256 + bj * 128 + cl0;
                        if (!is_v || !lat) *(u32x4*)(P + (size_t)row * DIN + col) = w;
                        if (is_v) {
                            const int vc = col - OFF_V;
                            if (!lat) { float* o = out + OUT_NV + ((size_t)(pm * 2 + layer) * CS + rl) * DKV + vc; *(f32x4*)o = v0; *(f32x4*)(o + 4) = v1; }
                            else { const int b = (pm - 16) >> 2, t = ((pm - 16) & 3) * 256 + rl; *(u32x4*)(VLl + ((size_t)b * KVL + t) * DKV + vc) = w; }
                        }
                    }
                    asm volatile("" ::: "memory");
                }
        }
    }
};
struct EpiOutProj {
    static constexpr bool PERM = true;
    const float* xc; const float* xl; float* xo; const float* modf;
    __device__ __forceinline__ void operator()(f32x4 (&acc)[2][2][4][2], const pg8::Unit& u, int wr, int wc, int fr, int fq) const {
        const int pn = u.pn, pm = u.pm;
        const bool lat = pm >= 16;
        const int j = lat ? 1 + ((pm - 16) >> 2) : 0;
        const float* gate = modf + (size_t)j * 3 * DM + 2 * DM;
        const float* xin = lat ? xl - (size_t)NCTX * DM : xc;
        asm volatile("" : "+v"(fr), "+v"(fq));
        const int rl0 = wr * 64 + fr, cl0 = wc * 32 + 8 * fq;
#pragma unroll
        for (int bj = 0; bj < 2; ++bj) {
            const int col = pn * 256 + bj * 128 + cl0;
            const f32x4 g0 = *(const f32x4*)(gate + col), g1 = *(const f32x4*)(gate + col + 4);
#pragma unroll
            for (int ai = 0; ai < 2; ++ai)
#pragma unroll
                for (int m = 0; m < 4; ++m) {
                    const size_t off = (size_t)(pm * 256 + ai * 128 + rl0 + m * 16) * DM + col;
                    const f32x4 x0 = *(const f32x4*)(xin + off), x1 = *(const f32x4*)(xin + off + 4);
                    *(f32x4*)(xo + off) = x0 + g0 * acc[ai][bj][m][0]; *(f32x4*)(xo + off + 4) = x1 + g1 * acc[ai][bj][m][1];
                }
        }
    }
};

__device__ __forceinline__ void p0_transpose_item(const float* W, int K, int N, bf16_t* WT, LAS float* scr, int item, int lane) {
    const int nblk = N / 64, kb = item / nblk, nb = item % nblk, k0 = 64 * kb, n0 = 64 * nb;
    const int kr = lane >> 3, c4 = (lane & 7) * 4;
    f32x4 v[2][8];
    const GAS float* src = (const GAS float*)W + (size_t)(k0 + kr) * N + n0 + c4;
#pragma unroll
    for (int h = 0; h < 2; ++h)
#pragma unroll
        for (int i = 0; i < 8; ++i) v[h][i] = *(const GAS f32x4*)(src + (size_t)(8 * i) * N + 32 * h);
    const int c = lane & 7;
#pragma unroll
    for (int h = 0; h < 2; ++h) {
#pragma unroll
        for (int i = 0; i < 8; ++i) { LAS float* d = scr + (8 * i + kr) * 33 + c4; d[0] = v[h][i][0]; d[1] = v[h][i][1]; d[2] = v[h][i][2]; d[3] = v[h][i][3]; }
        LDS_WAIT();
#pragma unroll
        for (int j = 0; j < 4; ++j) { const int n = (lane >> 3) + 8 * j; const LAS float* s_ = scr + (8 * c) * 33 + n;
            u32x4 o; o.x = cvt_pk(s_[0 * 33], s_[1 * 33]); o.y = cvt_pk(s_[2 * 33], s_[3 * 33]); o.z = cvt_pk(s_[4 * 33], s_[5 * 33]); o.w = cvt_pk(s_[6 * 33], s_[7 * 33]);
            *(u32x4*)(WT + (size_t)(n0 + 32 * h + n) * K + k0 + 8 * c) = o; }
        LDS_WAIT();
    }
}

template <int DIR>
__device__ __forceinline__ void filter_item(const Params& p, int l, int L, int ci, bf16_t* T, LAS float* scr) {
    int tid = threadIdx.x; asm volatile("" : "+v"(tid));
    const float* w1 = p.in[14] + l * 33 * 64; const float* b1 = p.in[15] + l * 64; const float* w2 = p.in[16] + l * 64 * 64; const float* b2 = p.in[17] + l * 64;
    const float* w3 = p.in[18] + (size_t)l * 64 * 2048; const float* freq = p.in[19] + l * 64;
    LAS float* zf = scr;
    LAS float* h1 = scr + 32 * 33;
    LAS float* h2t = h1 + 32 * 64;
    const int tbase = DIR == 0 ? 1 + 32 * ci : 32 * ci;
    for (int idx = tid; idx < 32 * 33; idx += NT) {
        const int tt = idx / 33, f = idx % 33; const float t = (float)(tbase + tt);
        const float t_norm = t / (float)(L - 1), w = 2.0f * 3.14159265358979323846f * t / (float)L;
        float v;
        if (f == 0) v = t_norm;
        else { const int i = (f - 1) & 15; const float band = 1e-4f + (float)i * ((15.f - 1e-4f) / 15.f); v = f <= 16 ? cosf(w * band) : -sinf(w * band); }
        zf[idx] = v;
    }
    __syncthreads();
    for (int idx = tid; idx < 32 * 64; idx += NT) {
        const int tt = idx >> 6, j = idx & 63; float a = b1[j];
        for (int f = 0; f < 33; ++f) a += zf[tt * 33 + f] * w1[f * 64 + j];
        h1[idx] = sinf(freq[j] * a);
    }
    __syncthreads();
    for (int idx = tid; idx < 32 * 64; idx += NT) {
        const int tt = idx >> 6, j = idx & 63; float a = b2[j];
        for (int i = 0; i < 64; ++i) a += h1[tt * 64 + i] * w2[i * 64 + j];
        h2t[j * 32 + tt] = sinf(freq[j] * a);
    }
    __syncthreads();
    const int c = tid * 2;
    float acc0[32], acc1[32];
#pragma unroll
    for (int tt = 0; tt < 32; ++tt) { acc0[tt] = 0.f; acc1[tt] = 0.f; }
    float e0 = 0.f, e1 = 0.f;
    const bool extra = (DIR == 1 && ci == 0);
    for (int j = 0; j < 64; ++j) {
        const f32x2 wv = *(const f32x2*)(w3 + (size_t)j * 2048 + DIR * 1024 + c);
#pragma unroll
        for (int q = 0; q < 8; ++q) {
            const f32x4 hv = *(const LAS f32x4*)(h2t + j * 32 + q * 4);
#pragma unroll
            for (int e = 0; e < 4; ++e) { acc0[q * 4 + e] += hv[e] * wv[0]; acc1[q * 4 + e] += hv[e] * wv[1]; }
        }
        if (extra) { const f32x2 wf = *(const f32x2*)(w3 + (size_t)j * 2048 + c); const float h0 = h2t[j * 32]; e0 += h0 * wf[0]; e1 += h0 * wf[1]; }
    }
    const float max_decay = logf(1e-2f) / 0.3f, min_decay = logf(1e-2f) / 1.5f;
    const float d0 = fabsf(min_decay + (float)c * ((max_decay - min_decay) / 1023.f)), d1 = fabsf(min_decay + (float)(c + 1) * ((max_decay - min_decay) / 1023.f));
#pragma unroll
    for (int tt = 0; tt < 32; ++tt) {
        const int t = tbase + tt; const float t_norm = (float)t / (float)(L - 1);
        float v0 = acc0[tt] * (__expf(-t_norm * d0) + 0.05f), v1 = acc1[tt] * (__expf(-t_norm * d1) + 0.05f);
        if (DIR == 0 && t >= L) { v0 = 0.f; v1 = 0.f; }
        if (extra && tt == 0) { v0 += e0 * 1.05f + p.in[20][l * DHY + c]; v1 += e1 * 1.05f + p.in[20][l * DHY + c + 1]; }
        acc0[tt] = v0; acc1[tt] = v1;
    }
    const int n0 = DIR == 0 ? L - 32 - 32 * ci : L + 32 * ci;
    bf16_t* r0 = T + (size_t)c * (2 * L) + n0; bf16_t* r1 = r0 + 2 * L;
#pragma unroll
    for (int q = 0; q < 4; ++q) {
        u32x4 a, b;
        if (DIR == 0) {
            a.x = pk2(acc0[31 - (8 * q + 0)], acc0[31 - (8 * q + 1)]); a.y = pk2(acc0[31 - (8 * q + 2)], acc0[31 - (8 * q + 3)]); a.z = pk2(acc0[31 - (8 * q + 4)], acc0[31 - (8 * q + 5)]); a.w = pk2(acc0[31 - (8 * q + 6)], acc0[31 - (8 * q + 7)]);
            b.x = pk2(acc1[31 - (8 * q + 0)], acc1[31 - (8 * q + 1)]); b.y = pk2(acc1[31 - (8 * q + 2)], acc1[31 - (8 * q + 3)]); b.z = pk2(acc1[31 - (8 * q + 4)], acc1[31 - (8 * q + 5)]); b.w = pk2(acc1[31 - (8 * q + 6)], acc1[31 - (8 * q + 7)]);
        } else {
            a.x = pk2(acc0[8 * q + 0], acc0[8 * q + 1]); a.y = pk2(acc0[8 * q + 2], acc0[8 * q + 3]); a.z = pk2(acc0[8 * q + 4], acc0[8 * q + 5]); a.w = pk2(acc0[8 * q + 6], acc0[8 * q + 7]);
            b.x = pk2(acc1[8 * q + 0], acc1[8 * q + 1]); b.y = pk2(acc1[8 * q + 2], acc1[8 * q + 3]); b.z = pk2(acc1[8 * q + 4], acc1[8 * q + 5]); b.w = pk2(acc1[8 * q + 6], acc1[8 * q + 7]);
        }
        *(u32x4*)(r0 + 8 * q) = a; *(u32x4*)(r1 + 8 * q) = b;
    }
    __syncthreads();
}

namespace att {
using s16x4 = __attribute__((ext_vector_type(4))) short;
using f32x16 = __attribute__((ext_vector_type(16))) float;
constexpr int D = 128, QBLK = 32, KVBLK = 64;
constexpr float SCALE = 0.088388347648318440f, THR = 8.f;
constexpr size_t SHM_V = KVBLK * D * 2, SHM_K = KVBLK * D * 2, SHM_ATTN = 2 * SHM_V + 2 * SHM_K + NW * 64 * 4;
#define KSWZ(row, colB) ((row) * 256 + ((colB) ^ (((row) & 7) << 4)))
#define SBAR() __builtin_amdgcn_sched_barrier(0)
__device__ __forceinline__ int crow(int r, int hi) { return (r & 3) + 8 * (r >> 2) + 4 * hi; }
__device__ __forceinline__ void partialSM(f32x16& p0, f32x16& p1, float& m_reg, float& mn, float& alpha) {
  constexpr float C = SCALE * 1.4426950408889634f;
  float pmax = p0[0];
#pragma unroll
  for (int r = 1; r < 16; ++r) pmax = fmaxf(pmax, p0[r]);
#pragma unroll
  for (int r = 0; r < 16; ++r) pmax = fmaxf(pmax, p1[r]);
  { auto rr = __builtin_amdgcn_permlane32_swap(__float_as_uint(pmax), __float_as_uint(pmax), false, false);
    pmax = fmaxf(__uint_as_float(rr[0]), __uint_as_float(rr[1])); }
  if (__builtin_expect(__all(pmax - m_reg <= THR / SCALE), 1)) { mn = m_reg; alpha = 1.f; }
  else { mn = fmaxf(m_reg, pmax); alpha = __builtin_amdgcn_exp2f((m_reg - mn) * C); m_reg = mn; }
  float mnC = -mn * C;
#pragma unroll
  for (int r = 0; r < 16; ++r) p0[r] = fmaf(p0[r], C, mnC);
#pragma unroll
  for (int r = 0; r < 16; ++r) p1[r] = fmaf(p1[r], C, mnC);
#pragma unroll
  for (int r = 0; r < 16; ++r) p0[r] = __builtin_amdgcn_exp2f(p0[r]);
}
__device__ __forceinline__ void finishSM(f32x16& p0, f32x16& p1, float alpha, float& l_reg, bf16x8& pa0, bf16x8& pa1, bf16x8& pa2, bf16x8& pa3) {
#pragma unroll
  for (int r = 0; r < 16; ++r) p1[r] = __builtin_amdgcn_exp2f(p1[r]);
  float ps = 0;
#pragma unroll
  for (int r = 0; r < 16; ++r) ps += p0[r];
#pragma unroll
  for (int r = 0; r < 16; ++r) ps += p1[r];
  { auto rr = __builtin_amdgcn_permlane32_swap(__float_as_uint(ps), __float_as_uint(ps), false, false);
    ps = __uint_as_float(rr[0]) + __uint_as_float(rr[1]); }
  l_reg = l_reg * alpha + ps;
#define PK4(P, BASE, OUT) do { unsigned a0 = cvt_pk(P[BASE + 0], P[BASE + 1]), a1 = cvt_pk(P[BASE + 2], P[BASE + 3]);   \
    unsigned b0 = cvt_pk(P[BASE + 4], P[BASE + 5]), b1 = cvt_pk(P[BASE + 6], P[BASE + 7]);                              \
    auto r0 = __builtin_amdgcn_permlane32_swap(a0, b0, false, false); auto r1 = __builtin_amdgcn_permlane32_swap(a1, b1, false, false); \
    u32x4 w = {r0[0], r1[0], r0[1], r1[1]}; OUT = *reinterpret_cast<bf16x8*>(&w); } while (0)
  PK4(p0, 0, pa0); PK4(p0, 8, pa1); PK4(p1, 0, pa2); PK4(p1, 8, pa3);
#undef PK4
}
__device__ __forceinline__ void qkt(f32x16& p0, f32x16& p1, const bf16_t* Ks, const bf16x8* qr, int r32, int hi) {
  p0 = f32x16{}; p1 = f32x16{};
#pragma unroll
  for (int d0 = 0; d0 < 8; ++d0) { int cb = (d0 * 16 + hi * 8) * 2;
    bf16x8 b0 = *reinterpret_cast<const bf16x8*>((const char*)Ks + KSWZ(r32, cb));
    bf16x8 b1 = *reinterpret_cast<const bf16x8*>((const char*)Ks + KSWZ(32 + r32, cb));
    p0 = __builtin_amdgcn_mfma_f32_32x32x16_bf16(b0, qr[d0], p0, 0, 0, 0);
    p1 = __builtin_amdgcn_mfma_f32_32x32x16_bf16(b1, qr[d0], p1, 0, 0, 0); }
}
__device__ __forceinline__ int v_st(int k, int c) { const int kk = (k & ~0xC) | ((k & 4) << 1) | ((k & 8) >> 1); return ((kk >> 3) * 4 + (c >> 5)) * 512 + ((kk & 7) * 32 + (c & 31)) * 2; }
__device__ __forceinline__ int v_rd_base(int lane) { return ((lane & 3) << 3) | (((lane >> 2) & 3) << 6) | (((lane >> 4) & 1) << 5) | (((lane >> 5) & 1) << 8); }
constexpr int v_rd_off(int d0, int ks, int half) { return d0 * 512 + ks * 4096 + half * 2048; }
template <int OFF> __device__ __forceinline__ s16x4 tr_read(int vb) {
  s16x4 r; asm volatile("ds_read_b64_tr_b16 %0, %1 offset:%2" : "=&v"(r) : "v"(vb), "i"(OFF) : "memory"); return r;
}
template <int D0> __device__ __forceinline__ void pv_one(f32x16& od, int vb, bf16x8 pa0, bf16x8 pa1, bf16x8 pa2, bf16x8 pa3) {
  const s16x4 l0 = tr_read<v_rd_off(D0, 0, 0)>(vb), h0 = tr_read<v_rd_off(D0, 0, 1)>(vb), l1 = tr_read<v_rd_off(D0, 1, 0)>(vb), h1 = tr_read<v_rd_off(D0, 1, 1)>(vb);
  const s16x4 l2 = tr_read<v_rd_off(D0, 2, 0)>(vb), h2 = tr_read<v_rd_off(D0, 2, 1)>(vb), l3 = tr_read<v_rd_off(D0, 3, 0)>(vb), h3 = tr_read<v_rd_off(D0, 3, 1)>(vb);
  asm volatile("s_waitcnt lgkmcnt(0)" ::: "memory"); SBAR();
#define PK(L, H) (bf16x8){L[0], L[1], L[2], L[3], H[0], H[1], H[2], H[3]}
  od = __builtin_amdgcn_mfma_f32_32x32x16_bf16(pa0, PK(l0, h0), od, 0, 0, 0);
  od = __builtin_amdgcn_mfma_f32_32x32x16_bf16(pa1, PK(l1, h1), od, 0, 0, 0);
  od = __builtin_amdgcn_mfma_f32_32x32x16_bf16(pa2, PK(l2, h2), od, 0, 0, 0);
  od = __builtin_amdgcn_mfma_f32_32x32x16_bf16(pa3, PK(l3, h3), od, 0, 0, 0);
#undef PK
}
__device__ __forceinline__ void pv_d0(f32x16* o, int vb, bf16x8 pa0, bf16x8 pa1, bf16x8 pa2, bf16x8 pa3) {
  pv_one<0>(o[0], vb, pa0, pa1, pa2, pa3); pv_one<1>(o[1], vb, pa0, pa1, pa2, pa3); pv_one<2>(o[2], vb, pa0, pa1, pa2, pa3); pv_one<3>(o[3], vb, pa0, pa1, pa2, pa3);
}
__device__ __forceinline__ void attn_body(const bf16_t* __restrict__ Qb, int ldq, const bf16_t* __restrict__ Kh, const bf16_t* __restrict__ Vh, int ldk,
                                          const bf16_t* __restrict__ Gb, int ldg, bf16_t* __restrict__ Ob, int ldo, int seq, char* lds, float* __restrict__ Opart, float* __restrict__ MLpart) {
  int tid = threadIdx.x; asm volatile("" : "+v"(tid));
  const int wid = tid >> 6, lane = tid & 63, r32 = lane & 31, hi = lane >> 5;
  bf16_t* V_lds = (bf16_t*)lds; bf16_t* K_lds = (bf16_t*)(lds + 2 * SHM_V);
  float* wsf = (float*)(lds + 2 * SHM_V + 2 * SHM_K) + wid * 64; float* li_l = wsf; float* al_l = wsf + 32;
  float m_reg = -1e30f, l_reg = 0; f32x16 o[4] = {}; bf16x8 qr[8];
  const bf16_t* Qw = Qb + (long)(wid * QBLK + r32) * ldq + hi * 8;
#pragma unroll
  for (int d0 = 0; d0 < 8; ++d0) qr[d0] = *reinterpret_cast<const bf16x8*>(Qw + d0 * 16);
  const int sr = tid >> 4, sc = (tid & 15) * 8, vst0 = v_st(sr, sc), vst1 = v_st(32 + sr, sc);
  const int vb0 = (int)(uintptr_t)V_lds + v_rd_base(lane);
  constexpr int SDEPTH = 1;
  struct { bf16x8 vs0, vs1, ks0, ks1; } sr_[SDEPTH];
  const unsigned kvoff0 = (unsigned)(sr * ldk + sc) * 2u, kvoff1 = kvoff0 + (unsigned)(64 * ldk);
#define SLOAD(i, k0) do { const char* vb_ = (const char*)Vh + (size_t)(k0) * ldk * 2; const char* kb_ = (const char*)Kh + (size_t)(k0) * ldk * 2; \
    sr_[i].vs0 = *reinterpret_cast<const bf16x8*>(vb_ + kvoff0); sr_[i].vs1 = *reinterpret_cast<const bf16x8*>(vb_ + kvoff1); \
    sr_[i].ks0 = *reinterpret_cast<const bf16x8*>(kb_ + kvoff0); sr_[i].ks1 = *reinterpret_cast<const bf16x8*>(kb_ + kvoff1); } while (0)
#define SWRITE(b, i) do { *(bf16x8*)((char*)V_lds + (b) * SHM_V + vst0) = sr_[i].vs0;          \
    *(bf16x8*)((char*)V_lds + (b) * SHM_V + vst1) = sr_[i].vs1; int kc = sc * 2;               \
    *(bf16x8*)((char*)K_lds + (b) * SHM_K + KSWZ(sr, kc)) = sr_[i].ks0;                       \
    *(bf16x8*)((char*)K_lds + (b) * SHM_K + KSWZ(32 + sr, kc)) = sr_[i].ks1; } while (0)
#define SWAIT() do { if constexpr (SDEPTH == 2) asm volatile("s_waitcnt vmcnt(4)" ::: "memory"); else asm volatile("s_waitcnt vmcnt(0)" ::: "memory"); } while (0)
#define RESC(a) do { if (__any((a) < 1.f)) { if (hi == 0) al_l[r32] = (a); asm volatile("s_waitcnt lgkmcnt(0)" ::: "memory"); \
    _Pragma("unroll") for (int d = 0; d < 4; ++d) _Pragma("unroll") for (int r = 0; r < 16; ++r) o[d][r] *= al_l[crow(r, hi)]; } } while (0)
  f32x16 pA0, pA1, pB0, pB1; float mnA, mnB, alA, alB; bf16x8 pa0, pa1, pa2, pa3; const int NTL = seq / KVBLK;
  constexpr int SE = 0, SO = SDEPTH - 1;
  SLOAD(SE, 0); asm volatile("s_waitcnt vmcnt(0)" ::: "memory"); SWRITE(0, SE); __syncthreads();
  qkt(pA0, pA1, K_lds, qr, r32, hi); partialSM(pA0, pA1, m_reg, mnA, alA);
  SLOAD(SO, KVBLK); if constexpr (SDEPTH == 2) { if (2 < NTL) SLOAD(SE, 2 * KVBLK); }
  SWAIT(); SWRITE(1, SO); __syncthreads();
  for (int j = 1; j + 1 < NTL; j += 2) {
    SBAR(); qkt(pB0, pB1, (bf16_t*)((char*)K_lds + SHM_K), qr, r32, hi);
    finishSM(pA0, pA1, alA, l_reg, pa0, pa1, pa2, pa3); SBAR();
    SLOAD(SO, (j + SDEPTH) * KVBLK); SBAR();
    pv_d0(o, vb0, pa0, pa1, pa2, pa3); partialSM(pB0, pB1, m_reg, mnB, alB);
    __syncthreads(); SWAIT(); SWRITE(0, SE);
    RESC(alB); __syncthreads();
    SBAR(); qkt(pA0, pA1, K_lds, qr, r32, hi);
    finishSM(pB0, pB1, alB, l_reg, pa0, pa1, pa2, pa3); SBAR();
    if (SDEPTH == 1 || j + 3 < NTL) SLOAD(SE, (j + 1 + SDEPTH) * KVBLK); SBAR();
    pv_d0(o, vb0 + (int)SHM_V, pa0, pa1, pa2, pa3); partialSM(pA0, pA1, m_reg, mnA, alA);
    __syncthreads(); SWAIT(); SWRITE(1, SO);
    RESC(alA); __syncthreads();
  }
  SBAR(); qkt(pB0, pB1, (bf16_t*)((char*)K_lds + SHM_K), qr, r32, hi);
  finishSM(pA0, pA1, alA, l_reg, pa0, pa1, pa2, pa3); SBAR();
  pv_d0(o, vb0, pa0, pa1, pa2, pa3); partialSM(pB0, pB1, m_reg, mnB, alB);
  __syncthreads(); RESC(alB);
  finishSM(pB0, pB1, alB, l_reg, pa0, pa1, pa2, pa3); SBAR();
  pv_d0(o, vb0 + (int)SHM_V, pa0, pa1, pa2, pa3);
  if (Opart) {
    float* Ow = Opart + (long)(wid * QBLK) * D;
#pragma unroll
    for (int r = 0; r < 16; ++r) { const int orow = crow(r, hi);
#pragma unroll
      for (int d0 = 0; d0 < 4; ++d0) Ow[orow * D + d0 * 32 + r32] = o[d0][r]; }
    if (hi == 0) *(f32x2*)(MLpart + (wid * QBLK + r32) * 2) = (f32x2){m_reg, l_reg};
    __syncthreads();
    return;
  }
  if (hi == 0) li_l[r32] = l_reg; asm volatile("s_waitcnt lgkmcnt(0)" ::: "memory");
  float rli[16];
#pragma unroll
  for (int r = 0; r < 16; ++r) rli[r] = __builtin_amdgcn_rcpf(li_l[crow(r, hi)]);
  bf16_t* Ow = Ob + (long)(wid * QBLK) * ldo; const bf16_t* Gw = Gb + (long)(wid * QBLK) * ldg;
  bf16_t* stg = K_lds + wid * 2048;
#pragma unroll
  for (int ph = 0; ph < 2; ++ph) {
#pragma unroll
    for (int r = 0; r < 16; ++r) { const int orow = crow(r, hi);
#pragma unroll
      for (int dd = 0; dd < 2; ++dd) stg[orow * 64 + dd * 32 + r32] = (bf16_t)f2bf(o[2 * ph + dd][r] * rli[r]); }
    asm volatile("s_waitcnt lgkmcnt(0)" ::: "memory");
#pragma unroll
    for (int i = 0; i < 4; ++i) { const int row = i * 8 + (lane >> 3), ch = lane & 7;
      const u32x4 ov = *(const u32x4*)(stg + row * 64 + ch * 8), g = *(const u32x4*)(Gw + (long)row * ldg + ph * 64 + ch * 8);
      u32x4 w; w.x = cvt_pk(bflo(ov.x) * bflo(g.x), bfhi(ov.x) * bfhi(g.x)); w.y = cvt_pk(bflo(ov.y) * bflo(g.y), bfhi(ov.y) * bfhi(g.y));
      w.z = cvt_pk(bflo(ov.z) * bflo(g.z), bfhi(ov.z) * bfhi(g.z)); w.w = cvt_pk(bflo(ov.w) * bflo(g.w), bfhi(ov.w) * bfhi(g.w));
      *(u32x4*)(Ow + (long)row * ldo + ph * 64 + ch * 8) = w; }
    asm volatile("s_waitcnt lgkmcnt(0)" ::: "memory");
  }
  __syncthreads();
#undef SLOAD
#undef SWRITE
#undef SWAIT
#undef RESC
}
#undef KSWZ
#undef SBAR
}

namespace hy {
using f32x16 = __attribute__((ext_vector_type(16))) float;
constexpr int Z_OFF = 0, T_OFF = 65536, TW = 8448, ZERO_OFF = T_OFF + 8 * TW;
template <int L>
__device__ __forceinline__ void unit(const Params& p, int layer, int base, int cg, LAS unsigned char* lds, const bf16_t* P, bf16_t* HM, const bf16_t* Tl) {
    constexpr int NB = L / 32, NP = L / 256, C1OFF = 4 * L + 68;
    int tid = threadIdx.x; asm volatile("" : "+v"(tid));
    const int lane = tid & 63, wave = __builtin_amdgcn_readfirstlane(tid >> 6);
    const float* cw = p.in[12] + (size_t)layer * 3 * 3072; const float* cb = p.in[13] + layer * 3072;
    u32x4 d[NP];
    { const unsigned char* Tsrc = (const unsigned char*)(Tl + (size_t)(cg * 32 + wave * 4) * (2 * L));
#pragma unroll
      for (int i = 0; i < NP; ++i) d[i] = *(const u32x4*)(Tsrc + i * 1024 + lane * 16); }
    {
        const int q = tid >> 2, oct = tid & 3, n = q >> 2, c = q & 3, T0 = n * 32 + c * 8, ch0 = cg * 32 + oct * 8;
        if (tid < 16) *(LAS unsigned*)(lds + ZERO_OFF + tid * 4) = 0u;
        const bf16_t* src = P + (size_t)(base + T0) * DIN + OFF_HY + ch0;
        const bool has_prev = (T0 & (L - 1)) != 0, has_next = ((T0 + 8) & (L - 1)) != 0;
        u32x4 r1[10], r2[10];
#pragma unroll
        for (int j = 0; j < 10; ++j) {
            const bool ok = (j == 0) ? has_prev : (j == 9 ? has_next : true);
            if (ok) { r1[j] = *(const u32x4*)(src + (long)(j - 1) * DIN + DHY); r2[j] = *(const u32x4*)(src + (long)(j - 1) * DIN + 2 * DHY); }
            else { r1[j] = (u32x4){0u, 0u, 0u, 0u}; r2[j] = (u32x4){0u, 0u, 0u, 0u}; }
        }
        f32x4 W1[3][2], W2[3][2], B1[2], B2[2];
#pragma unroll
        for (int i = 0; i < 2; ++i) { B1[i] = *(const f32x4*)(cb + DHY + ch0 + 4 * i); B2[i] = *(const f32x4*)(cb + 2 * DHY + ch0 + 4 * i);
#pragma unroll
            for (int tp = 0; tp < 3; ++tp) { W1[tp][i] = *(const f32x4*)(cw + tp * 3072 + DHY + ch0 + 4 * i); W2[tp][i] = *(const f32x4*)(cw + tp * 3072 + 2 * DHY + ch0 + 4 * i); } }
#pragma unroll
        for (int cc = 0; cc < 8; ++cc) {
            const float w10 = W1[0][cc >> 2][cc & 3], w11 = W1[1][cc >> 2][cc & 3], w12 = W1[2][cc >> 2][cc & 3], b1 = B1[cc >> 2][cc & 3];
            const float w20 = W2[0][cc >> 2][cc & 3], w21 = W2[1][cc >> 2][cc & 3], w22 = W2[2][cc >> 2][cc & 3], b2 = B2[cc >> 2][cc & 3];
            float x1[10], x2[10];
#pragma unroll
            for (int j = 0; j < 10; ++j) { const unsigned a = r1[j][cc >> 1], b = r2[j][cc >> 1]; x1[j] = (cc & 1) ? bfhi(a) : bflo(a); x2[j] = (cc & 1) ? bfhi(b) : bflo(b); }
            float z[8];
#pragma unroll
            for (int e = 0; e < 8; ++e) { const float u1 = b1 + w10 * x1[e] + w11 * x1[e + 1] + w12 * x1[e + 2], u2 = b2 + w20 * x2[e] + w21 * x2[e + 1] + w22 * x2[e + 2]; z[e] = u1 * u2; }
            u32x4 w; w.x = cvt_pk(z[0], z[1]); w.y = cvt_pk(z[2], z[3]); w.z = cvt_pk(z[4], z[5]); w.w = cvt_pk(z[6], z[7]);
            *(LAS u32x4*)(lds + Z_OFF + (oct * 8 + cc) * 2048 + n * 64 + ((c ^ ((n >> 2) & 3)) << 4)) = w;
        }
    }
    __syncthreads();
    {
        LAS unsigned char* tw = lds + T_OFF + wave * TW;
        const int r = lane & 31, h = lane >> 5, e = r & 1;
        for (int ci = 0; ci < 4; ++ci) {
            const int chl = wave * 4 + ci, ch = cg * 32 + chl;
#pragma unroll
            for (int i = 0; i < NP; ++i) {
                *(LAS u32x4*)(tw + i * 1024 + lane * 16) = d[i];
                unsigned nx = (unsigned)__builtin_amdgcn_ds_bpermute(((lane + 1) & 63) << 2, (int)d[i].x);
                const unsigned nfirst = (i + 1 < NP) ? (unsigned)__builtin_amdgcn_readlane((int)d[(i + 1 < NP) ? i + 1 : i].x, 0) : 0u;
                if (lane == 63) nx = nfirst;
                LAS unsigned* o = (LAS unsigned*)(tw + C1OFF + i * 1024 + lane * 16);
                o[0] = __builtin_amdgcn_alignbit(d[i].y, d[i].x, 16); o[1] = __builtin_amdgcn_alignbit(d[i].z, d[i].y, 16);
                o[2] = __builtin_amdgcn_alignbit(d[i].w, d[i].z, 16); o[3] = __builtin_amdgcn_alignbit(nx, d[i].w, 16);
            }
            LDS_WAIT(); __builtin_amdgcn_wave_barrier();
            if (ci < 3) { const unsigned char* Tsrc = (const unsigned char*)(Tl + (size_t)(ch + 1) * (2 * L));
#pragma unroll
                for (int i = 0; i < NP; ++i) d[i] = *(const u32x4*)(Tsrc + i * 1024 + lane * 16); }
            const LAS unsigned char* aBase = tw + e * C1OFF + ((((L - r - e) >> 1) + 4 * h) << 2);
            const LAS unsigned char* zc = lds + Z_OFF + chl * 2048;
            f32x16 acc0 = {}, acc1 = {};
#pragma unroll 3
            for (int k = -(NB - 1); k <= NB - 1; ++k) {
                const int np = r - k;
                const bool valid = (L == 1024) ? ((unsigned)np < 32u) : ((unsigned)((r & 7) - k) < 8u);
                const int c0 = h ^ ((np >> 2) & 3);
                const LAS unsigned char* zp = zc + np * 64;
                const LAS unsigned char* z0 = valid ? zp + (c0 << 4) : lds + ZERO_OFF;
                const LAS unsigned char* z1 = valid ? zp + ((c0 ^ 2) << 4) : lds + ZERO_OFF;
                const LAS unsigned* ap = (const LAS unsigned*)(aBase - 64 * k);
                const u32x4 a0 = {ap[0], ap[1], ap[2], ap[3]}, a1 = {ap[8], ap[9], ap[10], ap[11]};
                const bf16x8 b0 = *(const LAS bf16x8*)z0, b1 = *(const LAS bf16x8*)z1;
                acc0 = __builtin_amdgcn_mfma_f32_32x32x16_bf16(__builtin_bit_cast(bf16x8, a0), b0, acc0, 0, 0, 0);
                acc1 = __builtin_amdgcn_mfma_f32_32x32x16_bf16(__builtin_bit_cast(bf16x8, a1), b1, acc1, 0, 0, 0);
            }
#pragma unroll
            for (int q = 0; q < 4; ++q) {
                u32x2 w; w.x = cvt_pk(acc0[4 * q] + acc1[4 * q], acc0[4 * q + 1] + acc1[4 * q + 1]); w.y = cvt_pk(acc0[4 * q + 2] + acc1[4 * q + 2], acc0[4 * q + 3] + acc1[4 * q + 3]);
                *(LAS u32x2*)(lds + Z_OFF + chl * 2048 + r * 64 + ((q ^ ((r >> 2) & 3)) << 4) + h * 8) = w;
            }
            LDS_WAIT(); __builtin_amdgcn_wave_barrier();
        }
    }
    __syncthreads();
    {
        const int oct = tid & 3, ch0 = cg * 32 + oct * 8;
        f32x4 w0[2], w1[2], w2[2], bb[2];
#pragma unroll
        for (int i = 0; i < 2; ++i) { w0[i] = *(const f32x4*)(cw + ch0 + 4 * i); w1[i] = *(const f32x4*)(cw + 3072 + ch0 + 4 * i); w2[i] = *(const f32x4*)(cw + 2 * 3072 + ch0 + 4 * i); bb[i] = *(const f32x4*)(cb + ch0 + 4 * i); }
        for (int it0 = 0; it0 < 8; it0 += 4) {
            u32x4 xp[4], xc[4], xn[4], gh[4];
#pragma unroll
            for (int q = 0; q < 4; ++q) {
                const int T = (tid >> 2) + 128 * (it0 + q);
                const bf16_t* src = P + (size_t)(base + T) * DIN + OFF_HY + ch0;
                const bool has_prev = (T & (L - 1)) != 0, has_next = ((T + 1) & (L - 1)) != 0;
                xc[q] = *(const u32x4*)src;
                xp[q] = *(const u32x4*)(has_prev ? src - DIN : src);
                xn[q] = *(const u32x4*)(has_next ? src + DIN : src);
                if (!has_prev) xp[q] = (u32x4){0u, 0u, 0u, 0u};
                if (!has_next) xn[q] = (u32x4){0u, 0u, 0u, 0u};
                gh[q] = *(const u32x4*)(P + (size_t)(base + T) * DIN + OFF_GH + ch0);
            }
#pragma unroll
            for (int q = 0; q < 4; ++q) {
                const int T = (tid >> 2) + 128 * (it0 + q), n = T >> 5, i = T & 31;
                const LAS unsigned char* yb = lds + Z_OFF + (oct * 8) * 2048 + n * 64 + (((i >> 3) ^ ((n >> 2) & 3)) << 4) + (i & 7) * 2;
                float o[8];
#pragma unroll
                for (int cc = 0; cc < 8; ++cc) {
                    const unsigned a = xp[q][cc >> 1], b = xc[q][cc >> 1], c2 = xn[q][cc >> 1], g = gh[q][cc >> 1];
                    const float fp = (cc & 1) ? bfhi(a) : bflo(a), fc = (cc & 1) ? bfhi(b) : bflo(b), fn = (cc & 1) ? bfhi(c2) : bflo(c2), fg = (cc & 1) ? bfhi(g) : bflo(g);
                    const float x0 = bb[cc >> 2][cc & 3] + w0[cc >> 2][cc & 3] * fp + w1[cc >> 2][cc & 3] * fc + w2[cc >> 2][cc & 3] * fn;
                    const float y = bf2f(*(const LAS unsigned short*)(yb + cc * 2048));
                    o[cc] = x0 * y * fg;
                }
                u32x4 w; w.x = cvt_pk(o[0], o[1]); w.y = cvt_pk(o[2], o[3]); w.z = cvt_pk(o[4], o[5]); w.w = cvt_pk(o[6], o[7]);
                *(u32x4*)(HM + (size_t)(base + T) * DM + DHY + ch0) = w;
            }
        }
    }
    __syncthreads();
}
}

__device__ __forceinline__ void prep_wave_items(const Params& p, int l, bool do_gemv, bool do_win, bool do_wout, bool do_common, int widx, int nw, int lane,
                                                LAS float* scr, const LAS float* sc, unsigned char* ws) {
    bf16_t* WinT = (bf16_t*)(ws + WS_WIN); bf16_t* WoutT = (bf16_t*)(ws + WS_WOUT); bf16_t* KL = (bf16_t*)(ws + WS_KL); bf16_t* VL = (bf16_t*)(ws + WS_VL);
    float* modp = (float*)(ws + WS_MODP); float* rope = (float*)(ws + WS_ROPE);
    constexpr int I_WIN = (DM / 64) * (DIN / 64), I_WOUT = (DM / 64) * (DM / 64), I_CACHE = 2 * 2 * 2 * PAST, I_ROPE = LS;
    const int n_gemv = do_gemv ? 24 * MODP : 0, n_win = do_win ? I_WIN : 0, n_wout = do_wout ? I_WOUT : 0, n_common = do_common ? I_CACHE + I_ROPE : 0;
    const int total = n_gemv + n_win + n_wout + n_common;
    for (int it = widx; it < total; it += nw) {
        int r = it;
        if (r < n_gemv) {
            const int kc = r % MODP, nc = r / MODP;
            const float* w = p.in[7] + ((size_t)l * DM + kc * (DM / MODP)) * (3 * DM) + nc * 256 + lane * 4;
            f32x4 a0 = {0.f, 0.f, 0.f, 0.f}, a1 = a0, a2 = a0;
#pragma unroll 16
            for (int k = 0; k < DM / MODP; ++k) {
                const f32x4 wv = *(const f32x4*)(w + (size_t)k * (3 * DM));
                const int kk = kc * (DM / MODP) + k;
                a0 += wv * sc[kk]; a1 += wv * sc[DM + kk]; a2 += wv * sc[2 * DM + kk];
            }
            float* o = modp + ((size_t)(l * MODP + kc) * 3) * (3 * DM) + nc * 256 + lane * 4;
            *(f32x4*)o = a0; *(f32x4*)(o + 3 * DM) = a1; *(f32x4*)(o + 2 * 3 * DM) = a2;
            continue;
        }
        r -= n_gemv;
        if (r < n_win) { p0_transpose_item(p.in[9] + (size_t)l * DM * DIN, DM, DIN, WinT + (size_t)l * DIN * DM, scr, r, lane); continue; }
        r -= n_win;
        if (r < n_wout) { p0_transpose_item(p.in[21] + (size_t)l * DM * DM, DM, DM, WoutT + (size_t)l * DM * DM, scr, r, lane); continue; }
        r -= n_wout;
        if (r < I_CACHE) {
            const int s_ = r % PAST, l2 = (r / PAST) & 1, b = (r / (2 * PAST)) & 1, which = r / (4 * PAST);
            const float* src = p.in[2 + which] + (((size_t)b * 2 + l2) * PAST + s_) * DKV + lane * 8;
            const f32x4 v0 = *(const f32x4*)src, v1 = *(const f32x4*)(src + 4);
            u32x4 w; w.x = pk2(v0[0], v0[1]); w.y = pk2(v0[2], v0[3]); w.z = pk2(v1[0], v1[1]); w.w = pk2(v1[2], v1[3]);
            bf16_t* dst = (which ? VL : KL) + (((size_t)l2 * 2 + b) * KVL + LS + s_) * DKV + lane * 8;
            *(u32x4*)dst = w;
            continue;
        }
        r -= I_CACHE;
        {
            const int t = r; const float rowp = (float)(t / 64), colp = (float)(t % 64);
            const float invf = powf(10000.f, -(float)(lane & 31) / 32.f);
            const float ang = (lane < 32 ? rowp : colp) * invf;
            *(f32x2*)(rope + ((size_t)t * 64 + lane) * 2) = (f32x2){cosf(ang), sinf(ang)};
        }
    }
}
__device__ __forceinline__ void mod_reduce(const Params& p, int l, int idx, unsigned char* ws) {
    const float* modp = (const float*)(ws + WS_MODP); float* modf = (float*)(ws + WS_MODF);
    if (idx < 3 * 3 * DM) {
        const int n = idx % (3 * DM), j = idx / (3 * DM); float sacc = p.in[8][l * 3 * DM + n];
#pragma unroll 8
        for (int q = 0; q < MODP; ++q) sacc += modp[((size_t)(l * MODP + q) * 3 + j) * (3 * DM) + n];
        modf[(size_t)l * 3 * 3 * DM + idx] = sacc;
    }
}
#define LOAD_SILU_C(sc_) do { for (int i_ = tid; i_ < DM; i_ += NT) { (sc_)[i_] = silu_f(p.in[5][i_]); (sc_)[DM + i_] = silu_f(p.in[4][i_]); (sc_)[2 * DM + i_] = silu_f(p.in[4][DM + i_]); } __syncthreads(); } while (0)

#define XB_TMO      128
#define XB_XCNT(j)  (256  + 64 * (j))
#define XB_XSUB(j)  (1280 + 64 * (j))
#define XB_XGEN(j)  (2304 + 64 * (j))
#define XB_TOP      3328
#define XB_TOPGEN   3392
#define XCD_BAR_WORDS 3456
#define XB_SPIN_CAP (1u << 18)
__device__ __forceinline__ unsigned xb_ld(unsigned* p)              { return __hip_atomic_load(p, __ATOMIC_RELAXED, __HIP_MEMORY_SCOPE_AGENT); }
__device__ __forceinline__ unsigned xb_add(unsigned* p, unsigned v) { return __hip_atomic_fetch_add(p, v, __ATOMIC_RELAXED, __HIP_MEMORY_SCOPE_AGENT); }
__device__ __forceinline__ unsigned xb_xcc_id() { return (unsigned)__builtin_amdgcn_s_getreg((3 << 11) | 20) & 0xFu; }
#define XB_SPIN(cond, bar) do { unsigned _sp = 0; while (cond) { __builtin_amdgcn_s_sleep(1); \
    if ((++_sp & 255u) == 0u) { if (xb_ld(&(bar)[XB_TMO])) break; if (_sp > XB_SPIN_CAP) { atomicAdd(&(bar)[XB_TMO], 1u); break; } } } } while (0)
struct XcdBarrier { unsigned* bar; unsigned x; volatile LAS unsigned* st; };
__device__ __forceinline__ XcdBarrier xcd_barrier_post(unsigned* bar, volatile LAS unsigned* st) {
    XcdBarrier b; b.bar = bar; b.x = xb_xcc_id(); b.st = st;
    if (threadIdx.x == 0) (void)xb_add(&bar[XB_XCNT(b.x)], 1u);
    return b;
}
__device__ __forceinline__ void xcd_barrier_complete(unsigned* bar, unsigned x, unsigned& nloc, unsigned& nx) {
    const unsigned G = gridDim.x * gridDim.y * gridDim.z;
    unsigned sum, cnt, mine, sp = 0u;
    for (;;) {
        sum = 0u; cnt = 0u; mine = 0u;
#pragma unroll
        for (unsigned j = 0; j < 16; ++j) { const unsigned c = xb_ld(&bar[XB_XCNT(j)]); sum += c; cnt += (c > 0u) ? 1u : 0u; mine = (j == x) ? c : mine; }
        if (sum == G) break;
        __builtin_amdgcn_s_sleep(1);
        if ((++sp & 255u) == 0u) { if (xb_ld(&bar[XB_TMO])) break; if (sp > XB_SPIN_CAP) { atomicAdd(&bar[XB_TMO], 1u); break; } }
    }
    nloc = mine > 0u ? mine : 1u; nx = cnt > 0u ? cnt : 1u;
}
__device__ __forceinline__ void xcd_barrier(const XcdBarrier& b) {
    asm volatile("s_waitcnt vmcnt(0)" ::: "memory");
    __syncthreads();
    int t0_ = threadIdx.x; asm volatile("" : "+v"(t0_));
    if (t0_ == 0) {
        unsigned* bar = b.bar;
        __builtin_amdgcn_s_waitcnt(0);
        unsigned nloc = b.st[0], nx = b.st[1];
        if (nloc == 0u) { xcd_barrier_complete(bar, b.x, nloc, nx); b.st[0] = nloc; b.st[1] = nx; }
        const unsigned old = xb_add(&bar[XB_XSUB(b.x)], 1u);
        const unsigned gen = old / nloc;
        if (old + 1u == (gen + 1u) * nloc) {
            __builtin_amdgcn_fence(__ATOMIC_RELEASE, "agent");
            asm volatile("s_waitcnt vmcnt(0)" ::: "memory");
            const unsigned og = xb_add(&bar[XB_TOP], 1u);
            const unsigned tg = og / nx;
            if (og + 1u == (tg + 1u) * nx) xb_add(&bar[XB_TOPGEN], 1u);
            else XB_SPIN(xb_ld(&bar[XB_TOPGEN]) == tg, bar);
            __builtin_amdgcn_fence(__ATOMIC_ACQUIRE, "agent");
            xb_add(&bar[XB_XGEN(b.x)], 1u);
            asm volatile("s_waitcnt vmcnt(0)" ::: "memory");
        } else {
            XB_SPIN(xb_ld(&bar[XB_XGEN(b.x)]) == gen, bar);
            __builtin_amdgcn_fence(__ATOMIC_ACQUIRE, "agent");
            asm volatile("s_waitcnt vmcnt(0)" ::: "memory");
        }
    }
    __syncthreads();
}

__global__ void __launch_bounds__(NT, 2) fwd_megakernel(Params p) {
    extern __shared__ __attribute__((aligned(16))) unsigned char lds_raw[];
    LAS unsigned char* lds = (LAS unsigned char*)lds_raw;
    if (threadIdx.x < 2) ((volatile LAS unsigned*)(lds + MISC_OFF))[threadIdx.x] = 0u;
    __syncthreads();
    (void)xcd_barrier_post((unsigned*)(p.ws + WS_BAR), (volatile LAS unsigned*)(lds + MISC_OFF));
#define GRID_SYNC() do { XcdBarrier gb_; gb_.bar = (unsigned*)(p.ws + WS_BAR); gb_.x = xb_xcc_id(); gb_.st = (volatile LAS unsigned*)(lds + MISC_OFF); xcd_barrier(gb_); } while (0)
    const int wave = __builtin_amdgcn_readfirstlane(threadIdx.x >> 6);
    const int G = gridDim.x, bx = blockIdx.x, vcu = (G % 8 == 0) ? (bx % 8) * (G / 8) + bx / 8 : bx;
    const bool split = (G == 256);
    const int gw = wave * G + vcu, NGW = G * NW;
#define PHASE_IDS() int tid = threadIdx.x; asm volatile("" : "+v"(tid)); const int lane = tid & 63; (void)lane; int gwp = gw; asm volatile("" : "+s"(gwp)); (void)gwp
#define WS_PTRS() unsigned char* ws = p.ws; asm volatile("" : "+s"(ws)); \
    bf16_t* WinT = (bf16_t*)(ws + WS_WIN); bf16_t* WoutT = (bf16_t*)(ws + WS_WOUT); bf16_t* HM = (bf16_t*)(ws + WS_HM); bf16_t* P = (bf16_t*)(ws + WS_P); \
    bf16_t* KL = (bf16_t*)(ws + WS_KL); bf16_t* VL = (bf16_t*)(ws + WS_VL); float* XB = (float*)(ws + WS_XB); \
    float* modp = (float*)(ws + WS_MODP); float* modf = (float*)(ws + WS_MODF); bf16_t* Tt = (bf16_t*)(ws + WS_T); float* rope = (float*)(ws + WS_ROPE); \
    const float* x_prompt = p.in[0]; const float* x_sample = p.in[1]; \
    (void)WinT; (void)WoutT; (void)HM; (void)P; (void)KL; (void)VL; (void)XB; (void)modp; (void)modf; (void)Tt; (void)rope; (void)x_prompt; (void)x_sample

    for (int rep = 0; rep < 1 + DUP_P0; ++rep) {
        PHASE_IDS(); WS_PTRS();
        LAS float* scr = (LAS float*)(lds + wave * 8448);
        LAS float* sc = (LAS float*)(lds + 8 * 8448);
        LAS float* fscr = (LAS float*)(lds + 8 * 8448 + 3 * DM * 4);
        LOAD_SILU_C(sc);
        for (int fi = vcu; fi < 160; fi += G) {
            const int l = fi / 80; int r = fi % 80; int L, dir, ci; bf16_t* T = Tt + (size_t)l * T_LAYER;
            if (r < 16) { L = 256; dir = r / 8; ci = r % 8; } else { r -= 16; L = 1024; dir = r / 32; ci = r % 32; T += (size_t)DHY * 512; }
            if (dir == 0) filter_item<0>(p, l, L, ci, T, fscr); else filter_item<1>(p, l, L, ci, T, fscr);
        }
        prep_wave_items(p, 0, true, true, true, true, gwp, NGW, lane, scr, sc, ws);
        if (!split) prep_wave_items(p, 1, true, true, true, false, gwp, NGW, lane, scr, sc, ws);
    GRID_SYNC();
    }

    {
        PHASE_IDS(); WS_PTRS();
        mod_reduce(p, 0, vcu * NT + tid, ws);
        if (!split) mod_reduce(p, 1, vcu * NT + tid, ws);
    }
    GRID_SYNC();

    for (int layer = 0; layer < 2; ++layer) {
        for (int rep = 0; rep < 1 + DUP_PA; ++rep) {
            PHASE_IDS(); WS_PTRS();
            const float* ng = p.in[6] + layer * DM;
            for (int row0 = gwp; row0 < NTOK; row0 += RIF * NGW) {
                f32x4 v[RIF][8];
#pragma unroll
                for (int r = 0; r < RIF; ++r) { const int rw = row0 + r * NGW, row = rw < NTOK ? rw : NTOK - 1;
                    const float* xr = layer == 0 ? (row < NCTX ? x_prompt + (size_t)row * DM : x_sample + (size_t)(row - NCTX) * DM) : XB + (size_t)row * DM;
                    const GAS f32x4* xg = (const GAS f32x4*)xr + lane;
#pragma unroll
                    for (int i = 0; i < 8; ++i) v[r][i] = xg[64 * i]; }
                asm volatile("" ::: "memory");
#pragma unroll
                for (int r = 0; r < RIF; ++r) { const int row = row0 + r * NGW;
                    if (row < NTOK) {
                        const int j = row < NCTX ? 0 : 1 + (row - NCTX) / LS;
                        const float* mrow = modf + ((size_t)layer * 3 + j) * (3 * DM);
                        float ss = 0.f;
#pragma unroll
                        for (int i = 0; i < 8; ++i) ss += (v[r][i][0] * v[r][i][0] + v[r][i][1] * v[r][i][1]) + (v[r][i][2] * v[r][i][2] + v[r][i][3] * v[r][i][3]);
                        ss = wave_sum(ss, lane);
                        const float rs = rsqrtf(ss * (1.f / DM) + EPS);
#pragma unroll
                        for (int i = 0; i < 8; ++i) {
                            const int col = 4 * lane + 256 * i;
                            const f32x4 gg = *(const f32x4*)(ng + col);
                            const f32x4 sh = *(const f32x4*)(mrow + col), scl = *(const f32x4*)(mrow + DM + col);
                            const f32x4 h = v[r][i] * rs * gg * (scl + 1.f) + sh;
                            u32x2 w; w.x = cvt_pk(h[0], h[1]); w.y = cvt_pk(h[2], h[3]);
                            *(u32x2*)(HM + (size_t)row * DM + col) = w;
                            if (i & 1) asm volatile("" ::: "memory");
                        }
                    } }
            }
        GRID_SYNC();
        }

        for (int rep = 0; rep < 1 + DUP_PB; ++rep) {
            WS_PTRS();
            pg8::Gemm g{HM, WinT + (size_t)layer * DIN * DM, NTOK, DIN, DM};
            pg8::StaticOrder S; S.init(NTOK, DIN, G, bx);
            EpiInProj E{P, KL + (size_t)layer * 2 * KVL * DKV, VL + (size_t)layer * 2 * KVL * DKV, p.out, p.in[10] + layer * HD, p.in[11] + layer * HD, rope, (LAS float*)(lds + XCH_OFF), layer};
            pg8::gemm_phase<EpiInProj, pg8::StaticOrder>(lds, g, S, E);
            if (split && layer == 0 && bx >= 160) {
                PHASE_IDS();
                LAS float* scr = (LAS float*)(lds + wave * 8448); LAS float* sc = (LAS float*)(lds + 8 * 8448);
                LOAD_SILU_C(sc);
                prep_wave_items(p, 1, true, true, false, false, wave * 96 + (bx - 160), 96 * NW, lane, scr, sc, ws);
            }
        GRID_SYNC();
        }

        for (int rep = 0; rep < 1 + DUP_PC; ++rep) {
            WS_PTRS();
            const bf16_t* KLl = KL + (size_t)layer * 2 * KVL * DKV; const bf16_t* VLl = VL + (size_t)layer * 2 * KVL * DKV;
            const bf16_t* T256 = Tt + (size_t)layer * T_LAYER; const bf16_t* T1024 = T256 + (size_t)DHY * 512;
            float* Opart = (float*)(ws + WS_OPART); float* MLp = (float*)(ws + WS_ML);
            for (int slot = bx; slot < 512; slot += G) {
                const int rnd = slot >> 8, i = slot & 255;
                int kind = -1, u = 0;
                if (rnd == 0) { if (i < 128) { kind = 0; u = i; } else if (i < 192) { kind = 2; u = i - 128; } else { kind = 1; u = 2 * (i - 192); } }
                else if (rnd == 1) { if (i < 128) { kind = 3; u = i; } else if (i >= 192) { kind = 1; u = 2 * (i - 192) + 1; } }
                if (kind == 0 || kind == 1) {
                    const bf16_t *Qb, *Kh, *Vh, *Gb; bf16_t* Ob; int ldk, seq; float* Op = nullptr; float* Mp = nullptr;
                    if (kind == 0) { const int un = u >> 1, half = u & 1, b = un >> 5, h = (un >> 2) & 7, qb = un & 3, kv = h >> 1; const size_t tok0 = NCTX + b * LS + qb * 256;
                        Qb = P + tok0 * DIN + h * HD; Gb = P + tok0 * DIN + OFF_GA + h * HD; Ob = HM + tok0 * DM + h * HD;
                        Kh = KLl + ((size_t)b * KVL + half * (KVL / 2)) * DKV + kv * HD; Vh = VLl + ((size_t)b * KVL + half * (KVL / 2)) * DKV + kv * HD; ldk = DKV; seq = KVL / 2;
                        Op = Opart + (size_t)u * 256 * HD; Mp = MLp + (size_t)u * 256 * 2; }
                    else { const int b = u >> 3, h = u & 7, kv = h >> 1; const size_t tok0 = (size_t)b * CS;
                        Qb = P + tok0 * DIN + h * HD; Gb = P + tok0 * DIN + OFF_GA + h * HD; Ob = HM + tok0 * DM + h * HD;
                        Kh = P + tok0 * DIN + OFF_K + kv * HD; Vh = P + tok0 * DIN + OFF_V + kv * HD; ldk = DIN; seq = CS; }
                    for (int r2 = 0; r2 < 1 + DUP_ATT; ++r2) att::attn_body(Qb, DIN, Kh, Vh, ldk, Gb, DIN, Ob, DM, seq, (char*)lds_raw, Op, Mp);
                } else if (kind == 2) { for (int r2 = 0; r2 < 1 + DUP_HY; ++r2) hy::unit<1024>(p, layer, (4 + (u >> 5)) * 1024, u & 31, lds, P, HM, T1024); }
                else if (kind == 3) { for (int r2 = 0; r2 < 1 + DUP_HY; ++r2) hy::unit<256>(p, layer, (u >> 5) * 1024, u & 31, lds, P, HM, T256); }
            }
        GRID_SYNC();
        {
            PHASE_IDS();
            const int sub = tid & 15, rl = tid >> 4;
            for (int rb = vcu; rb < 64 * 8; rb += G) {
                const int un = rb >> 3, row = (rb & 7) * 32 + rl;
                const int b = un >> 5, h = (un >> 2) & 7, qb = un & 3; const size_t tok = NCTX + b * LS + qb * 256 + row;
                const f32x2 ml0 = *(const f32x2*)(MLp + ((size_t)(2 * un) * 256 + row) * 2), ml1 = *(const f32x2*)(MLp + ((size_t)(2 * un + 1) * 256 + row) * 2);
                const float M = fmaxf(ml0[0], ml1[0]), f0 = __expf(att::SCALE * (ml0[0] - M)), f1 = __expf(att::SCALE * (ml1[0] - M));
                const float inv = 1.f / (f0 * ml0[1] + f1 * ml1[1]), w0 = f0 * inv, w1 = f1 * inv;
                const float* o0 = Opart + ((size_t)(2 * un) * 256 + row) * HD + sub * 8; const float* o1 = o0 + (size_t)256 * HD;
                const f32x4 a0 = *(const f32x4*)o0, a1 = *(const f32x4*)(o0 + 4), b0 = *(const f32x4*)o1, b1 = *(const f32x4*)(o1 + 4);
                const u32x4 g = *(const u32x4*)(P + tok * DIN + OFF_GA + h * HD + sub * 8);
                const f32x4 r0 = a0 * w0 + b0 * w1, r1 = a1 * w0 + b1 * w1;
                u32x4 w; w.x = cvt_pk(r0[0] * bflo(g.x), r0[1] * bfhi(g.x)); w.y = cvt_pk(r0[2] * bflo(g.y), r0[3] * bfhi(g.y));
                w.z = cvt_pk(r1[0] * bflo(g.z), r1[1] * bfhi(g.z)); w.w = cvt_pk(r1[2] * bflo(g.w), r1[3] * bfhi(g.w));
                *(u32x4*)(HM + tok * DM + h * HD + sub * 8) = w;
            }
        }
        GRID_SYNC();
        }

        for (int rep = 0; rep < 1 + (layer == 0 ? DUP_PD : 0); ++rep) {
            WS_PTRS();
            pg8::Gemm g{HM, WoutT + (size_t)layer * DM * DM, NTOK, DM, DM};
            pg8::StaticOrder S; S.init(NTOK, DM, G, bx);
            EpiOutProj E{layer == 0 ? x_prompt : XB, layer == 0 ? x_sample : XB + (size_t)NCTX * DM, XB, modf + (size_t)layer * 3 * 3 * DM};
            pg8::gemm_phase<EpiOutProj, pg8::StaticOrder>(lds, g, S, E);
            if (split && layer == 0 && bx >= 192) {
                PHASE_IDS();
                LAS float* scr = (LAS float*)(lds + wave * 8448);
                prep_wave_items(p, 1, false, false, true, false, wave * 64 + (bx - 192), 64 * NW, lane, scr, (const LAS float*)scr, ws);
                mod_reduce(p, 1, (bx - 192) * NT + tid, ws);
            }
        GRID_SYNC();
        }
    }

    for (int r3 = 0; r3 < DUP_SYNC; ++r3) GRID_SYNC();
    {
        PHASE_IDS(); WS_PTRS();
        const float* fg = p.in[22];
        for (int row0 = gwp; row0 < NTOK; row0 += RIF * NGW) {
            f32x4 v[RIF][8];
#pragma unroll
            for (int r = 0; r < RIF; ++r) { const int rw = row0 + r * NGW, row = rw < NTOK ? rw : NTOK - 1;
#pragma unroll
                for (int i = 0; i < 8; ++i) v[r][i] = *(const f32x4*)(XB + (size_t)row * DM + 4 * lane + 256 * i); }
            asm volatile("" ::: "memory");
#pragma unroll
            for (int r = 0; r < RIF; ++r) { const int row = row0 + r * NGW;
                if (row < NTOK) {
                    float ss = 0.f;
#pragma unroll
                    for (int i = 0; i < 8; ++i) ss += (v[r][i][0] * v[r][i][0] + v[r][i][1] * v[r][i][1]) + (v[r][i][2] * v[r][i][2] + v[r][i][3] * v[r][i][3]);
                    ss = wave_sum(ss, lane);
                    const float rs = rsqrtf(ss * (1.f / DM) + EPS);
#pragma unroll
                    for (int i = 0; i < 8; ++i) { const int col = 4 * lane + 256 * i; *(f32x4*)(p.out + (size_t)row * DM + col) = v[r][i] * rs * *(const f32x4*)(fg + col); if (i & 1) asm volatile("" ::: "memory"); }
                } }
        }
    }
}

extern "C" void kernel_launch(void* const* d_in, const int* in_sizes, int n_in, void* d_out, int out_size, void* d_ws, size_t ws_size, hipStream_t stream) {
    static int grid = 0;
    if (grid == 0) {
        if (n_in != 23 || ws_size < WS_END) { fprintf(stderr, "kernel_launch: n_in %d ws %zu (need %zu)\n", n_in, ws_size, (size_t)WS_END); grid = -1; return; }
        int dev = 0, cus = 0, per_cu = 0;
        if (hipGetDevice(&dev) != hipSuccess || hipDeviceGetAttribute(&cus, hipDeviceAttributeMultiprocessorCount, dev) != hipSuccess) { grid = -1; return; }
        if (hipFuncSetAttribute((const void*)fwd_megakernel, hipFuncAttributeMaxDynamicSharedMemorySize, LDS_BYTES) != hipSuccess) { fprintf(stderr, "kernel_launch: hipFuncSetAttribute failed\n"); grid = -1; return; }
        if (hipOccupancyMaxActiveBlocksPerMultiprocessor(&per_cu, (const void*)fwd_megakernel, NT, LDS_BYTES) != hipSuccess || per_cu < 1) { fprintf(stderr, "kernel_launch: occupancy query says %d\n", per_cu); grid = -1; return; }
        grid = cus;
    }
    if (grid < 0) return;
    Params prm{};
    for (int i = 0; i < 23; ++i) prm.in[i] = (const float*)d_in[i];
    prm.out = (float*)d_out; prm.ws = (unsigned char*)d_ws;
    if (hipMemsetAsync((char*)d_ws + WS_BAR, 0, 16384, stream) != hipSuccess) { fprintf(stderr, "kernel_launch: memset failed\n"); return; }
    void* args[] = {&prm};
    hipError_t e = hipLaunchCooperativeKernel((const void*)fwd_megakernel, dim3(grid), dim3(NT), args, LDS_BYTES, stream);
    if (e != hipSuccess) fprintf(stderr, "cooperative launch failed: %s (grid %d)\n", hipGetErrorString(e), grid);
}
```

```cpp
#include <hip/hip_runtime.h>
#include <hip/hip_cooperative_groups.h>
#include <cstdio>
#include <cstdint>
namespace cg = cooperative_groups;

#define LAS __attribute__((address_space(3)))
#define GAS __attribute__((address_space(1)))
typedef unsigned short bf16_t;
typedef short bf16x8 __attribute__((ext_vector_type(8)));
typedef float f32x4 __attribute__((ext_vector_type(4)));
typedef float f32x2 __attribute__((ext_vector_type(2)));
typedef unsigned u32x4 __attribute__((ext_vector_type(4)));
typedef unsigned u32x2 __attribute__((ext_vector_type(2)));

#define DUP_P0 0
#define DUP_PA 0
#define DUP_PB 0
#define DUP_PC 0
#define DUP_PD 0
#define DUP_ATT 0
#define DUP_HY 0
#define DUP_SYNC 0
#define DUP_EPI 0
#define TS_I 0
#define TS_J 0
#define TS_BLK 0
#define TS_AMP 20
#define DUP_PC2 0
#define DUP_GEMV 0
#define DUP_TR 0
#define DUP_FILT 0
#define DUP_ST 0
#define KREP_PB 1
#define KREP_PD 1
constexpr int DM = 2048, NCTX = 4096, NLAT = 2048, NTOK = 6144, DIN = 7168;
constexpr int CS = 256, LS = 1024, PAST = 512, KVL = LS + PAST;
constexpr int HD = 128, NKV = 4, DHY = 1024, DKV = 512;
constexpr int OFF_K = 1024, OFF_V = 1536, OFF_GA = 2048, OFF_HY = 3072, OFF_GH = 6144;
constexpr float EPS = 1e-6f;
constexpr size_t OUT_NK = (size_t)NTOK * DM, OUT_NV = OUT_NK + (size_t)16 * 2 * CS * DKV;
constexpr int NW = 8, NT = NW * 64;
constexpr int MODP = 32;
constexpr int RIF = 3;

constexpr size_t al256(size_t x) { return (x + 255) / 256 * 256; }
constexpr size_t WS_WIN = 0;
constexpr size_t WS_WOUT = WS_WIN + (size_t)2 * DIN * DM * 2;
constexpr size_t WS_HM = WS_WOUT + (size_t)2 * DM * DM * 2;
constexpr size_t WS_P = WS_HM + (size_t)NTOK * DM * 2;
constexpr size_t WS_KL = WS_P + (size_t)NTOK * DIN * 2 * (1 + DUP_ST);
constexpr size_t WS_VL = WS_KL + (size_t)2 * 2 * KVL * DKV * 2;
constexpr size_t WS_XB = WS_VL + (size_t)2 * 2 * KVL * DKV * 2;
constexpr size_t WS_MODP = WS_XB + (size_t)NTOK * DM * 4;
constexpr size_t WS_MODF = WS_MODP + (size_t)2 * MODP * 3 * 3 * DM * 4;
constexpr size_t WS_T = WS_MODF + (size_t)2 * 3 * 3 * DM * 4;
constexpr size_t T_LAYER = (size_t)DHY * (512 + 2048);
constexpr size_t WS_ROPE = WS_T + 2 * T_LAYER * 2;
constexpr size_t WS_OPART = WS_ROPE + (size_t)LS * 64 * 2 * 4;
constexpr size_t WS_ML = WS_OPART + (size_t)64 * 2 * 256 * 128 * 4;
constexpr size_t WS_BAR = WS_ML + (size_t)64 * 2 * 256 * 2 * 4;
constexpr size_t WS_END = WS_BAR + 16384;

constexpr int RING_BYTES = 131072, XCH_OFF = RING_BYTES, MISC_OFF = XCH_OFF + 8192, LDS_BYTES = 147456;

struct Params {
    const float* in[23];
    float* out;
    unsigned char* ws;
};

__device__ __forceinline__ unsigned f2bf(float f) { unsigned u = __builtin_bit_cast(unsigned, f); return (u + 0x7fffu + ((u >> 16) & 1u)) >> 16; }
__device__ __forceinline__ unsigned pk2(float lo, float hi) { return f2bf(lo) | (f2bf(hi) << 16); }
__device__ __forceinline__ float bf2f(unsigned short v) { return __builtin_bit_cast(float, (unsigned)v << 16); }
__device__ __forceinline__ float bflo(unsigned v) { return __builtin_bit_cast(float, v << 16); }
__device__ __forceinline__ float bfhi(unsigned v) { return __builtin_bit_cast(float, v & 0xffff0000u); }
__device__ __forceinline__ float silu_f(float x) { return x * __builtin_amdgcn_rcpf(1.f + __expf(-x)); }
__device__ __forceinline__ unsigned cvt_pk(float lo, float hi) { unsigned r; asm volatile("v_cvt_pk_bf16_f32 %0, %1, %2" : "=v"(r) : "v"(lo), "v"(hi)); return r; }
__device__ __forceinline__ float shx(float v, int m, int lane) { return __builtin_bit_cast(float, __builtin_amdgcn_ds_bpermute((lane ^ m) << 2, __builtin_bit_cast(int, v))); }
__device__ __forceinline__ float wave_sum(float v, int lane) {
#pragma unroll
    for (int o = 1; o < 64; o <<= 1) v += shx(v, o, lane);
    return v;
}
#define LDS_WAIT() asm volatile("s_waitcnt lgkmcnt(0)" ::: "memory")

namespace pg8 {
constexpr int BM = 256, BK = 64, HALF = 128, HTB = HALF * BK * 2, STAGE_BYTES = 8 * HTB, NXCD = 8, WGM = 8;
__host__ __device__ __forceinline__ int lds_byte(int r, int c) { const int st = (r >> 4) * 2 + (c >> 5), rr = r & 15, cc = c & 31, ob = rr * 64 + cc * 2; return st * 1024 + (ob ^ (((ob >> 9) & 1) << 5)); }
__host__ __device__ __forceinline__ void stage_rc(int b, int& R, int& C) { const int st = b / 1024, sb = b % 1024, swz = sb ^ (((sb >> 9) & 1) << 5); R = (st >> 1) * 16 + swz / 64; C = (st & 1) * 32 + (swz % 64) / 2; }
__host__ __device__ __forceinline__ int perm32(int rho) { const int n = rho >> 4, i = rho & 15; return 8 * (i >> 2) + 4 * n + (i & 3); }
struct Unit { int pm, pn; };
struct Gemm { const bf16_t* A; const bf16_t* Bt; int M, N, K; };
struct StaticOrder {
    int nM, nN, nwg, G, c;
    __device__ void init(int M, int N, int G_, int c_, int bm = BM) { nM = M / bm; nN = N / BM; nwg = nM * nN; G = G_; c = c_; }
    __device__ bool next(int i, Unit& u) const {
        const long L = (long)i * G + c; if (L >= nwg) return false;
        int wgid = (int)L; { const int q = nwg / NXCD, r = nwg % NXCD, xcd = wgid % NXCD, off = wgid / NXCD; wgid = (xcd < r ? xcd * (q + 1) : r * (q + 1) + (xcd - r) * q) + off; }
        const int nig = WGM * nN, gid = wgid / nig, fm = gid * WGM, gsz = (nM - fm) < WGM ? (nM - fm) : WGM;
        u.pm = fm + ((wgid % nig) % gsz); u.pn = (wgid % nig) / gsz; return true;
    }
};
template <class Epi, class Sched, int MF>
__device__ __forceinline__ void gemm_phase(LAS unsigned char* lds, const Gemm g, const Sched& S, const Epi& E) {
    int tid = threadIdx.x; asm volatile("" : "+v"(tid));
    const int wid = __builtin_amdgcn_readfirstlane(tid >> 6), lane = tid & 63, wr = wid >> 2, wc = wid & 3, fr = lane & 15, fq = lane >> 4;
    const int K = g.K, nt = K / BK;
    unsigned voffA[2], voffB[2];
#pragma unroll
    for (int i = 0; i < 2; ++i) { int R, C; stage_rc(tid * 16 + i * 8192, R, C); const int Rb = Epi::PERM ? ((R & ~31) + perm32(R & 31)) : R;
        voffA[i] = (unsigned)(R * K + C) * 2u; voffB[i] = (unsigned)(Rb * K + C) * 2u; }
    const size_t kstep = (size_t)(BK * 2);
    const size_t hstep = (size_t)HALF * K * 2, hstepA = (size_t)(MF * 32) * K * 2;
    const size_t tstep = 2 * hstep, tstepA = 2 * hstepA;
    const unsigned ldsw = (unsigned)wid * 1024u;
    const int aoff = lds_byte(wr * (MF * 16) + fr, fq * 8), boff = lds_byte(wc * 32 + fr, fq * 8);
#define PG8_SA(b, h) (((b) * 2 + (h)) * HTB)
#define PG8_SB(b, h) ((4 + (b) * 2 + (h)) * HTB)
#define PG8_STAGE(bufoff, gbase, voff) do { _Pragma("unroll") for (int _i = 0; _i < 2; ++_i) \
        __builtin_amdgcn_global_load_lds((const unsigned*)((const char*)(gbase) + (voff)[_i]), (LAS unsigned*)(lds + (bufoff) + ldsw + _i * 8192), 16, 0, 0); } while (0)
#define PG8_LDA(dst, b, h) do { _Pragma("unroll") for (int m = 0; m < MF; ++m) _Pragma("unroll") for (int k = 0; k < 2; ++k) dst[m][k] = *(const LAS bf16x8*)(lds + PG8_SA(b, h) + aoff + m * 2048 + k * 1024); } while (0)
#define PG8_LDB(dst, b, h) do { _Pragma("unroll") for (int n = 0; n < 2; ++n) _Pragma("unroll") for (int k = 0; k < 2; ++k) dst[n][k] = *(const LAS bf16x8*)(lds + PG8_SB(b, h) + boff + n * 2048 + k * 1024); } while (0)
#define PG8_MMA(ai, bj, At, Bt) do { __builtin_amdgcn_s_setprio(1); _Pragma("unroll") for (int m = 0; m < MF; ++m) _Pragma("unroll") for (int n = 0; n < 2; ++n) _Pragma("unroll") for (int k = 0; k < 2; ++k) \
        acc[ai][bj][m][n] = __builtin_amdgcn_mfma_f32_16x16x32_bf16(Bt[n][k], At[m][k], acc[ai][bj][m][n], 0, 0, 0); __builtin_amdgcn_s_setprio(0); } while (0)
#define PG8_WAIT_V(n) asm volatile("s_waitcnt vmcnt(" #n ")" ::: "memory")
#define PG8_WAIT_L(n) asm volatile("s_waitcnt lgkmcnt(" #n ")" ::: "memory")
#define PG8_BAR __builtin_amdgcn_s_barrier()
#define PG8_SCHED __builtin_amdgcn_sched_barrier(0)
    Unit cur, nxt; int ui = 0;
    if (!S.next(0, cur)) return;
    f32x4 acc[2][2][MF][2];
#pragma unroll
    for (int a = 0; a < 2; ++a)
#pragma unroll
        for (int b = 0; b < 2; ++b)
#pragma unroll
            for (int m = 0; m < MF; ++m)
#pragma unroll
                for (int n = 0; n < 2; ++n) acc[a][b][m][n] = (f32x4){0.f, 0.f, 0.f, 0.f};
    bf16x8 At[MF][2], B0[2][2], B1[2][2];
    const char* cA = (const char*)g.A + (size_t)cur.pm * tstepA; const char* cB = (const char*)g.Bt + (size_t)cur.pn * tstep;
    PG8_STAGE(PG8_SB(0, 0), cB, voffB); PG8_STAGE(PG8_SB(0, 1), cB + hstep, voffB); PG8_STAGE(PG8_SA(0, 0), cA, voffA); PG8_STAGE(PG8_SA(0, 1), cA + hstepA, voffA);
    if (wr == 1) PG8_BAR;
    PG8_WAIT_V(2); PG8_BAR;
    PG8_STAGE(PG8_SB(1, 0), cB + kstep, voffB); PG8_STAGE(PG8_SA(1, 0), cA + kstep, voffA); PG8_STAGE(PG8_SB(1, 1), cB + hstep + kstep, voffB);
    PG8_WAIT_V(6); PG8_BAR;
    for (;;) {
        const bool has_next = S.next(ui + 1, nxt);
        const char* nA = has_next ? (const char*)g.A + (size_t)nxt.pm * tstepA : cA; const char* nB = has_next ? (const char*)g.Bt + (size_t)nxt.pn * tstep : cB;
        for (int t_ = 0; t_ < nt * Epi::KREP; t_ += 2) {
            const bool last = (t_ == nt * Epi::KREP - 2);
            const int t = t_ % nt, t2 = (t_ + 2) % nt;
            const char* a1 = cA + (size_t)(t + 1) * kstep;
            const char* a2 = last ? nA : cA + (size_t)t2 * kstep; const char* b2 = last ? nB : cB + (size_t)t2 * kstep;
            const char* a3 = a2 + kstep; const char* b3 = b2 + kstep;
            PG8_LDB(B0, 0, 0); PG8_LDB(B1, 0, 1); PG8_SCHED; PG8_LDA(At, 0, 0); PG8_STAGE(PG8_SA(1, 1), a1 + hstepA, voffA);
            PG8_WAIT_V(8); PG8_WAIT_L(0); PG8_BAR; PG8_MMA(0, 0, At, B0); PG8_MMA(0, 1, At, B1); PG8_BAR; PG8_SCHED;
            PG8_LDA(At, 0, 1); PG8_STAGE(PG8_SB(0, 0), b2, voffB); PG8_STAGE(PG8_SB(0, 1), b2 + hstep, voffB); PG8_STAGE(PG8_SA(0, 0), a2, voffA);
            PG8_WAIT_V(8); PG8_WAIT_L(0); PG8_BAR; PG8_MMA(1, 0, At, B0); PG8_MMA(1, 1, At, B1); PG8_BAR; PG8_SCHED;
            PG8_LDB(B0, 1, 0); PG8_LDB(B1, 1, 1); PG8_SCHED; PG8_LDA(At, 1, 0); PG8_STAGE(PG8_SA(0, 1), a2 + hstepA, voffA);
            PG8_WAIT_V(8); PG8_WAIT_L(0); PG8_BAR; PG8_MMA(0, 0, At, B0); PG8_MMA(0, 1, At, B1); PG8_BAR; PG8_SCHED;
            PG8_LDA(At, 1, 1); PG8_STAGE(PG8_SB(1, 0), b3, voffB); PG8_STAGE(PG8_SB(1, 1), b3 + hstep, voffB); PG8_STAGE(PG8_SA(1, 0), a3, voffA);
            PG8_WAIT_V(8); PG8_WAIT_L(0); PG8_BAR; PG8_MMA(1, 0, At, B0); PG8_MMA(1, 1, At, B1); PG8_BAR; PG8_SCHED;
        }
        if (wr == 0) PG8_BAR;
        if (Epi::KREP > 1) {
#pragma unroll
            for (int a = 0; a < 2; ++a)
#pragma unroll
                for (int b = 0; b < 2; ++b)
#pragma unroll
                    for (int m = 0; m < MF; ++m)
#pragma unroll
                        for (int n = 0; n < 2; ++n) acc[a][b][m][n] *= (1.0f / Epi::KREP);
        }
        E(acc, cur, wr, wc, fr, fq);
        if (!has_next) break;
#pragma unroll
        for (int a = 0; a < 2; ++a)
#pragma unroll
            for (int b = 0; b < 2; ++b)
#pragma unroll
                for (int m = 0; m < MF; ++m)
#pragma unroll
                    for (int n = 0; n < 2; ++n) acc[a][b][m][n] = (f32x4){0.f, 0.f, 0.f, 0.f};
        cur = nxt; cA = nA; cB = nB; ++ui;
        if (wr == 1) PG8_BAR;
    }
    PG8_WAIT_V(0);
    PG8_BAR;
#undef PG8_SA
#undef PG8_SB
#undef PG8_STAGE
#undef PG8_LDA
#undef PG8_LDB
#undef PG8_MMA
#undef PG8_WAIT_V
#undef PG8_WAIT_L
#undef PG8_BAR
#undef PG8_SCHED
}
}

struct EpiInProj {
    static constexpr bool PERM = true; static constexpr int MF = 4, KREP = KREP_PB;
    bf16_t* P; bf16_t* KLl; bf16_t* VLl;
    float* out; const float* qg; const float* kg; const float* rope; LAS float* xch; int layer;
    __device__ __forceinline__ void operator()(f32x4 (&acc)[2][2][4][2], const pg8::Unit& u, int wr, int wc, int fr, int fq) const {
        const int pn = u.pn, pm = u.pm;
        const bool lat = pm >= 16;
        asm volatile("" : "+v"(fr), "+v"(fq));
        const int rl0 = wr * 64 + fr, cl0 = wc * 32 + 8 * fq;
        if (pn < 6) {
#pragma unroll
            for (int ai = 0; ai < 2; ++ai)
#pragma unroll
                for (int m = 0; m < 4; ++m)
#pragma unroll
                    for (int bj = 0; bj < 2; ++bj) {
                        const f32x4 a = acc[ai][bj][m][0], b = acc[ai][bj][m][1];
                        float s = (a[0] * a[0] + a[1] * a[1]) + (a[2] * a[2] + a[3] * a[3]) + (b[0] * b[0] + b[1] * b[1]) + (b[2] * b[2] + b[3] * b[3]);
                        s += shx(s, 16, fq * 16 + fr); s += shx(s, 32, fq * 16 + fr);
                        if (fq == 0) xch[((ai * 128 + rl0 + m * 16) * 2 + bj) * 4 + wc] = s;
                    }
            LDS_WAIT(); __builtin_amdgcn_s_barrier(); asm volatile("" ::: "memory");
            const float* gsrc = (pn < 4) ? qg : kg;
            const f32x4 g0 = *(const f32x4*)(gsrc + cl0), g1 = *(const f32x4*)(gsrc + cl0 + 4);
            const f32x4 ifr = *(const f32x4*)(rope + ((cl0 >> 1) & 31));
#pragma unroll
            for (int ai = 0; ai < 2; ++ai)
#pragma unroll
                for (int m = 0; m < 4; ++m) {
                    const int rl = ai * 128 + rl0 + m * 16, row = pm * 256 + rl;
#pragma unroll
                    for (int bj = 0; bj < 2; ++bj) {
                        const f32x4 pp = *(const LAS f32x4*)(xch + (rl * 2 + bj) * 4);
                        const float rs = rsqrtf(((pp[0] + pp[1]) + (pp[2] + pp[3])) * (1.f / HD) + EPS);
                        f32x4 v0 = acc[ai][bj][m][0] * rs * g0, v1 = acc[ai][bj][m][1] * rs * g1;
                        if (lat) {
                            const int t = (row - NCTX) & (LS - 1);
                            const float pos = (float)(wc < 2 ? (t >> 6) : (t & 63));
                            const f32x4 ar = ifr * pos;
                            const f32x4 c0 = {__builtin_amdgcn_cosf(ar[0]), __builtin_amdgcn_sinf(ar[0]), __builtin_amdgcn_cosf(ar[1]), __builtin_amdgcn_sinf(ar[1])};
                            const f32x4 c1 = {__builtin_amdgcn_cosf(ar[2]), __builtin_amdgcn_sinf(ar[2]), __builtin_amdgcn_cosf(ar[3]), __builtin_amdgcn_sinf(ar[3])};
                            f32x4 w0, w1;
                            w0[0] = v0[0] * c0[0] - v0[1] * c0[1]; w0[1] = v0[0] * c0[1] + v0[1] * c0[0]; w0[2] = v0[2] * c0[2] - v0[3] * c0[3]; w0[3] = v0[2] * c0[3] + v0[3] * c0[2];
                            w1[0] = v1[0] * c1[0] - v1[1] * c1[1]; w1[1] = v1[0] * c1[1] + v1[1] * c1[0]; w1[2] = v1[2] * c1[2] - v1[3] * c1[3]; w1[3] = v1[2] * c1[3] + v1[3] * c1[2];
                            v0 = w0; v1 = w1;
                        }
                        u32x4 w; w.x = cvt_pk(v0[0], v0[1]); w.y = cvt_pk(v0[2], v0[3]); w.z = cvt_pk(v1[0], v1[1]); w.w = cvt_pk(v1[2], v1[3]);
                        const int col = pn * 256 + bj * 128 + cl0;
                        if (pn < 4 || !lat) *(u32x4*)(P + (size_t)row * DIN + col) = w;
                        if (pn >= 4) {
                            const int kc = col - OFF_K;
                            if (!lat) { float* o = out + OUT_NK + ((size_t)(pm * 2 + layer) * CS + rl) * DKV + kc; *(f32x4*)o = v0; *(f32x4*)(o + 4) = v1; }
                            else { const int b = (pm - 16) >> 2, t = ((pm - 16) & 3) * 256 + rl; *(u32x4*)(KLl + ((size_t)b * KVL + t) * DKV + kc) = w; }
                        }
                    }
                    asm volatile("" ::: "memory");
                }
        } else {
            const bool is_v = pn < 8, act = (pn >= 8 && pn < 12) || pn >= 24;
#pragma unroll
            for (int ai = 0; ai < 2; ++ai)
#pragma unroll
                for (int m = 0; m < 4; ++m) {
                    const int rl = ai * 128 + rl0 + m * 16, row = pm * 256 + rl;
#pragma unroll
                    for (int bj = 0; bj < 2; ++bj) {
                        f32x4 v0 = acc[ai][bj][m][0], v1 = acc[ai][bj][m][1];
                        if (act) {
#pragma unroll
                            for (int e = 0; e < 4; ++e) { v0[e] = silu_f(v0[e]); v1[e] = silu_f(v1[e]); }
                        }
                        u32x4 w; w.x = cvt_pk(v0[0], v0[1]); w.y = cvt_pk(v0[2], v0[3]); w.z = cvt_pk(v1[0], v1[1]); w.w = cvt_pk(v1[2], v1[3]);
                        const int col = pn * 256 + bj * 128 + cl0;
                        if (!is_v || !lat) { *(u32x4*)(P + (size_t)row * DIN + col) = w; if (DUP_ST) { *(u32x4*)(P + (size_t)NTOK * DIN + (size_t)row * DIN + col) = w; } }
                        if (is_v) {
                            const int vc = col - OFF_V;
                            if (!lat) { float* o = out + OUT_NV + ((size_t)(pm * 2 + layer) * CS + rl) * DKV + vc; *(f32x4*)o = v0; *(f32x4*)(o + 4) = v1; }
                            else { const int b = (pm - 16) >> 2, t = ((pm - 16) & 3) * 256 + rl; *(u32x4*)(VLl + ((size_t)b * KVL + t) * DKV + vc) = w; }
                        }
                    }
                    asm volatile("" ::: "memory");
                }
        }
    }
};
struct EpiOutProj {
    static constexpr bool PERM = true; static constexpr int MF = 3, KREP = KREP_PD;
    const float* xc; const float* xl; float* xo; const float* modf;
    __device__ __forceinline__ void operator()(f32x4 (&acc)[2][2][3][2], const pg8::Unit& u, int wr, int wc, int fr, int fq) const {
        const int pn = u.pn, pm = u.pm;
        asm volatile("" : "+v"(fr), "+v"(fq));
        const int rl0 = wr * 48 + fr, cl0 = wc * 32 + 8 * fq;
#pragma unroll
        for (int ai = 0; ai < 2; ++ai)
#pragma unroll
            for (int m = 0; m < 3; ++m) {
                const int row = pm * 192 + ai * 96 + rl0 + m * 16;
                const bool lat = row >= NCTX;
                const int j = lat ? 1 + ((row - NCTX) >> 10) : 0;
                const float* gate = modf + (size_t)j * 3 * DM + 2 * DM;
                const float* xin = lat ? xl - (size_t)NCTX * DM : xc;
#pragma unroll
                for (int bj = 0; bj < 2; ++bj) {
                    const int col = pn * 256 + bj * 128 + cl0;
                    const size_t off = (size_t)row * DM + col;
                    const f32x4 g0 = *(const f32x4*)(gate + col), g1 = *(const f32x4*)(gate + col + 4);
                    const f32x4 x0 = *(const f32x4*)(xin + off), x1 = *(const f32x4*)(xin + off + 4);
                    *(f32x4*)(xo + off) = x0 + g0 * acc[ai][bj][m][0]; *(f32x4*)(xo + off + 4) = x1 + g1 * acc[ai][bj][m][1];
                }
                if (m == 2) asm volatile("" ::: "memory");
            }
    }
};

__device__ __forceinline__ void p0_transpose_item(const float* W, int K, int N, bf16_t* WT, LAS float* scr, int item, int lane) {
    const int nblk = N / 64, kb = item / nblk, nb = item % nblk, k0 = 64 * kb, n0 = 64 * nb;
    const int kr = lane >> 3, c4 = (lane & 7) * 4;
    f32x4 v[2][8];
    const GAS float* src = (const GAS float*)W + (size_t)(k0 + kr) * N + n0 + c4;
#pragma unroll
    for (int h = 0; h < 2; ++h)
#pragma unroll
        for (int i = 0; i < 8; ++i) v[h][i] = *(const GAS f32x4*)(src + (size_t)(8 * i) * N + 32 * h);
    const int c = lane & 7;
#pragma unroll
    for (int h = 0; h < 2; ++h) {
#pragma unroll
        for (int i = 0; i < 8; ++i) { LAS float* d = scr + (8 * i + kr) * 33 + c4; d[0] = v[h][i][0]; d[1] = v[h][i][1]; d[2] = v[h][i][2]; d[3] = v[h][i][3]; }
        LDS_WAIT();
#pragma unroll
        for (int j = 0; j < 4; ++j) { const int n = (lane >> 3) + 8 * j; const LAS float* s_ = scr + (8 * c) * 33 + n;
            u32x4 o; o.x = cvt_pk(s_[0 * 33], s_[1 * 33]); o.y = cvt_pk(s_[2 * 33], s_[3 * 33]); o.z = cvt_pk(s_[4 * 33], s_[5 * 33]); o.w = cvt_pk(s_[6 * 33], s_[7 * 33]);
            *(u32x4*)(WT + (size_t)(n0 + 32 * h + n) * K + k0 + 8 * c) = o; }
        LDS_WAIT();
    }
}

template <int DIR>
__device__ __forceinline__ void filter_item(const Params& p, int l, int L, int ci, bf16_t* T, LAS float* scr) {
    int tid = threadIdx.x; asm volatile("" : "+v"(tid));
    const float* w1 = p.in[14] + l * 33 * 64; const float* b1 = p.in[15] + l * 64; const float* w2 = p.in[16] + l * 64 * 64; const float* b2 = p.in[17] + l * 64;
    const float* w3 = p.in[18] + (size_t)l * 64 * 2048; const float* freq = p.in[19] + l * 64;
    LAS float* zf = scr;
    LAS float* h1 = scr + 32 * 33;
    LAS float* h2t = h1 + 32 * 64;
    LAS float* w1s = h2t + 64 * 32;
    LAS float* w2s = w1s + 33 * 64;
    LAS float* cst = w2s + 64 * 64;
    const int tbase = DIR == 0 ? 1 + 32 * ci : 32 * ci;
    for (int idx = tid; idx < 33 * 64; idx += NT) w1s[idx] = w1[idx];
    for (int idx = tid; idx < 64 * 64; idx += NT) w2s[idx] = w2[idx];
    if (tid < 64) { cst[tid] = b1[tid]; cst[64 + tid] = b2[tid]; cst[128 + tid] = freq[tid] * 0.15915494309189535f; }
    for (int idx = tid; idx < 32 * 33; idx += NT) {
        const int tt = idx / 33, f = idx % 33; const float t = (float)(tbase + tt);
        float v;
        if (f == 0) v = t / (float)(L - 1);
        else { const int i = (f - 1) & 15; const float band = 1e-4f + (float)i * ((15.f - 1e-4f) / 15.f); const float rev = t * band / (float)L;
            v = f <= 16 ? __builtin_amdgcn_cosf(rev) : -__builtin_amdgcn_sinf(rev); }
        zf[idx] = v;
    }
    __syncthreads();
    for (int idx = tid; idx < 32 * 64; idx += NT) {
        const int tt = idx >> 6, j = idx & 63; float a = cst[j];
#pragma unroll 11
        for (int f = 0; f < 33; ++f) a += zf[tt * 33 + f] * w1s[f * 64 + j];
        h1[idx] = __builtin_amdgcn_sinf(cst[128 + j] * a);
    }
    __syncthreads();
    for (int idx = tid; idx < 32 * 64; idx += NT) {
        const int tt = idx >> 6, j = idx & 63; float a = cst[64 + j];
#pragma unroll 16
        for (int i = 0; i < 64; ++i) a += h1[tt * 64 + i] * w2s[i * 64 + j];
        h2t[j * 32 + tt] = __builtin_amdgcn_sinf(cst[128 + j] * a);
    }
    __syncthreads();
    const int c = tid * 2;
    float acc0[32], acc1[32];
#pragma unroll
    for (int tt = 0; tt < 32; ++tt) { acc0[tt] = 0.f; acc1[tt] = 0.f; }
    float e0 = 0.f, e1 = 0.f;
    const bool extra = (DIR == 1 && ci == 0);
    for (int j0 = 0; j0 < 64; j0 += 8) {
        f32x2 wv[8];
#pragma unroll
        for (int jj = 0; jj < 8; ++jj) wv[jj] = *(const GAS f32x2*)((const GAS float*)w3 + (size_t)(j0 + jj) * 2048 + DIR * 1024 + c);
#pragma unroll
        for (int jj = 0; jj < 8; ++jj) {
            const int j = j0 + jj;
#pragma unroll
            for (int q = 0; q < 8; ++q) {
                const f32x4 hv = *(const LAS f32x4*)(h2t + j * 32 + q * 4);
#pragma unroll
                for (int e = 0; e < 4; ++e) { acc0[q * 4 + e] += hv[e] * wv[jj][0]; acc1[q * 4 + e] += hv[e] * wv[jj][1]; }
            }
        }
    }
    if (extra) {
#pragma unroll 8
        for (int j = 0; j < 64; ++j) { const f32x2 wf = *(const GAS f32x2*)((const GAS float*)w3 + (size_t)j * 2048 + c); const float h0 = h2t[j * 32]; e0 += h0 * wf[0]; e1 += h0 * wf[1]; }
    }
    const float max_decay = logf(1e-2f) / 0.3f, min_decay = logf(1e-2f) / 1.5f;
    const float d0 = fabsf(min_decay + (float)c * ((max_decay - min_decay) / 1023.f)), d1 = fabsf(min_decay + (float)(c + 1) * ((max_decay - min_decay) / 1023.f));
#pragma unroll
    for (int tt = 0; tt < 32; ++tt) {
        const int t = tbase + tt; const float t_norm = (float)t / (float)(L - 1);
        float v0 = acc0[tt] * (__expf(-t_norm * d0) + 0.05f), v1 = acc1[tt] * (__expf(-t_norm * d1) + 0.05f);
        if (DIR == 0 && t >= L) { v0 = 0.f; v1 = 0.f; }
        if (extra && tt == 0) { v0 += e0 * 1.05f + p.in[20][l * DHY + c]; v1 += e1 * 1.05f + p.in[20][l * DHY + c + 1]; }
        acc0[tt] = v0; acc1[tt] = v1;
    }
    const int n0 = DIR == 0 ? L - 32 - 32 * ci : L + 32 * ci;
    bf16_t* r0 = T + (size_t)c * (2 * L) + n0; bf16_t* r1 = r0 + 2 * L;
#pragma unroll
    for (int q = 0; q < 4; ++q) {
        u32x4 a, b;
        if (DIR == 0) {
            a.x = pk2(acc0[31 - (8 * q + 0)], acc0[31 - (8 * q + 1)]); a.y = pk2(acc0[31 - (8 * q + 2)], acc0[31 - (8 * q + 3)]); a.z = pk2(acc0[31 - (8 * q + 4)], acc0[31 - (8 * q + 5)]); a.w = pk2(acc0[31 - (8 * q + 6)], acc0[31 - (8 * q + 7)]);
            b.x = pk2(acc1[31 - (8 * q + 0)], acc1[31 - (8 * q + 1)]); b.y = pk2(acc1[31 - (8 * q + 2)], acc1[31 - (8 * q + 3)]); b.z = pk2(acc1[31 - (8 * q + 4)], acc1[31 - (8 * q + 5)]); b.w = pk2(acc1[31 - (8 * q + 6)], acc1[31 - (8 * q + 7)]);
        } else {
            a.x = pk2(acc0[8 * q + 0], acc0[8 * q + 1]); a.y = pk2(acc0[8 * q + 2], acc0[8 * q + 3]); a.z = pk2(acc0[8 * q + 4], acc0[8 * q + 5]); a.w = pk2(acc0[8 * q + 6], acc0[8 * q + 7]);
            b.x = pk2(acc1[8 * q + 0], acc1[8 * q + 1]); b.y = pk2(acc1[8 * q + 2], acc1[8 * q + 3]); b.z = pk2(acc1[8 * q + 4], acc1[8 * q + 5]); b.w = pk2(acc1[8 * q + 6], acc1[8 * q + 7]);
        }
        *(u32x4*)(r0 + 8 * q) = a; *(u32x4*)(r1 + 8 * q) = b;
    }
    __syncthreads();
}

namespace att {
using s16x4 = __attribute__((ext_vector_type(4))) short;
using f32x16 = __attribute__((ext_vector_type(16))) float;
constexpr int D = 128, QBLK = 32, KVBLK = 64;
constexpr float SCALE = 0.088388347648318440f, THR = 8.f;
constexpr size_t SHM_V = KVBLK * D * 2, SHM_K = KVBLK * D * 2, SHM_ATTN = 2 * SHM_V + 2 * SHM_K + NW * 64 * 4;
#define KSWZ(row, colB) ((row) * 256 + ((colB) ^ (((row) & 7) << 4)))
#define SBAR() __builtin_amdgcn_sched_barrier(0)
__device__ __forceinline__ int crow(int r, int hi) { return (r & 3) + 8 * (r >> 2) + 4 * hi; }
__device__ __forceinline__ void partialSM(f32x16& p0, f32x16& p1, float& m_reg, float& mn, float& alpha) {
  constexpr float C = SCALE * 1.4426950408889634f;
  float pmax = p0[0];
#pragma unroll
  for (int r = 1; r < 16; ++r) pmax = fmaxf(pmax, p0[r]);
#pragma unroll
  for (int r = 0; r < 16; ++r) pmax = fmaxf(pmax, p1[r]);
  { auto rr = __builtin_amdgcn_permlane32_swap(__float_as_uint(pmax), __float_as_uint(pmax), false, false);
    pmax = fmaxf(__uint_as_float(rr[0]), __uint_as_float(rr[1])); }
  if (__builtin_expect(__all(pmax - m_reg <= THR / SCALE), 1)) { mn = m_reg; alpha = 1.f; }
  else { mn = fmaxf(m_reg, pmax); alpha = __builtin_amdgcn_exp2f((m_reg - mn) * C); m_reg = mn; }
  float mnC = -mn * C;
#pragma unroll
  for (int r = 0; r < 16; ++r) p0[r] = fmaf(p0[r], C, mnC);
#pragma unroll
  for (int r = 0; r < 16; ++r) p1[r] = fmaf(p1[r], C, mnC);
#pragma unroll
  for (int r = 0; r < 16; ++r) p0[r] = __builtin_amdgcn_exp2f(p0[r]);
}
__device__ __forceinline__ void finishSM(f32x16& p0, f32x16& p1, float alpha, float& l_reg, bf16x8& pa0, bf16x8& pa1, bf16x8& pa2, bf16x8& pa3) {
#pragma unroll
  for (int r = 0; r < 16; ++r) p1[r] = __builtin_amdgcn_exp2f(p1[r]);
  float ps = 0;
#pragma unroll
  for (int r = 0; r < 16; ++r) ps += p0[r];
#pragma unroll
  for (int r = 0; r < 16; ++r) ps += p1[r];
  { auto rr = __builtin_amdgcn_permlane32_swap(__float_as_uint(ps), __float_as_uint(ps), false, false);
    ps = __uint_as_float(rr[0]) + __uint_as_float(rr[1]); }
  l_reg = l_reg * alpha + ps;
#define PK4(P, BASE, OUT) do { unsigned a0 = cvt_pk(P[BASE + 0], P[BASE + 1]), a1 = cvt_pk(P[BASE + 2], P[BASE + 3]);   \
    unsigned b0 = cvt_pk(P[BASE + 4], P[BASE + 5]), b1 = cvt_pk(P[BASE + 6], P[BASE + 7]);                              \
    auto r0 = __builtin_amdgcn_permlane32_swap(a0, b0, false, false); auto r1 = __builtin_amdgcn_permlane32_swap(a1, b1, false, false); \
    u32x4 w = {r0[0], r1[0], r0[1], r1[1]}; OUT = *reinterpret_cast<bf16x8*>(&w); } while (0)
  PK4(p0, 0, pa0); PK4(p0, 8, pa1); PK4(p1, 0, pa2); PK4(p1, 8, pa3);
#undef PK4
}
__device__ __forceinline__ void qkt(f32x16& p0, f32x16& p1, const bf16_t* Ks, const bf16x8* qr, int r32, int hi) {
  p0 = f32x16{}; p1 = f32x16{};
#pragma unroll
  for (int d0 = 0; d0 < 8; ++d0) { int cb = (d0 * 16 + hi * 8) * 2;
    bf16x8 b0 = *reinterpret_cast<const bf16x8*>((const char*)Ks + KSWZ(r32, cb));
    bf16x8 b1 = *reinterpret_cast<const bf16x8*>((const char*)Ks + KSWZ(32 + r32, cb));
    p0 = __builtin_amdgcn_mfma_f32_32x32x16_bf16(b0, qr[d0], p0, 0, 0, 0);
    p1 = __builtin_amdgcn_mfma_f32_32x32x16_bf16(b1, qr[d0], p1, 0, 0, 0); }
}
__device__ __forceinline__ int v_st(int k, int c) { const int kk = (k & ~0xC) | ((k & 4) << 1) | ((k & 8) >> 1); return ((kk >> 3) * 4 + (c >> 5)) * 512 + ((kk & 7) * 32 + (c & 31)) * 2; }
__device__ __forceinline__ int v_rd_base(int lane) { return ((lane & 3) << 3) | (((lane >> 2) & 3) << 6) | (((lane >> 4) & 1) << 5) | (((lane >> 5) & 1) << 8); }
constexpr int v_rd_off(int d0, int ks, int half) { return d0 * 512 + ks * 4096 + half * 2048; }
template <int OFF> __device__ __forceinline__ s16x4 tr_read(int vb) {
  s16x4 r; asm volatile("ds_read_b64_tr_b16 %0, %1 offset:%2" : "=&v"(r) : "v"(vb), "i"(OFF) : "memory"); return r;
}
template <int D0> __device__ __forceinline__ void pv_one(f32x16& od, int vb, bf16x8 pa0, bf16x8 pa1, bf16x8 pa2, bf16x8 pa3) {
  const s16x4 l0 = tr_read<v_rd_off(D0, 0, 0)>(vb), h0 = tr_read<v_rd_off(D0, 0, 1)>(vb), l1 = tr_read<v_rd_off(D0, 1, 0)>(vb), h1 = tr_read<v_rd_off(D0, 1, 1)>(vb);
  const s16x4 l2 = tr_read<v_rd_off(D0, 2, 0)>(vb), h2 = tr_read<v_rd_off(D0, 2, 1)>(vb), l3 = tr_read<v_rd_off(D0, 3, 0)>(vb), h3 = tr_read<v_rd_off(D0, 3, 1)>(vb);
  asm volatile("s_waitcnt lgkmcnt(0)" ::: "memory"); SBAR();
#define PK(L, H) (bf16x8){L[0], L[1], L[2], L[3], H[0], H[1], H[2], H[3]}
  od = __builtin_amdgcn_mfma_f32_32x32x16_bf16(pa0, PK(l0, h0), od, 0, 0, 0);
  od = __builtin_amdgcn_mfma_f32_32x32x16_bf16(pa1, PK(l1, h1), od, 0, 0, 0);
  od = __builtin_amdgcn_mfma_f32_32x32x16_bf16(pa2, PK(l2, h2), od, 0, 0, 0);
  od = __builtin_amdgcn_mfma_f32_32x32x16_bf16(pa3, PK(l3, h3), od, 0, 0, 0);
#undef PK
}
__device__ __forceinline__ void pv_d0(f32x16* o, int vb, bf16x8 pa0, bf16x8 pa1, bf16x8 pa2, bf16x8 pa3) {
  pv_one<0>(o[0], vb, pa0, pa1, pa2, pa3); pv_one<1>(o[1], vb, pa0, pa1, pa2, pa3); pv_one<2>(o[2], vb, pa0, pa1, pa2, pa3); pv_one<3>(o[3], vb, pa0, pa1, pa2, pa3);
}
__device__ __forceinline__ void attn_body(const bf16_t* __restrict__ Qb, int ldq, const bf16_t* __restrict__ Kh, const bf16_t* __restrict__ Vh, int ldk,
                                          const bf16_t* __restrict__ Gb, int ldg, bf16_t* __restrict__ Ob, int ldo, int seq, char* lds, float* __restrict__ Opart, float* __restrict__ MLpart) {
  int tid = threadIdx.x; asm volatile("" : "+v"(tid));
  const int wid = tid >> 6, lane = tid & 63, r32 = lane & 31, hi = lane >> 5;
  bf16_t* V_lds = (bf16_t*)lds; bf16_t* K_lds = (bf16_t*)(lds + 2 * SHM_V);
  float* wsf = (float*)(lds + 2 * SHM_V + 2 * SHM_K) + wid * 64; float* li_l = wsf; float* al_l = wsf + 32;
  float m_reg = -1e30f, l_reg = 0; f32x16 o[4] = {}; bf16x8 qr[8];
  const bf16_t* Qw = Qb + (long)(wid * QBLK + r32) * ldq + hi * 8;
#pragma unroll
  for (int d0 = 0; d0 < 8; ++d0) qr[d0] = *reinterpret_cast<const bf16x8*>(Qw + d0 * 16);
  const int sr = tid >> 4, sc = (tid & 15) * 8, vst0 = v_st(sr, sc), vst1 = v_st(32 + sr, sc);
  const int vb0 = (int)(uintptr_t)V_lds + v_rd_base(lane);
  constexpr int SDEPTH = 1;
  struct { bf16x8 vs0, vs1, ks0, ks1; } sr_[SDEPTH];
  const unsigned kvoff0 = (unsigned)(sr * ldk + sc) * 2u, kvoff1 = kvoff0 + (unsigned)(64 * ldk);
#define SLOAD(i, k0) do { const char* vb_ = (const char*)Vh + (size_t)(k0) * ldk * 2; const char* kb_ = (const char*)Kh + (size_t)(k0) * ldk * 2; \
    sr_[i].vs0 = *reinterpret_cast<const bf16x8*>(vb_ + kvoff0); sr_[i].vs1 = *reinterpret_cast<const bf16x8*>(vb_ + kvoff1); \
    sr_[i].ks0 = *reinterpret_cast<const bf16x8*>(kb_ + kvoff0); sr_[i].ks1 = *reinterpret_cast<const bf16x8*>(kb_ + kvoff1); } while (0)
#define SWRITE(b, i) do { *(bf16x8*)((char*)V_lds + (b) * SHM_V + vst0) = sr_[i].vs0;          \
    *(bf16x8*)((char*)V_lds + (b) * SHM_V + vst1) = sr_[i].vs1; int kc = sc * 2;               \
    *(bf16x8*)((char*)K_lds + (b) * SHM_K + KSWZ(sr, kc)) = sr_[i].ks0;                       \
    *(bf16x8*)((char*)K_lds + (b) * SHM_K + KSWZ(32 + sr, kc)) = sr_[i].ks1; } while (0)
#define SWAIT() do { if constexpr (SDEPTH == 2) asm volatile("s_waitcnt vmcnt(4)" ::: "memory"); else asm volatile("s_waitcnt vmcnt(0)" ::: "memory"); } while (0)
#define RESC(a) do { if (__any((a) < 1.f)) { if (hi == 0) al_l[r32] = (a); asm volatile("s_waitcnt lgkmcnt(0)" ::: "memory"); \
    _Pragma("unroll") for (int d = 0; d < 4; ++d) _Pragma("unroll") for (int r = 0; r < 16; ++r) o[d][r] *= al_l[crow(r, hi)]; } } while (0)
  f32x16 pA0, pA1, pB0, pB1; float mnA, mnB, alA, alB; bf16x8 pa0, pa1, pa2, pa3; const int NTL = seq / KVBLK;
  constexpr int SE = 0, SO = SDEPTH - 1;
  SLOAD(SE, 0); asm volatile("s_waitcnt vmcnt(0)" ::: "memory"); SWRITE(0, SE); __syncthreads();
  qkt(pA0, pA1, K_lds, qr, r32, hi); partialSM(pA0, pA1, m_reg, mnA, alA);
  SLOAD(SO, KVBLK); if constexpr (SDEPTH == 2) { if (2 < NTL) SLOAD(SE, 2 * KVBLK); }
  SWAIT(); SWRITE(1, SO); __syncthreads();
  for (int j = 1; j + 1 < NTL; j += 2) {
    SBAR(); qkt(pB0, pB1, (bf16_t*)((char*)K_lds + SHM_K), qr, r32, hi);
    finishSM(pA0, pA1, alA, l_reg, pa0, pa1, pa2, pa3); SBAR();
    SLOAD(SO, (j + SDEPTH) * KVBLK); SBAR();
    pv_d0(o, vb0, pa0, pa1, pa2, pa3); partialSM(pB0, pB1, m_reg, mnB, alB);
    __syncthreads(); SWAIT(); SWRITE(0, SE);
    RESC(alB); __syncthreads();
    SBAR(); qkt(pA0, pA1, K_lds, qr, r32, hi);
    finishSM(pB0, pB1, alB, l_reg, pa0, pa1, pa2, pa3); SBAR();
    if (SDEPTH == 1 || j + 3 < NTL) SLOAD(SE, (j + 1 + SDEPTH) * KVBLK); SBAR();
    pv_d0(o, vb0 + (int)SHM_V, pa0, pa1, pa2, pa3); partialSM(pA0, pA1, m_reg, mnA, alA);
    __syncthreads(); SWAIT(); SWRITE(1, SO);
    RESC(alA); __syncthreads();
  }
  SBAR(); qkt(pB0, pB1, (bf16_t*)((char*)K_lds + SHM_K), qr, r32, hi);
  finishSM(pA0, pA1, alA, l_reg, pa0, pa1, pa2, pa3); SBAR();
  pv_d0(o, vb0, pa0, pa1, pa2, pa3); partialSM(pB0, pB1, m_reg, mnB, alB);
  __syncthreads(); RESC(alB);
  finishSM(pB0, pB1, alB, l_reg, pa0, pa1, pa2, pa3); SBAR();
  pv_d0(o, vb0 + (int)SHM_V, pa0, pa1, pa2, pa3);
  if (Opart) {
    float* Ow = Opart + (long)(wid * QBLK) * D;
#pragma unroll
    for (int r = 0; r < 16; ++r) { const int orow = crow(r, hi);
#pragma unroll
      for (int d0 = 0; d0 < 4; ++d0) Ow[orow * D + d0 * 32 + r32] = o[d0][r]; }
    if (hi == 0) *(f32x2*)(MLpart + (wid * QBLK + r32) * 2) = (f32x2){m_reg, l_reg};
    __syncthreads();
    return;
  }
  if (hi == 0) li_l[r32] = l_reg; asm volatile("s_waitcnt lgkmcnt(0)" ::: "memory");
  float rli[16];
#pragma unroll
  for (int r = 0; r < 16; ++r) rli[r] = __builtin_amdgcn_rcpf(li_l[crow(r, hi)]);
  bf16_t* Ow = Ob + (long)(wid * QBLK) * ldo; const bf16_t* Gw = Gb + (long)(wid * QBLK) * ldg;
  bf16_t* stg = K_lds + wid * 2048;
#pragma unroll
  for (int ph = 0; ph < 2; ++ph) {
#pragma unroll
    for (int r = 0; r < 16; ++r) { const int orow = crow(r, hi);
#pragma unroll
      for (int dd = 0; dd < 2; ++dd) stg[orow * 64 + dd * 32 + r32] = (bf16_t)f2bf(o[2 * ph + dd][r] * rli[r]); }
    asm volatile("s_waitcnt lgkmcnt(0)" ::: "memory");
#pragma unroll
    for (int i = 0; i < 4; ++i) { const int row = i * 8 + (lane >> 3), ch = lane & 7;
      const u32x4 ov = *(const u32x4*)(stg + row * 64 + ch * 8), g = *(const u32x4*)(Gw + (long)row * ldg + ph * 64 + ch * 8);
      u32x4 w; w.x = cvt_pk(bflo(ov.x) * bflo(g.x), bfhi(ov.x) * bfhi(g.x)); w.y = cvt_pk(bflo(ov.y) * bflo(g.y), bfhi(ov.y) * bfhi(g.y));
      w.z = cvt_pk(bflo(ov.z) * bflo(g.z), bfhi(ov.z) * bfhi(g.z)); w.w = cvt_pk(bflo(ov.w) * bflo(g.w), bfhi(ov.w) * bfhi(g.w));
      *(u32x4*)(Ow + (long)row * ldo + ph * 64 + ch * 8) = w; }
    asm volatile("s_waitcnt lgkmcnt(0)" ::: "memory");
  }
  __syncthreads();
#undef SLOAD
#undef SWRITE
#undef SWAIT
#undef RESC
}
#undef KSWZ
#undef SBAR
}

namespace hy {
using f32x16 = __attribute__((ext_vector_type(16))) float;
constexpr int Z_OFF = 0, T_OFF = 65536, TW = 8448, ZERO_OFF = T_OFF + 8 * TW;
template <int L>
__device__ __forceinline__ void unit(const Params& p, int layer, int base, int cg, LAS unsigned char* lds, const bf16_t* P, bf16_t* HM, const bf16_t* Tl) {
    constexpr int NB = L / 32, NP = L / 256, C1OFF = 4 * L + 68;
    int tid = threadIdx.x; asm volatile("" : "+v"(tid));
    const int lane = tid & 63, wave = __builtin_amdgcn_readfirstlane(tid >> 6);
#define HY_MARK(id) do { if ((TS_J) != 0 && (int)blockIdx.x == (TS_BLK) && threadIdx.x == 0) { const unsigned long long t_ = __builtin_amdgcn_s_memrealtime(); ((volatile LAS unsigned*)(lds + MISC_OFF))[16 + 2 * (id)] = (unsigned)t_; ((volatile LAS unsigned*)(lds + MISC_OFF))[17 + 2 * (id)] = (unsigned)(t_ >> 32); } } while (0)
    HY_MARK(23);
    const float* cw = p.in[12] + (size_t)layer * 3 * 3072; const float* cb = p.in[13] + layer * 3072;
    u32x4 d[NP];
    { const unsigned char* Tsrc = (const unsigned char*)(Tl + (size_t)(cg * 32 + wave * 4) * (2 * L));
#pragma unroll
      for (int i = 0; i < NP; ++i) d[i] = *(const u32x4*)(Tsrc + i * 1024 + lane * 16); }
    {
        const int q = tid >> 2, oct = tid & 3, n = q >> 2, c = q & 3, T0 = n * 32 + c * 8, ch0 = cg * 32 + oct * 8;
        if (tid < 16) *(LAS unsigned*)(lds + ZERO_OFF + tid * 4) = 0u;
        const bf16_t* src = P + (size_t)(base + T0) * DIN + OFF_HY + ch0;
        const bool has_prev = (T0 & (L - 1)) != 0, has_next = ((T0 + 8) & (L - 1)) != 0;
        u32x4 r1[10], r2[10];
#pragma unroll
        for (int j = 0; j < 10; ++j) {
            const bool ok = (j == 0) ? has_prev : (j == 9 ? has_next : true);
            if (ok) { r1[j] = *(const u32x4*)(src + (long)(j - 1) * DIN + DHY); r2[j] = *(const u32x4*)(src + (long)(j - 1) * DIN + 2 * DHY); }
            else { r1[j] = (u32x4){0u, 0u, 0u, 0u}; r2[j] = (u32x4){0u, 0u, 0u, 0u}; }
        }
        f32x4 W1[3][2], W2[3][2], B1[2], B2[2];
#pragma unroll
        for (int i = 0; i < 2; ++i) { B1[i] = *(const f32x4*)(cb + DHY + ch0 + 4 * i); B2[i] = *(const f32x4*)(cb + 2 * DHY + ch0 + 4 * i);
#pragma unroll
            for (int tp = 0; tp < 3; ++tp) { W1[tp][i] = *(const f32x4*)(cw + tp * 3072 + DHY + ch0 + 4 * i); W2[tp][i] = *(const f32x4*)(cw + tp * 3072 + 2 * DHY + ch0 + 4 * i); } }
#pragma unroll
        for (int cc = 0; cc < 8; ++cc) {
            const float w10 = W1[0][cc >> 2][cc & 3], w11 = W1[1][cc >> 2][cc & 3], w12 = W1[2][cc >> 2][cc & 3], b1 = B1[cc >> 2][cc & 3];
            const float w20 = W2[0][cc >> 2][cc & 3], w21 = W2[1][cc >> 2][cc & 3], w22 = W2[2][cc >> 2][cc & 3], b2 = B2[cc >> 2][cc & 3];
            float x1[10], x2[10];
#pragma unroll
            for (int j = 0; j < 10; ++j) { const unsigned a = r1[j][cc >> 1], b = r2[j][cc >> 1]; x1[j] = (cc & 1) ? bfhi(a) : bflo(a); x2[j] = (cc & 1) ? bfhi(b) : bflo(b); }
            float z[8];
#pragma unroll
            for (int e = 0; e < 8; ++e) { const float u1 = b1 + w10 * x1[e] + w11 * x1[e + 1] + w12 * x1[e + 2], u2 = b2 + w20 * x2[e] + w21 * x2[e + 1] + w22 * x2[e + 2]; z[e] = u1 * u2; }
            u32x4 w; w.x = cvt_pk(z[0], z[1]); w.y = cvt_pk(z[2], z[3]); w.z = cvt_pk(z[4], z[5]); w.w = cvt_pk(z[6], z[7]);
            *(LAS u32x4*)(lds + Z_OFF + (oct * 8 + cc) * 2048 + n * 64 + ((c ^ ((n >> 2) & 3)) << 4)) = w;
        }
    }
    __syncthreads();
    HY_MARK(24);
    {
        LAS unsigned char* tw = lds + T_OFF + wave * TW;
        const int r = lane & 31, h = lane >> 5, e = r & 1;
        for (int ci = 0; ci < 4; ++ci) {
            const int chl = wave * 4 + ci, ch = cg * 32 + chl;
#pragma unroll
            for (int i = 0; i < NP; ++i) {
                *(LAS u32x4*)(tw + i * 1024 + lane * 16) = d[i];
                unsigned nx = (unsigned)__builtin_amdgcn_ds_bpermute(((lane + 1) & 63) << 2, (int)d[i].x);
                const unsigned nfirst = (i + 1 < NP) ? (unsigned)__builtin_amdgcn_readlane((int)d[(i + 1 < NP) ? i + 1 : i].x, 0) : 0u;
                if (lane == 63) nx = nfirst;
                LAS unsigned* o = (LAS unsigned*)(tw + C1OFF + i * 1024 + lane * 16);
                o[0] = __builtin_amdgcn_alignbit(d[i].y, d[i].x, 16); o[1] = __builtin_amdgcn_alignbit(d[i].z, d[i].y, 16);
                o[2] = __builtin_amdgcn_alignbit(d[i].w, d[i].z, 16); o[3] = __builtin_amdgcn_alignbit(nx, d[i].w, 16);
            }
            LDS_WAIT(); __builtin_amdgcn_wave_barrier();
            if (ci < 3) { const unsigned char* Tsrc = (const unsigned char*)(Tl + (size_t)(ch + 1) * (2 * L));
#pragma unroll
                for (int i = 0; i < NP; ++i) d[i] = *(const u32x4*)(Tsrc + i * 1024 + lane * 16); }
            const LAS unsigned char* aBase = tw + e * C1OFF + ((((L - r - e) >> 1) + 4 * h) << 2);
            const LAS unsigned char* zc = lds + Z_OFF + chl * 2048;
            f32x16 acc0 = {}, acc1 = {};
#pragma unroll 3
            for (int k = -(NB - 1); k <= NB - 1; ++k) {
                const int np = r - k;
                const bool valid = (L == 1024) ? ((unsigned)np < 32u) : ((unsigned)((r & 7) - k) < 8u);
                const int c0 = h ^ ((np >> 2) & 3);
                const LAS unsigned char* zp = zc + np * 64;
                const LAS unsigned char* z0 = valid ? zp + (c0 << 4) : lds + ZERO_OFF;
                const LAS unsigned char* z1 = valid ? zp + ((c0 ^ 2) << 4) : lds + ZERO_OFF;
                const LAS unsigned* ap = (const LAS unsigned*)(aBase - 64 * k);
                const u32x4 a0 = {ap[0], ap[1], ap[2], ap[3]}, a1 = {ap[8], ap[9], ap[10], ap[11]};
                const bf16x8 b0 = *(const LAS bf16x8*)z0, b1 = *(const LAS bf16x8*)z1;
                acc0 = __builtin_amdgcn_mfma_f32_32x32x16_bf16(__builtin_bit_cast(bf16x8, a0), b0, acc0, 0, 0, 0);
                acc1 = __builtin_amdgcn_mfma_f32_32x32x16_bf16(__builtin_bit_cast(bf16x8, a1), b1, acc1, 0, 0, 0);
            }
#pragma unroll
            for (int q = 0; q < 4; ++q) {
                u32x2 w; w.x = cvt_pk(acc0[4 * q] + acc1[4 * q], acc0[4 * q + 1] + acc1[4 * q + 1]); w.y = cvt_pk(acc0[4 * q + 2] + acc1[4 * q + 2], acc0[4 * q + 3] + acc1[4 * q + 3]);
                *(LAS u32x2*)(lds + Z_OFF + chl * 2048 + r * 64 + ((q ^ ((r >> 2) & 3)) << 4) + h * 8) = w;
            }
            LDS_WAIT(); __builtin_amdgcn_wave_barrier();
        }
    }
    __syncthreads();
    HY_MARK(25);
    {
        const int oct = tid & 3, ch0 = cg * 32 + oct * 8;
        f32x4 w0[2], w1[2], w2[2], bb[2];
#pragma unroll
        for (int i = 0; i < 2; ++i) { w0[i] = *(const f32x4*)(cw + ch0 + 4 * i); w1[i] = *(const f32x4*)(cw + 3072 + ch0 + 4 * i); w2[i] = *(const f32x4*)(cw + 2 * 3072 + ch0 + 4 * i); bb[i] = *(const f32x4*)(cb + ch0 + 4 * i); }
        for (int it0 = 0; it0 < 8; it0 += 4) {
            u32x4 xp[4], xc[4], xn[4], gh[4];
#pragma unroll
            for (int q = 0; q < 4; ++q) {
                const int T = (tid >> 2) + 128 * (it0 + q);
                const bf16_t* src = P + (size_t)(base + T) * DIN + OFF_HY + ch0;
                const bool has_prev = (T & (L - 1)) != 0, has_next = ((T + 1) & (L - 1)) != 0;
                xc[q] = *(const u32x4*)src;
                xp[q] = *(const u32x4*)(has_prev ? src - DIN : src);
                xn[q] = *(const u32x4*)(has_next ? src + DIN : src);
                if (!has_prev) xp[q] = (u32x4){0u, 0u, 0u, 0u};
                if (!has_next) xn[q] = (u32x4){0u, 0u, 0u, 0u};
                gh[q] = *(const u32x4*)(P + (size_t)(base + T) * DIN + OFF_GH + ch0);
            }
#pragma unroll
            for (int q = 0; q < 4; ++q) {
                const int T = (tid >> 2) + 128 * (it0 + q), n = T >> 5, i = T & 31;
                const LAS unsigned char* yb = lds + Z_OFF + (oct * 8) * 2048 + n * 64 + (((i >> 3) ^ ((n >> 2) & 3)) << 4) + (i & 7) * 2;
                float o[8];
#pragma unroll
                for (int cc = 0; cc < 8; ++cc) {
                    const unsigned a = xp[q][cc >> 1], b = xc[q][cc >> 1], c2 = xn[q][cc >> 1], g = gh[q][cc >> 1];
                    const float fp = (cc & 1) ? bfhi(a) : bflo(a), fc = (cc & 1) ? bfhi(b) : bflo(b), fn = (cc & 1) ? bfhi(c2) : bflo(c2), fg = (cc & 1) ? bfhi(g) : bflo(g);
                    const float x0 = bb[cc >> 2][cc & 3] + w0[cc >> 2][cc & 3] * fp + w1[cc >> 2][cc & 3] * fc + w2[cc >> 2][cc & 3] * fn;
                    const float y = bf2f(*(const LAS unsigned short*)(yb + cc * 2048));
                    o[cc] = x0 * y * fg;
                }
                u32x4 w; w.x = cvt_pk(o[0], o[1]); w.y = cvt_pk(o[2], o[3]); w.z = cvt_pk(o[4], o[5]); w.w = cvt_pk(o[6], o[7]);
                *(u32x4*)(HM + (size_t)(base + T) * DM + DHY + ch0) = w;
            }
        }
    }
    __syncthreads();
    HY_MARK(26);
}
}

__device__ __forceinline__ void prep_wave_items(const Params& p, int l, bool do_gemv, bool do_win, bool do_wout, bool do_common, int widx, int nw, int lane,
                                                LAS float* scr, const LAS float* sc, unsigned char* ws) {
    bf16_t* WinT = (bf16_t*)(ws + WS_WIN); bf16_t* WoutT = (bf16_t*)(ws + WS_WOUT); bf16_t* KL = (bf16_t*)(ws + WS_KL); bf16_t* VL = (bf16_t*)(ws + WS_VL);
    float* modp = (float*)(ws + WS_MODP); float* rope = (float*)(ws + WS_ROPE);
    constexpr int I_WIN = (DM / 64) * (DIN / 64), I_WOUT = (DM / 64) * (DM / 64), I_CACHE = 2 * 2 * 2 * PAST, I_ROPE = 0;
    const int n_gemv = do_gemv ? 48 * MODP : 0, n_win = do_win ? I_WIN : 0, n_wout = do_wout ? I_WOUT : 0, n_common = do_common ? I_CACHE + I_ROPE : 0;
    const int total = n_gemv + n_win + n_wout + n_common;
    for (int it = widx; it < total; it += nw) {
        int r = it;
        if (r < n_gemv) {
            const int nc = r % 48, kc = r / 48, kh = lane >> 5, c4 = (lane & 31) * 4;
            const float* w = p.in[7] + ((size_t)l * DM + kc * (DM / MODP) + kh) * (3 * DM) + nc * 128 + c4;
            f32x4 a0 = {0.f, 0.f, 0.f, 0.f}, a1 = a0, a2 = a0;
#pragma unroll 16
            for (int k = 0; k < DM / MODP / 2; ++k) {
                const f32x4 wv = *(const GAS f32x4*)((const GAS float*)w + (size_t)(2 * k) * (3 * DM));
                const int kk = kc * (DM / MODP) + 2 * k + kh;
                a0 += wv * sc[kk]; a1 += wv * sc[DM + kk]; a2 += wv * sc[2 * DM + kk];
            }
#pragma unroll
            for (int e = 0; e < 4; ++e) { a0[e] += shx(a0[e], 32, lane); a1[e] += shx(a1[e], 32, lane); a2[e] += shx(a2[e], 32, lane); }
            if (lane < 32) {
                float* o = modp + ((size_t)(l * MODP + kc) * 3) * (3 * DM) + nc * 128 + c4;
                *(f32x4*)o = a0; *(f32x4*)(o + 3 * DM) = a1; *(f32x4*)(o + 2 * 3 * DM) = a2;
            }
            continue;
        }
        r -= n_gemv;
        if (r < n_win) { p0_transpose_item(p.in[9] + (size_t)l * DM * DIN, DM, DIN, WinT + (size_t)l * DIN * DM, scr, r, lane); continue; }
        r -= n_win;
        if (r < n_wout) { p0_transpose_item(p.in[21] + (size_t)l * DM * DM, DM, DM, WoutT + (size_t)l * DM * DM, scr, r, lane); continue; }
        r -= n_wout;
        if (r < I_CACHE) {
            const int s_ = r % PAST, l2 = (r / PAST) & 1, b = (r / (2 * PAST)) & 1, which = r / (4 * PAST);
            const float* src = p.in[2 + which] + (((size_t)b * 2 + l2) * PAST + s_) * DKV + lane * 8;
            const f32x4 v0 = *(const f32x4*)src, v1 = *(const f32x4*)(src + 4);
            u32x4 w; w.x = pk2(v0[0], v0[1]); w.y = pk2(v0[2], v0[3]); w.z = pk2(v1[0], v1[1]); w.w = pk2(v1[2], v1[3]);
            bf16_t* dst = (which ? VL : KL) + (((size_t)l2 * 2 + b) * KVL + LS + s_) * DKV + lane * 8;
            *(u32x4*)dst = w;
            continue;
        }
        r -= I_CACHE;
        { (void)rope; }
    }
}
__device__ __forceinline__ void mod_reduce(const Params& p, int l, int idx, unsigned char* ws) {
    const float* modp = (const float*)(ws + WS_MODP); float* modf = (float*)(ws + WS_MODF);
    if (idx < 3 * 3 * DM) {
        const int n = idx % (3 * DM), j = idx / (3 * DM); float sacc = p.in[8][l * 3 * DM + n];
#pragma unroll 8
        for (int q = 0; q < MODP; ++q) sacc += modp[((size_t)(l * MODP + q) * 3 + j) * (3 * DM) + n];
        modf[(size_t)l * 3 * 3 * DM + idx] = sacc;
    }
}
#define LOAD_SILU_C(sc_) do { for (int i_ = tid; i_ < DM; i_ += NT) { (sc_)[i_] = silu_f(p.in[5][i_]); (sc_)[DM + i_] = silu_f(p.in[4][i_]); (sc_)[2 * DM + i_] = silu_f(p.in[4][DM + i_]); } __syncthreads(); } while (0)

#define XB_TMO      128
#define XB_XCNT(j)  (256  + 64 * (j))
#define XB_XSUB(j)  (1280 + 64 * (j))
#define XB_XGEN(j)  (2304 + 64 * (j))
#define XB_TOP      3328
#define XB_TOPGEN   3392
#define XCD_BAR_WORDS 3456
#define XB_SPIN_CAP (1u << 18)
__device__ __forceinline__ unsigned xb_ld(unsigned* p)              { return __hip_atomic_load(p, __ATOMIC_RELAXED, __HIP_MEMORY_SCOPE_AGENT); }
__device__ __forceinline__ unsigned xb_add(unsigned* p, unsigned v) { return __hip_atomic_fetch_add(p, v, __ATOMIC_RELAXED, __HIP_MEMORY_SCOPE_AGENT); }
__device__ __forceinline__ unsigned xb_xcc_id() { return (unsigned)__builtin_amdgcn_s_getreg((3 << 11) | 20) & 0xFu; }
#define XB_SPIN(cond, bar) do { unsigned _sp = 0; while (cond) { __builtin_amdgcn_s_sleep(1); \
    if ((++_sp & 255u) == 0u) { if (xb_ld(&(bar)[XB_TMO])) break; if (_sp > XB_SPIN_CAP) { atomicAdd(&(bar)[XB_TMO], 1u); break; } } } } while (0)
struct XcdBarrier { unsigned* bar; unsigned x; volatile LAS unsigned* st; };
__device__ __forceinline__ XcdBarrier xcd_barrier_post(unsigned* bar, volatile LAS unsigned* st) {
    XcdBarrier b; b.bar = bar; b.x = xb_xcc_id(); b.st = st;
    if (threadIdx.x == 0) (void)xb_add(&bar[XB_XCNT(b.x)], 1u);
    return b;
}
__device__ __forceinline__ void xcd_barrier_complete(unsigned* bar, unsigned x, unsigned& nloc, unsigned& nx) {
    const unsigned G = gridDim.x * gridDim.y * gridDim.z;
    unsigned sum, cnt, mine, sp = 0u;
    for (;;) {
        sum = 0u; cnt = 0u; mine = 0u;
#pragma unroll
        for (unsigned j = 0; j < 16; ++j) { const unsigned c = xb_ld(&bar[XB_XCNT(j)]); sum += c; cnt += (c > 0u) ? 1u : 0u; mine = (j == x) ? c : mine; }
        if (sum == G) break;
        __builtin_amdgcn_s_sleep(1);
        if ((++sp & 255u) == 0u) { if (xb_ld(&bar[XB_TMO])) break; if (sp > XB_SPIN_CAP) { atomicAdd(&bar[XB_TMO], 1u); break; } }
    }
    nloc = mine > 0u ? mine : 1u; nx = cnt > 0u ? cnt : 1u;
}
__device__ __forceinline__ void xcd_barrier(const XcdBarrier& b) {
    asm volatile("s_waitcnt vmcnt(0)" ::: "memory");
    __syncthreads();
    int t0_ = threadIdx.x; asm volatile("" : "+v"(t0_));
    if (t0_ == 0) {
        unsigned* bar = b.bar;
        __builtin_amdgcn_s_waitcnt(0);
        unsigned nloc = b.st[0], nx = b.st[1];
        if (nloc == 0u) { xcd_barrier_complete(bar, b.x, nloc, nx); b.st[0] = nloc; b.st[1] = nx; }
        const unsigned old = xb_add(&bar[XB_XSUB(b.x)], 1u);
        const unsigned gen = old / nloc;
        if (old + 1u == (gen + 1u) * nloc) {
            __builtin_amdgcn_fence(__ATOMIC_RELEASE, "agent");
            asm volatile("s_waitcnt vmcnt(0)" ::: "memory");
            const unsigned og = xb_add(&bar[XB_TOP], 1u);
            const unsigned tg = og / nx;
            if (og + 1u == (tg + 1u) * nx) xb_add(&bar[XB_TOPGEN], 1u);
            else XB_SPIN(xb_ld(&bar[XB_TOPGEN]) == tg, bar);
            __builtin_amdgcn_fence(__ATOMIC_ACQUIRE, "agent");
            xb_add(&bar[XB_XGEN(b.x)], 1u);
            asm volatile("s_waitcnt vmcnt(0)" ::: "memory");
        } else {
            XB_SPIN(xb_ld(&bar[XB_XGEN(b.x)]) == gen, bar);
            __builtin_amdgcn_fence(__ATOMIC_ACQUIRE, "agent");
            asm volatile("s_waitcnt vmcnt(0)" ::: "memory");
        }
    }
    __syncthreads();
}

__global__ void __launch_bounds__(NT, 2) fwd_megakernel(Params p) {
    extern __shared__ __attribute__((aligned(16))) unsigned char lds_raw[];
    LAS unsigned char* lds = (LAS unsigned char*)lds_raw;
    if (threadIdx.x < 2) ((volatile LAS unsigned*)(lds + MISC_OFF))[threadIdx.x] = 0u;
    __syncthreads();
    (void)xcd_barrier_post((unsigned*)(p.ws + WS_BAR), (volatile LAS unsigned*)(lds + MISC_OFF));
#define GRID_SYNC() do { XcdBarrier gb_; gb_.bar = (unsigned*)(p.ws + WS_BAR); gb_.x = xb_xcc_id(); gb_.st = (volatile LAS unsigned*)(lds + MISC_OFF); xcd_barrier(gb_); } while (0)
    const int wave = __builtin_amdgcn_readfirstlane(threadIdx.x >> 6);
    const int G = gridDim.x, bx = blockIdx.x, vcu = (G % 8 == 0) ? (bx % 8) * (G / 8) + bx / 8 : bx;
    const bool split = false; const bool filt_late = false;
    const int gw = wave * G + vcu, NGW = G * NW;
#define TS_MARK(id) do { if ((TS_J) != 0 && bx == (TS_BLK) && threadIdx.x == 0) { const unsigned long long t_ = __builtin_amdgcn_s_memrealtime(); ((volatile LAS unsigned*)(lds + MISC_OFF))[16 + 2 * (id)] = (unsigned)t_; ((volatile LAS unsigned*)(lds + MISC_OFF))[17 + 2 * (id)] = (unsigned)(t_ >> 32); } } while (0)
#define PHASE_IDS() int tid = threadIdx.x; asm volatile("" : "+v"(tid)); const int lane = tid & 63; (void)lane; int gwp = gw; asm volatile("" : "+s"(gwp)); (void)gwp
    TS_MARK(0);
#define WS_PTRS() unsigned char* ws = p.ws; asm volatile("" : "+s"(ws)); \
    bf16_t* WinT = (bf16_t*)(ws + WS_WIN); bf16_t* WoutT = (bf16_t*)(ws + WS_WOUT); bf16_t* HM = (bf16_t*)(ws + WS_HM); bf16_t* P = (bf16_t*)(ws + WS_P); \
    bf16_t* KL = (bf16_t*)(ws + WS_KL); bf16_t* VL = (bf16_t*)(ws + WS_VL); float* XB = (float*)(ws + WS_XB); \
    float* modp = (float*)(ws + WS_MODP); float* modf = (float*)(ws + WS_MODF); bf16_t* Tt = (bf16_t*)(ws + WS_T); float* rope = (float*)(ws + WS_ROPE); \
    const float* x_prompt = p.in[0]; const float* x_sample = p.in[1]; \
    (void)WinT; (void)WoutT; (void)HM; (void)P; (void)KL; (void)VL; (void)XB; (void)modp; (void)modf; (void)Tt; (void)rope; (void)x_prompt; (void)x_sample

    for (int rep = 0; rep < 1 + DUP_P0; ++rep) {
        PHASE_IDS(); WS_PTRS();
        LAS float* scr = (LAS float*)(lds + wave * 8448);
        LAS float* sc = (LAS float*)(lds + 8 * 8448);
        LAS float* fscr = (LAS float*)(lds + 8 * 8448 + 3 * DM * 4);
        LOAD_SILU_C(sc);
        if (!filt_late) for (int fr_ = 0; fr_ < 1 + DUP_FILT; ++fr_) for (int fi = vcu; fi < 160; fi += G) {
            const int l = fi / 80; int r = fi % 80; int L, dir, ci; bf16_t* T = Tt + (size_t)l * T_LAYER;
            if (r < 16) { L = 256; dir = r / 8; ci = r % 8; } else { r -= 16; L = 1024; dir = r / 32; ci = r % 32; T += (size_t)DHY * 512; }
            if (dir == 0) filter_item<0>(p, l, L, ci, T, fscr); else filter_item<1>(p, l, L, ci, T, fscr);
        }
        TS_MARK(20);
        prep_wave_items(p, 0, true, true, true, true, gwp, NGW, lane, scr, sc, ws);
        TS_MARK(21);
        if (DUP_GEMV) { prep_wave_items(p, 0, true, false, false, false, gwp, NGW, lane, scr, sc, ws); prep_wave_items(p, 1, true, false, false, false, gwp, NGW, lane, scr, sc, ws); }
        if (DUP_TR) { prep_wave_items(p, 0, false, true, true, false, gwp, NGW, lane, scr, sc, ws); prep_wave_items(p, 1, false, true, true, false, gwp, NGW, lane, scr, sc, ws); }
        if (!split) prep_wave_items(p, 1, true, true, true, false, gwp, NGW, lane, scr, sc, ws);
        TS_MARK(22);
    GRID_SYNC();
    }
    TS_MARK(1);

    {
        PHASE_IDS(); WS_PTRS();
        if (vcu == 0 && tid < 32) rope[tid] = powf(10000.f, -(float)tid / 32.f) * 0.15915494309189535f;
        mod_reduce(p, 0, vcu * NT + tid, ws);
        if (!split) mod_reduce(p, 1, vcu * NT + tid, ws);
    }
    GRID_SYNC();
    TS_MARK(2);

    for (int layer = 0; layer < 2; ++layer) {
        for (int rep = 0; rep < 1 + DUP_PA; ++rep) {
            PHASE_IDS(); WS_PTRS();
            const float* ng = p.in[6] + layer * DM;
            for (int row0 = gwp; row0 < NTOK; row0 += RIF * NGW) {
                f32x4 v[RIF][8];
#pragma unroll
                for (int r = 0; r < RIF; ++r) { const int rw = row0 + r * NGW, row = rw < NTOK ? rw : NTOK - 1;
                    const float* xr = layer == 0 ? (row < NCTX ? x_prompt + (size_t)row * DM : x_sample + (size_t)(row - NCTX) * DM) : XB + (size_t)row * DM;
                    const GAS f32x4* xg = (const GAS f32x4*)xr + lane;
#pragma unroll
                    for (int i = 0; i < 8; ++i) v[r][i] = xg[64 * i]; }
                asm volatile("" ::: "memory");
#pragma unroll
                for (int r = 0; r < RIF; ++r) { const int row = row0 + r * NGW;
                    if (row < NTOK) {
                        const int j = row < NCTX ? 0 : 1 + (row - NCTX) / LS;
                        const float* mrow = modf + ((size_t)layer * 3 + j) * (3 * DM);
                        float ss = 0.f;
#pragma unroll
                        for (int i = 0; i < 8; ++i) ss += (v[r][i][0] * v[r][i][0] + v[r][i][1] * v[r][i][1]) + (v[r][i][2] * v[r][i][2] + v[r][i][3] * v[r][i][3]);
                        ss = wave_sum(ss, lane);
                        const float rs = rsqrtf(ss * (1.f / DM) + EPS);
                        f32x4 gg[8], sh[8], scl[8];
#pragma unroll
                        for (int i = 0; i < 8; ++i) { const int col = 4 * lane + 256 * i; gg[i] = *(const f32x4*)(ng + col); sh[i] = *(const f32x4*)(mrow + col); scl[i] = *(const f32x4*)(mrow + DM + col); }
#pragma unroll
                        for (int i = 0; i < 8; ++i) {
                            const int col = 4 * lane + 256 * i;
                            const f32x4 h = v[r][i] * rs * gg[i] * (scl[i] + 1.f) + sh[i];
                            u32x2 w; w.x = cvt_pk(h[0], h[1]); w.y = cvt_pk(h[2], h[3]);
                            *(u32x2*)(HM + (size_t)row * DM + col) = w;
                        }
                        asm volatile("" ::: "memory");
                    } }
            }
        GRID_SYNC();
        }
        TS_MARK(3 + 8 * layer);

        for (int rep = 0; rep < 1 + DUP_PB; ++rep) {
            WS_PTRS();
            pg8::Gemm g{HM, WinT + (size_t)layer * DIN * DM, NTOK, DIN, DM};
            pg8::StaticOrder S; S.init(NTOK, DIN, G, bx);
            EpiInProj E{P, KL + (size_t)layer * 2 * KVL * DKV, VL + (size_t)layer * 2 * KVL * DKV, p.out, p.in[10] + layer * HD, p.in[11] + layer * HD, rope, (LAS float*)(lds + XCH_OFF), layer};
            pg8::gemm_phase<EpiInProj, pg8::StaticOrder, 4>(lds, g, S, E);
            TS_MARK(4 + 8 * layer);
            if (filt_late && bx >= 160 && bx < 240) {
                WS_PTRS();
                LAS float* fscr = (LAS float*)(lds + 8 * 8448 + 3 * DM * 4);
                {
                    const int fi = layer * 80 + (bx - 160);
                    const int l = fi / 80; int r = fi % 80; int L, dir, ci; bf16_t* T = Tt + (size_t)l * T_LAYER;
                    if (r < 16) { L = 256; dir = r / 8; ci = r % 8; } else { r -= 16; L = 1024; dir = r / 32; ci = r % 32; T += (size_t)DHY * 512; }
                    if (dir == 0) filter_item<0>(p, l, L, ci, T, fscr); else filter_item<1>(p, l, L, ci, T, fscr);
                }
            }
            if (split && layer == 0 && bx >= 160) {
                PHASE_IDS();
                LAS float* scr = (LAS float*)(lds + wave * 8448); LAS float* sc = (LAS float*)(lds + 8 * 8448);
                prep_wave_items(p, 1, false, true, false, false, wave * 96 + (bx - 160), 96 * NW, lane, scr, sc, ws);
            }
        GRID_SYNC();
        }
        TS_MARK(5 + 8 * layer);

        for (int rep = 0; rep < 1 + DUP_PC; ++rep) {
            WS_PTRS();
            const bf16_t* KLl = KL + (size_t)layer * 2 * KVL * DKV; const bf16_t* VLl = VL + (size_t)layer * 2 * KVL * DKV;
            const bf16_t* T256 = Tt + (size_t)layer * T_LAYER; const bf16_t* T1024 = T256 + (size_t)DHY * 512;
            float* Opart = (float*)(ws + WS_OPART); float* MLp = (float*)(ws + WS_ML);
            for (int slot = bx; slot < 512; slot += G) {
                const int rnd = slot >> 8, i = slot & 255;
                int kind = -1, u = 0;
                if (rnd == 0) { if (i < 128) { kind = 0; u = i; } else if (i < 192) { kind = 3; u = 2 * (i - 128); } else { kind = 2; u = i - 192; } }
                else if (rnd == 1) { if (i < 128) { kind = 1; u = i; } else if (i < 192) { kind = 3; u = 2 * (i - 128) + 1; } }
                if (kind == 0 || kind == 1) {
                    const bf16_t *Qb, *Kh, *Vh, *Gb; bf16_t* Ob; int ldk, seq; float* Op = nullptr; float* Mp = nullptr;
                    if (kind == 0) { const int un = u >> 1, half = u & 1, b = un >> 5, h = (un >> 2) & 7, qb = un & 3, kv = h >> 1; const size_t tok0 = NCTX + b * LS + qb * 256;
                        Qb = P + tok0 * DIN + h * HD; Gb = P + tok0 * DIN + OFF_GA + h * HD; Ob = HM + tok0 * DM + h * HD;
                        Kh = KLl + ((size_t)b * KVL + half * (KVL / 2)) * DKV + kv * HD; Vh = VLl + ((size_t)b * KVL + half * (KVL / 2)) * DKV + kv * HD; ldk = DKV; seq = KVL / 2;
                        Op = Opart + (size_t)u * 256 * HD; Mp = MLp + (size_t)u * 256 * 2; }
                    else { const int b = u >> 3, h = u & 7, kv = h >> 1; const size_t tok0 = (size_t)b * CS;
                        Qb = P + tok0 * DIN + h * HD; Gb = P + tok0 * DIN + OFF_GA + h * HD; Ob = HM + tok0 * DM + h * HD;
                        Kh = P + tok0 * DIN + OFF_K + kv * HD; Vh = P + tok0 * DIN + OFF_V + kv * HD; ldk = DIN; seq = CS; }
                    for (int r2 = 0; r2 < 1 + DUP_ATT; ++r2) att::attn_body(Qb, DIN, Kh, Vh, ldk, Gb, DIN, Ob, DM, seq, (char*)lds_raw, Op, Mp);
                } else if (kind == 2) { for (int r2 = 0; r2 < 1 + DUP_HY; ++r2) hy::unit<1024>(p, layer, (4 + (u >> 5)) * 1024, u & 31, lds, P, HM, T1024); }
                else if (kind == 3) { for (int r2 = 0; r2 < 1 + DUP_HY; ++r2) hy::unit<256>(p, layer, (u >> 5) * 1024, u & 31, lds, P, HM, T256); }
            }
            if (split && layer == 0 && bx >= 192) {
                PHASE_IDS();
                LAS float* sc = (LAS float*)(lds + 8 * 8448);
                LOAD_SILU_C(sc);
                prep_wave_items(p, 1, true, false, false, false, wave * 64 + (bx - 192), 64 * NW, lane, (LAS float*)lds, sc, ws);
                __syncthreads();
            }
        TS_MARK(6 + 8 * layer);
        GRID_SYNC();
        TS_MARK(7 + 8 * layer);
        for (int r5 = 0; r5 < 1 + DUP_PC2; ++r5) {
            if (r5) GRID_SYNC();
            PHASE_IDS();
            const int sub = tid & 15, rl = tid >> 4;
            for (int rb0 = vcu; rb0 < 64 * 8; rb0 += 2 * G) {
                f32x2 ml0[2], ml1[2]; f32x4 a0[2], a1[2], b0[2], b1[2]; u32x4 g[2]; size_t tok[2]; int hh[2];
#pragma unroll
                for (int q = 0; q < 2; ++q) {
                    const int rbq = rb0 + q * G, rb = rbq < 64 * 8 ? rbq : rb0;
                    const int un = rb >> 3, row = (rb & 7) * 32 + rl;
                    const int b = un >> 5, h = (un >> 2) & 7, qb = un & 3; tok[q] = NCTX + b * LS + qb * 256 + row; hh[q] = h;
                    ml0[q] = *(const f32x2*)(MLp + ((size_t)(2 * un) * 256 + row) * 2); ml1[q] = *(const f32x2*)(MLp + ((size_t)(2 * un + 1) * 256 + row) * 2);
                    const float* o0 = Opart + ((size_t)(2 * un) * 256 + row) * HD + sub * 8; const float* o1 = o0 + (size_t)256 * HD;
                    a0[q] = *(const f32x4*)o0; a1[q] = *(const f32x4*)(o0 + 4); b0[q] = *(const f32x4*)o1; b1[q] = *(const f32x4*)(o1 + 4);
                    g[q] = *(const u32x4*)(P + tok[q] * DIN + OFF_GA + h * HD + sub * 8);
                }
#pragma unroll
                for (int q = 0; q < 2; ++q) {
                    if (rb0 + q * G < 64 * 8) {
                        const float M = fmaxf(ml0[q][0], ml1[q][0]), f0 = __expf(att::SCALE * (ml0[q][0] - M)), f1 = __expf(att::SCALE * (ml1[q][0] - M));
                        const float inv = 1.f / (f0 * ml0[q][1] + f1 * ml1[q][1]), w0 = f0 * inv, w1 = f1 * inv;
                        const f32x4 r0 = a0[q] * w0 + b0[q] * w1, r1 = a1[q] * w0 + b1[q] * w1;
                        u32x4 w; w.x = cvt_pk(r0[0] * bflo(g[q].x), r0[1] * bfhi(g[q].x)); w.y = cvt_pk(r0[2] * bflo(g[q].y), r0[3] * bfhi(g[q].y));
                        w.z = cvt_pk(r1[0] * bflo(g[q].z), r1[1] * bfhi(g[q].z)); w.w = cvt_pk(r1[2] * bflo(g[q].w), r1[3] * bfhi(g[q].w));
                        *(u32x4*)(HM + tok[q] * DM + hh[q] * HD + sub * 8) = w;
                    }
                }
            }
        }
        GRID_SYNC();
        }
        TS_MARK(8 + 8 * layer);

        for (int rep = 0; rep < 1 + (layer == 0 ? DUP_PD : 0); ++rep) {
            WS_PTRS();
            pg8::Gemm g{HM, WoutT + (size_t)layer * DM * DM, NTOK, DM, DM};
            pg8::StaticOrder S; S.init(NTOK, DM, G, bx, 192);
            EpiOutProj E{layer == 0 ? x_prompt : XB, layer == 0 ? x_sample : XB + (size_t)NCTX * DM, XB, modf + (size_t)layer * 3 * 3 * DM};
            pg8::gemm_phase<EpiOutProj, pg8::StaticOrder, 3>(lds, g, S, E);
            TS_MARK(9 + 8 * layer);
            if (split && layer == 0 && bx >= 192) {
                PHASE_IDS();
                LAS float* scr = (LAS float*)(lds + wave * 8448);
                prep_wave_items(p, 1, false, false, true, false, wave * 64 + (bx - 192), 64 * NW, lane, scr, (const LAS float*)scr, ws);
                mod_reduce(p, 1, (bx - 192) * NT + tid, ws);
            }
        GRID_SYNC();
        }
        TS_MARK(10 + 8 * layer);
    }

    for (int r3 = 0; r3 < DUP_SYNC; ++r3) GRID_SYNC();
    {
        PHASE_IDS(); WS_PTRS();
        const float* fg = p.in[22];
        f32x4 fgv[8];
#pragma unroll
        for (int i = 0; i < 8; ++i) fgv[i] = *(const f32x4*)(fg + 4 * lane + 256 * i);
        for (int row0 = gwp; row0 < NTOK; row0 += RIF * NGW) {
            f32x4 v[RIF][8];
#pragma unroll
            for (int r = 0; r < RIF; ++r) { const int rw = row0 + r * NGW, row = rw < NTOK ? rw : NTOK - 1;
#pragma unroll
                for (int i = 0; i < 8; ++i) v[r][i] = *(const f32x4*)(XB + (size_t)row * DM + 4 * lane + 256 * i); }
            asm volatile("" ::: "memory");
#pragma unroll
            for (int r = 0; r < RIF; ++r) { const int row = row0 + r * NGW;
                if (row < NTOK) {
                    float ss = 0.f;
#pragma unroll
                    for (int i = 0; i < 8; ++i) ss += (v[r][i][0] * v[r][i][0] + v[r][i][1] * v[r][i][1]) + (v[r][i][2] * v[r][i][2] + v[r][i][3] * v[r][i][3]);
                    ss = wave_sum(ss, lane);
                    const float rs = rsqrtf(ss * (1.f / DM) + EPS);
#pragma unroll
                    for (int i = 0; i < 8; ++i) { const int col = 4 * lane + 256 * i; *(f32x4*)(p.out + (size_t)row * DM + col) = v[r][i] * rs * fgv[i]; }
                } }
        }
    }
    TS_MARK(19);
    if ((TS_J) != 0 && bx == (TS_BLK) && threadIdx.x == 0) {
        volatile LAS unsigned* m = (volatile LAS unsigned*)(lds + MISC_OFF);
        const unsigned long long ti = ((unsigned long long)m[17 + 2 * (TS_I)] << 32) | m[16 + 2 * (TS_I)], tj = ((unsigned long long)m[17 + 2 * (TS_J)] << 32) | m[16 + 2 * (TS_J)];
        const unsigned long long t0 = __builtin_amdgcn_s_memrealtime(), want = (tj - ti) * (TS_AMP);
        while (__builtin_amdgcn_s_memrealtime() - t0 < want) __builtin_amdgcn_s_sleep(32);
    }
}

extern "C" void kernel_launch(void* const* d_in, const int* in_sizes, int n_in, void* d_out, int out_size, void* d_ws, size_t ws_size, hipStream_t stream) {
    static int grid = 0;
    if (grid == 0) {
        if (n_in != 23 || ws_size < WS_END) { fprintf(stderr, "kernel_launch: n_in %d ws %zu (need %zu)\n", n_in, ws_size, (size_t)WS_END); grid = -1; return; }
        int dev = 0, cus = 0, per_cu = 0;
        if (hipGetDevice(&dev) != hipSuccess || hipDeviceGetAttribute(&cus, hipDeviceAttributeMultiprocessorCount, dev) != hipSuccess) { grid = -1; return; }
        if (hipFuncSetAttribute((const void*)fwd_megakernel, hipFuncAttributeMaxDynamicSharedMemorySize, LDS_BYTES) != hipSuccess) { fprintf(stderr, "kernel_launch: hipFuncSetAttribute failed\n"); grid = -1; return; }
        if (hipOccupancyMaxActiveBlocksPerMultiprocessor(&per_cu, (const void*)fwd_megakernel, NT, LDS_BYTES) != hipSuccess || per_cu < 1) { fprintf(stderr, "kernel_launch: occupancy query says %d\n", per_cu); grid = -1; return; }
        grid = cus;
    }
    if (grid < 0) return;
    Params prm{};
    for (int i = 0; i < 23; ++i) prm.in[i] = (const float*)d_in[i];
    prm.out = (float*)d_out; prm.ws = (unsigned char*)d_ws;
    if (hipMemsetAsync((char*)d_ws + WS_BAR, 0, 16384, stream) != hipSuccess) { fprintf(stderr, "kernel_launch: memset failed\n"); return; }
    void* args[] = {&prm};
    hipError_t e = hipLaunchCooperativeKernel((const void*)fwd_megakernel, dim3(grid), dim3(NT), args, LDS_BYTES, stream);
    if (e != hipSuccess) fprintf(stderr, "cooperative launch failed: %s (grid %d)\n", hipGetErrorString(e), grid);
}
```

```cpp
#include <hip/hip_runtime.h>
#include <hip/hip_cooperative_groups.h>
#include <cstdio>
#include <cstdint>
namespace cg = cooperative_groups;

#define LAS __attribute__((address_space(3)))
#define GAS __attribute__((address_space(1)))
typedef unsigned short bf16_t;
typedef short bf16x8 __attribute__((ext_vector_type(8)));
typedef float f32x4 __attribute__((ext_vector_type(4)));
typedef float f32x2 __attribute__((ext_vector_type(2)));
typedef unsigned u32x4 __attribute__((ext_vector_type(4)));
typedef unsigned u32x2 __attribute__((ext_vector_type(2)));

#define DUP_P0 0
#define DUP_PA 0
#define DUP_PB 0
#define DUP_PC 0
#define DUP_PD 0
#define DUP_ATT 0
#define DUP_HY 0
#define DUP_SYNC 0
#define DUP_EPI 0
#define TS_I 0
#define TS_J 0
#define TS_BLK 0
#define TS_AMP 20
#define DUP_PC2 0
#define DUP_GEMV 0
#define DUP_TR 0
#define DUP_FILT 0
#define DUP_ST 0
#define KREP_PB 1
#define KREP_PD 1
constexpr int DM = 2048, NCTX = 4096, NLAT = 2048, NTOK = 6144, DIN = 7168;
constexpr int CS = 256, LS = 1024, PAST = 512, KVL = LS + PAST;
constexpr int HD = 128, NKV = 4, DHY = 1024, DKV = 512;
constexpr int OFF_K = 1024, OFF_V = 1536, OFF_GA = 2048, OFF_HY = 3072, OFF_GH = 6144;
constexpr float EPS = 1e-6f;
constexpr size_t OUT_NK = (size_t)NTOK * DM, OUT_NV = OUT_NK + (size_t)16 * 2 * CS * DKV;
constexpr int NW = 8, NT = NW * 64;
constexpr int MODP = 32;
constexpr int RIF = 3;

constexpr size_t al256(size_t x) { return (x + 255) / 256 * 256; }
constexpr size_t WS_WIN = 0;
constexpr size_t WS_WOUT = WS_WIN + (size_t)2 * DIN * DM * 2;
constexpr size_t WS_HM = WS_WOUT + (size_t)2 * DM * DM * 2;
constexpr size_t WS_P = WS_HM + (size_t)NTOK * DM * 2;
constexpr size_t WS_KL = WS_P + (size_t)NTOK * DIN * 2 * (1 + DUP_ST);
constexpr size_t WS_VL = WS_KL + (size_t)2 * 2 * KVL * DKV * 2;
constexpr size_t WS_XB = WS_VL + (size_t)2 * 2 * KVL * DKV * 2;
constexpr size_t WS_MODP = WS_XB + (size_t)NTOK * DM * 4;
constexpr size_t WS_MODF = WS_MODP + (size_t)2 * MODP * 3 * 3 * DM * 4;
constexpr size_t WS_T = WS_MODF + (size_t)2 * 3 * 3 * DM * 4;
constexpr size_t T_LAYER = (size_t)DHY * (512 + 2048);
constexpr size_t WS_ROPE = WS_T + 2 * T_LAYER * 2;
constexpr size_t WS_OPART = WS_ROPE + (size_t)LS * 64 * 2 * 4;
constexpr size_t WS_ML = WS_OPART + (size_t)64 * 2 * 256 * 128 * 4;
constexpr size_t WS_BAR = WS_ML + (size_t)64 * 2 * 256 * 2 * 4;
constexpr size_t WS_END = WS_BAR + 16384;

constexpr int RING_BYTES = 131072, XCH_OFF = RING_BYTES, MISC_OFF = XCH_OFF + 8192, LDS_BYTES = 147456;

struct Params {
    const float* in[23];
    float* out;
    unsigned char* ws;
};

__device__ __forceinline__ unsigned f2bf(float f) { unsigned u = __builtin_bit_cast(unsigned, f); return (u + 0x7fffu + ((u >> 16) & 1u)) >> 16; }
__device__ __forceinline__ unsigned pk2(float lo, float hi) { return f2bf(lo) | (f2bf(hi) << 16); }
__device__ __forceinline__ float bf2f(unsigned short v) { return __builtin_bit_cast(float, (unsigned)v << 16); }
__device__ __forceinline__ float bflo(unsigned v) { return __builtin_bit_cast(float, v << 16); }
__device__ __forceinline__ float bfhi(unsigned v) { return __builtin_bit_cast(float, v & 0xffff0000u); }
__device__ __forceinline__ float silu_f(float x) { return x * __builtin_amdgcn_rcpf(1.f + __expf(-x)); }
__device__ __forceinline__ unsigned cvt_pk(float lo, float hi) { unsigned r; asm volatile("v_cvt_pk_bf16_f32 %0, %1, %2" : "=v"(r) : "v"(lo), "v"(hi)); return r; }
__device__ __forceinline__ float shx(float v, int m, int lane) { return __builtin_bit_cast(float, __builtin_amdgcn_ds_bpermute((lane ^ m) << 2, __builtin_bit_cast(int, v))); }
__device__ __forceinline__ float wave_sum(float v, int lane) {
#pragma unroll
    for (int o = 1; o < 64; o <<= 1) v += shx(v, o, lane);
    return v;
}
#define LDS_WAIT() asm volatile("s_waitcnt lgkmcnt(0)" ::: "memory")

namespace pg8 {
constexpr int BM = 256, BK = 64, HALF = 128, HTB = HALF * BK * 2, STAGE_BYTES = 8 * HTB, NXCD = 8, WGM = 8;
__host__ __device__ __forceinline__ int lds_byte(int r, int c) { const int st = (r >> 4) * 2 + (c >> 5), rr = r & 15, cc = c & 31, ob = rr * 64 + cc * 2; return st * 1024 + (ob ^ (((ob >> 9) & 1) << 5)); }
__host__ __device__ __forceinline__ void stage_rc(int b, int& R, int& C) { const int st = b / 1024, sb = b % 1024, swz = sb ^ (((sb >> 9) & 1) << 5); R = (st >> 1) * 16 + swz / 64; C = (st & 1) * 32 + (swz % 64) / 2; }
__host__ __device__ __forceinline__ int perm32(int rho) { const int n = rho >> 4, i = rho & 15; return 8 * (i >> 2) + 4 * n + (i & 3); }
struct Unit { int pm, pn; };
struct Gemm { const bf16_t* A; const bf16_t* Bt; int M, N, K; };
struct StaticOrder {
    int nM, nN, nwg, G, c;
    __device__ void init(int M, int N, int G_, int c_, int bm = BM) { nM = M / bm; nN = N / BM; nwg = nM * nN; G = G_; c = c_; }
    __device__ bool next(int i, Unit& u) const {
        const long L = (long)i * G + c; if (L >= nwg) return false;
        int wgid = (int)L; { const int q = nwg / NXCD, r = nwg % NXCD, xcd = wgid % NXCD, off = wgid / NXCD; wgid = (xcd < r ? xcd * (q + 1) : r * (q + 1) + (xcd - r) * q) + off; }
        const int nig = WGM * nN, gid = wgid / nig, fm = gid * WGM, gsz = (nM - fm) < WGM ? (nM - fm) : WGM;
        u.pm = fm + ((wgid % nig) % gsz); u.pn = (wgid % nig) / gsz; return true;
    }
};
template <class Epi, class Sched, int MF>
__device__ __forceinline__ void gemm_phase(LAS unsigned char* lds, const Gemm g, const Sched& S, const Epi& E) {
    int tid = threadIdx.x; asm volatile("" : "+v"(tid));
    const int wid = __builtin_amdgcn_readfirstlane(tid >> 6), lane = tid & 63, wr = wid >> 2, wc = wid & 3, fr = lane & 15, fq = lane >> 4;
    const int K = g.K, nt = K / BK;
    unsigned voffA[2], voffB[2];
#pragma unroll
    for (int i = 0; i < 2; ++i) { int R, C; stage_rc(tid * 16 + i * 8192, R, C); const int Rb = Epi::PERM ? ((R & ~31) + perm32(R & 31)) : R;
        voffA[i] = (unsigned)(R * K + C) * 2u; voffB[i] = (unsigned)(Rb * K + C) * 2u; }
    const size_t kstep = (size_t)(BK * 2);
    const size_t hstep = (size_t)HALF * K * 2, hstepA = (size_t)(MF * 32) * K * 2;
    const size_t tstep = 2 * hstep, tstepA = 2 * hstepA;
    const unsigned ldsw = (unsigned)wid * 1024u;
    const int aoff = lds_byte(wr * (MF * 16) + fr, fq * 8), boff = lds_byte(wc * 32 + fr, fq * 8);
#define PG8_SA(b, h) (((b) * 2 + (h)) * HTB)
#define PG8_SB(b, h) ((4 + (b) * 2 + (h)) * HTB)
#define PG8_STAGE(bufoff, gbase, voff) do { _Pragma("unroll") for (int _i = 0; _i < 2; ++_i) \
        __builtin_amdgcn_global_load_lds((const unsigned*)((const char*)(gbase) + (voff)[_i]), (LAS unsigned*)(lds + (bufoff) + ldsw + _i * 8192), 16, 0, 0); } while (0)
#define PG8_LDA(dst, b, h) do { _Pragma("unroll") for (int m = 0; m < MF; ++m) _Pragma("unroll") for (int k = 0; k < 2; ++k) dst[m][k] = *(const LAS bf16x8*)(lds + PG8_SA(b, h) + aoff + m * 2048 + k * 1024); } while (0)
#define PG8_LDB(dst, b, h) do { _Pragma("unroll") for (int n = 0; n < 2; ++n) _Pragma("unroll") for (int k = 0; k < 2; ++k) dst[n][k] = *(const LAS bf16x8*)(lds + PG8_SB(b, h) + boff + n * 2048 + k * 1024); } while (0)
#define PG8_MMA(ai, bj, At, Bt) do { __builtin_amdgcn_s_setprio(1); _Pragma("unroll") for (int m = 0; m < MF; ++m) _Pragma("unroll") for (int n = 0; n < 2; ++n) _Pragma("unroll") for (int k = 0; k < 2; ++k) \
        acc[ai][bj][m][n] = __builtin_amdgcn_mfma_f32_16x16x32_bf16(Bt[n][k], At[m][k], acc[ai][bj][m][n], 0, 0, 0); __builtin_amdgcn_s_setprio(0); } while (0)
#define PG8_WAIT_V(n) asm volatile("s_waitcnt vmcnt(" #n ")" ::: "memory")
#define PG8_WAIT_L(n) asm volatile("s_waitcnt lgkmcnt(" #n ")" ::: "memory")
#define PG8_BAR __builtin_amdgcn_s_barrier()
#define PG8_SCHED __builtin_amdgcn_sched_barrier(0)
    Unit cur, nxt; int ui = 0;
    if (!S.next(0, cur)) return;
    f32x4 acc[2][2][MF][2];
#pragma unroll
    for (int a = 0; a < 2; ++a)
#pragma unroll
        for (int b = 0; b < 2; ++b)
#pragma unroll
            for (int m = 0; m < MF; ++m)
#pragma unroll
                for (int n = 0; n < 2; ++n) acc[a][b][m][n] = (f32x4){0.f, 0.f, 0.f, 0.f};
    bf16x8 At[MF][2], B0[2][2], B1[2][2];
    const char* cA = (const char*)g.A + (size_t)cur.pm * tstepA; const char* cB = (const char*)g.Bt + (size_t)cur.pn * tstep;
    PG8_STAGE(PG8_SB(0, 0), cB, voffB); PG8_STAGE(PG8_SB(0, 1), cB + hstep, voffB); PG8_STAGE(PG8_SA(0, 0), cA, voffA); PG8_STAGE(PG8_SA(0, 1), cA + hstepA, voffA);
    if (wr == 1) PG8_BAR;
    PG8_WAIT_V(2); PG8_BAR;
    PG8_STAGE(PG8_SB(1, 0), cB + kstep, voffB); PG8_STAGE(PG8_SA(1, 0), cA + kstep, voffA); PG8_STAGE(PG8_SB(1, 1), cB + hstep + kstep, voffB);
    PG8_WAIT_V(6); PG8_BAR;
    for (;;) {
        const bool has_next = S.next(ui + 1, nxt);
        const char* nA = has_next ? (const char*)g.A + (size_t)nxt.pm * tstepA : cA; const char* nB = has_next ? (const char*)g.Bt + (size_t)nxt.pn * tstep : cB;
        for (int t_ = 0; t_ < nt * Epi::KREP; t_ += 2) {
            const bool last = (t_ == nt * Epi::KREP - 2);
            const int t = t_ % nt, t2 = (t_ + 2) % nt;
            const char* a1 = cA + (size_t)(t + 1) * kstep;
            const char* a2 = last ? nA : cA + (size_t)t2 * kstep; const char* b2 = last ? nB : cB + (size_t)t2 * kstep;
            const char* a3 = a2 + kstep; const char* b3 = b2 + kstep;
            PG8_LDB(B0, 0, 0); PG8_LDB(B1, 0, 1); PG8_SCHED; PG8_LDA(At, 0, 0); PG8_STAGE(PG8_SA(1, 1), a1 + hstepA, voffA);
            PG8_WAIT_V(8); PG8_WAIT_L(0); PG8_BAR; PG8_MMA(0, 0, At, B0); PG8_MMA(0, 1, At, B1); PG8_BAR; PG8_SCHED;
            PG8_LDA(At, 0, 1); PG8_STAGE(PG8_SB(0, 0), b2, voffB); PG8_STAGE(PG8_SB(0, 1), b2 + hstep, voffB); PG8_STAGE(PG8_SA(0, 0), a2, voffA);
            PG8_WAIT_V(8); PG8_WAIT_L(0); PG8_BAR; PG8_MMA(1, 0, At, B0); PG8_MMA(1, 1, At, B1); PG8_BAR; PG8_SCHED;
            PG8_LDB(B0, 1, 0); PG8_LDB(B1, 1, 1); PG8_SCHED; PG8_LDA(At, 1, 0); PG8_STAGE(PG8_SA(0, 1), a2 + hstepA, voffA);
            PG8_WAIT_V(8); PG8_WAIT_L(0); PG8_BAR; PG8_MMA(0, 0, At, B0); PG8_MMA(0, 1, At, B1); PG8_BAR; PG8_SCHED;
            PG8_LDA(At, 1, 1); PG8_STAGE(PG8_SB(1, 0), b3, voffB); PG8_STAGE(PG8_SB(1, 1), b3 + hstep, voffB); PG8_STAGE(PG8_SA(1, 0), a3, voffA);
            PG8_WAIT_V(8); PG8_WAIT_L(0); PG8_BAR; PG8_MMA(1, 0, At, B0); PG8_MMA(1, 1, At, B1); PG8_BAR; PG8_SCHED;
        }
        if (wr == 0) PG8_BAR;
        if (Epi::KREP > 1) {
#pragma unroll
            for (int a = 0; a < 2; ++a)
#pragma unroll
                for (int b = 0; b < 2; ++b)
#pragma unroll
                    for (int m = 0; m < MF; ++m)
#pragma unroll
                        for (int n = 0; n < 2; ++n) acc[a][b][m][n] *= (1.0f / Epi::KREP);
        }
        E(acc, cur, wr, wc, fr, fq);
        if (!has_next) break;
#pragma unroll
        for (int a = 0; a < 2; ++a)
#pragma unroll
            for (int b = 0; b < 2; ++b)
#pragma unroll
                for (int m = 0; m < MF; ++m)
#pragma unroll
                    for (int n = 0; n < 2; ++n) acc[a][b][m][n] = (f32x4){0.f, 0.f, 0.f, 0.f};
        cur = nxt; cA = nA; cB = nB; ++ui;
        if (wr == 1) PG8_BAR;
    }
    PG8_WAIT_V(0);
    PG8_BAR;
#undef PG8_SA
#undef PG8_SB
#undef PG8_STAGE
#undef PG8_LDA
#undef PG8_LDB
#undef PG8_MMA
#undef PG8_WAIT_V
#undef PG8_WAIT_L
#undef PG8_BAR
#undef PG8_SCHED
}
}

struct EpiInProj {
    static constexpr bool PERM = true; static constexpr int MF = 4, KREP = KREP_PB;
    bf16_t* P; bf16_t* KLl; bf16_t* VLl;
    float* out; const float* qg; const float* kg; const float* rope; LAS float* xch; int layer;
    __device__ __forceinline__ void operator()(f32x4 (&acc)[2][2][4][2], const pg8::Unit& u, int wr, int wc, int fr, int fq) const {
        const int pn = u.pn, pm = u.pm;
        const bool lat = pm >= 16;
        asm volatile("" : "+v"(fr), "+v"(fq));
        const int rl0 = wr * 64 + fr, cl0 = wc * 32 + 8 * fq;
        if (pn < 6) {
#pragma unroll
            for (int ai = 0; ai < 2; ++ai)
#pragma unroll
                for (int m = 0; m < 4; ++m)
#pragma unroll
                    for (int bj = 0; bj < 2; ++bj) {
                        const f32x4 a = acc[ai][bj][m][0], b = acc[ai][bj][m][1];
                        float s = (a[0] * a[0] + a[1] * a[1]) + (a[2] * a[2] + a[3] * a[3]) + (b[0] * b[0] + b[1] * b[1]) + (b[2] * b[2] + b[3] * b[3]);
                        s += shx(s, 16, fq * 16 + fr); s += shx(s, 32, fq * 16 + fr);
                        if (fq == 0) xch[((ai * 128 + rl0 + m * 16) * 2 + bj) * 4 + wc] = s;
                    }
            LDS_WAIT(); __builtin_amdgcn_s_barrier(); asm volatile("" ::: "memory");
            const float* gsrc = (pn < 4) ? qg : kg;
            const f32x4 g0 = *(const f32x4*)(gsrc + cl0), g1 = *(const f32x4*)(gsrc + cl0 + 4);
            const f32x4 ifr = *(const f32x4*)(rope + ((cl0 >> 1) & 31));
#pragma unroll
            for (int ai = 0; ai < 2; ++ai)
#pragma unroll
                for (int m = 0; m < 4; ++m) {
                    const int rl = ai * 128 + rl0 + m * 16, row = pm * 256 + rl;
#pragma unroll
                    for (int bj = 0; bj < 2; ++bj) {
                        const f32x4 pp = *(const LAS f32x4*)(xch + (rl * 2 + bj) * 4);
                        const float rs = rsqrtf(((pp[0] + pp[1]) + (pp[2] + pp[3])) * (1.f / HD) + EPS);
                        f32x4 v0 = acc[ai][bj][m][0] * rs * g0, v1 = acc[ai][bj][m][1] * rs * g1;
                        if (lat) {
                            const int t = (row - NCTX) & (LS - 1);
                            const float pos = (float)(wc < 2 ? (t >> 6) : (t & 63));
                            const f32x4 ar = ifr * pos;
                            const f32x4 c0 = {__builtin_amdgcn_cosf(ar[0]), __builtin_amdgcn_sinf(ar[0]), __builtin_amdgcn_cosf(ar[1]), __builtin_amdgcn_sinf(ar[1])};
                            const f32x4 c1 = {__builtin_amdgcn_cosf(ar[2]), __builtin_amdgcn_sinf(ar[2]), __builtin_amdgcn_cosf(ar[3]), __builtin_amdgcn_sinf(ar[3])};
                            f32x4 w0, w1;
                            w0[0] = v0[0] * c0[0] - v0[1] * c0[1]; w0[1] = v0[0] * c0[1] + v0[1] * c0[0]; w0[2] = v0[2] * c0[2] - v0[3] * c0[3]; w0[3] = v0[2] * c0[3] + v0[3] * c0[2];
                            w1[0] = v1[0] * c1[0] - v1[1] * c1[1]; w1[1] = v1[0] * c1[1] + v1[1] * c1[0]; w1[2] = v1[2] * c1[2] - v1[3] * c1[3]; w1[3] = v1[2] * c1[3] + v1[3] * c1[2];
                            v0 = w0; v1 = w1;
                        }
                        u32x4 w; w.x = cvt_pk(v0[0], v0[1]); w.y = cvt_pk(v0[2], v0[3]); w.z = cvt_pk(v1[0], v1[1]); w.w = cvt_pk(v1[2], v1[3]);
                        const int col = pn * 256 + bj * 128 + cl0;
                        if (pn < 4 || !lat) *(u32x4*)(P + (size_t)row * DIN + col) = w;
                        if (pn >= 4) {
                            const int kc = col - OFF_K;
                            if (!lat) { float* o = out + OUT_NK + ((size_t)(pm * 2 + layer) * CS + rl) * DKV + kc; *(f32x4*)o = v0; *(f32x4*)(o + 4) = v1; }
                            else { const int b = (pm - 16) >> 2, t = ((pm - 16) & 3) * 256 + rl; *(u32x4*)(KLl + ((size_t)b * KVL + t) * DKV + kc) = w; }
                        }
                    }
                    asm volatile("" ::: "memory");
                }
        } else {
            const bool is_v = pn < 8, act = (pn >= 8 && pn < 12) || pn >= 24;
#pragma unroll
            for (int ai = 0; ai < 2; ++ai)
#pragma unroll
                for (int m = 0; m < 4; ++m) {
                    const int rl = ai * 128 + rl0 + m * 16, row = pm * 256 + rl;
#pragma unroll
                    for (int bj = 0; bj < 2; ++bj) {
                        f32x4 v0 = acc[ai][bj][m][0], v1 = acc[ai][bj][m][1];
                        if (act) {
#pragma unroll
                            for (int e = 0; e < 4; ++e) { v0[e] = silu_f(v0[e]); v1[e] = silu_f(v1[e]); }
                        }
                        u32x4 w; w.x = cvt_pk(v0[0], v0[1]); w.y = cvt_pk(v0[2], v0[3]); w.z = cvt_pk(v1[0], v1[1]); w.w = cvt_pk(v1[2], v1[3]);
                        const int col = pn * 256 + bj * 128 + cl0;
                        if (!is_v || !lat) { *(u32x4*)(P + (size_t)row * DIN + col) = w; if (DUP_ST) { *(u32x4*)(P + (size_t)NTOK * DIN + (size_t)row * DIN + col) = w; } }
                        if (is_v) {
                            const int vc = col - OFF_V;
                            if (!lat) { float* o = out + OUT_NV + ((size_t)(pm * 2 + layer) * CS + rl) * DKV + vc; *(f32x4*)o = v0; *(f32x4*)(o + 4) = v1; }
                            else { const int b = (pm - 16) >> 2, t = ((pm - 16) & 3) * 256 + rl; *(u32x4*)(VLl + ((size_t)b * KVL + t) * DKV + vc) = w; }
                        }
                    }
                    asm volatile("" ::: "memory");
                }
        }
    }
};
struct EpiOutProj {
    static constexpr bool PERM = true; static constexpr int MF = 3, KREP = KREP_PD;
    const float* xc; const float* xl; float* xo; const float* modf;
    __device__ __forceinline__ void operator()(f32x4 (&acc)[2][2][3][2], const pg8::Unit& u, int wr, int wc, int fr, int fq) const {
        const int pn = u.pn, pm = u.pm;
        asm volatile("" : "+v"(fr), "+v"(fq));
        const int rl0 = wr * 48 + fr, cl0 = wc * 32 + 8 * fq;
#pragma unroll
        for (int ai = 0; ai < 2; ++ai)
#pragma unroll
            for (int m = 0; m < 3; ++m) {
                const int row = pm * 192 + ai * 96 + rl0 + m * 16;
                const bool lat = row >= NCTX;
                const int j = lat ? 1 + ((row - NCTX) >> 10) : 0;
                const float* gate = modf + (size_t)j * 3 * DM + 2 * DM;
                const float* xin = lat ? xl - (size_t)NCTX * DM : xc;
#pragma unroll
                for (int bj = 0; bj < 2; ++bj) {
                    const int col = pn * 256 + bj * 128 + cl0;
                    const size_t off = (size_t)row * DM + col;
                    const f32x4 g0 = *(const f32x4*)(gate + col), g1 = *(const f32x4*)(gate + col + 4);
                    const f32x4 x0 = *(const f32x4*)(xin + off), x1 = *(const f32x4*)(xin + off + 4);
                    *(f32x4*)(xo + off) = x0 + g0 * acc[ai][bj][m][0]; *(f32x4*)(xo + off + 4) = x1 + g1 * acc[ai][bj][m][1];
                }
                if (m == 2) asm volatile("" ::: "memory");
            }
    }
};

__device__ __forceinline__ void p0_transpose_item(const float* W, int K, int N, bf16_t* WT, LAS float* scr, int item, int lane) {
    const int nblk = N / 64, kb = item / nblk, nb = item % nblk, k0 = 64 * kb, n0 = 64 * nb;
    const int kr = lane >> 3, c4 = (lane & 7) * 4;
    f32x4 v[2][8];
    const GAS float* src = (const GAS float*)W + (size_t)(k0 + kr) * N + n0 + c4;
#pragma unroll
    for (int h = 0; h < 2; ++h)
#pragma unroll
        for (int i = 0; i < 8; ++i) v[h][i] = __builtin_nontemporal_load((const GAS f32x4*)(src + (size_t)(8 * i) * N + 32 * h));
    const int c = lane & 7;
#pragma unroll
    for (int h = 0; h < 2; ++h) {
#pragma unroll
        for (int i = 0; i < 8; ++i) { LAS float* d = scr + (8 * i + kr) * 33 + c4; d[0] = v[h][i][0]; d[1] = v[h][i][1]; d[2] = v[h][i][2]; d[3] = v[h][i][3]; }
        LDS_WAIT();
#pragma unroll
        for (int j = 0; j < 4; ++j) { const int n = (lane >> 3) + 8 * j; const LAS float* s_ = scr + (8 * c) * 33 + n;
            u32x4 o; o.x = cvt_pk(s_[0 * 33], s_[1 * 33]); o.y = cvt_pk(s_[2 * 33], s_[3 * 33]); o.z = cvt_pk(s_[4 * 33], s_[5 * 33]); o.w = cvt_pk(s_[6 * 33], s_[7 * 33]);
            *(u32x4*)(WT + (size_t)(n0 + 32 * h + n) * K + k0 + 8 * c) = o; }
        LDS_WAIT();
    }
}

template <int DIR>
__device__ __forceinline__ void filter_item(const Params& p, int l, int L, int ci, bf16_t* T, LAS float* scr) {
    int tid = threadIdx.x; asm volatile("" : "+v"(tid));
    const float* w1 = p.in[14] + l * 33 * 64; const float* b1 = p.in[15] + l * 64; const float* w2 = p.in[16] + l * 64 * 64; const float* b2 = p.in[17] + l * 64;
    const float* w3 = p.in[18] + (size_t)l * 64 * 2048; const float* freq = p.in[19] + l * 64;
    LAS float* zf = scr;
    LAS float* h1 = scr + 32 * 33;
    LAS float* h2t = h1 + 32 * 64;
    LAS float* w1s = h2t + 64 * 32;
    LAS float* w2s = w1s + 33 * 64;
    LAS float* cst = w2s + 64 * 64;
    const int tbase = DIR == 0 ? 1 + 32 * ci : 32 * ci;
    for (int idx = tid; idx < 33 * 64; idx += NT) w1s[idx] = w1[idx];
    for (int idx = tid; idx < 64 * 64; idx += NT) w2s[idx] = w2[idx];
    if (tid < 64) { cst[tid] = b1[tid]; cst[64 + tid] = b2[tid]; cst[128 + tid] = freq[tid] * 0.15915494309189535f; }
    for (int idx = tid; idx < 32 * 33; idx += NT) {
        const int tt = idx / 33, f = idx % 33; const float t = (float)(tbase + tt);
        float v;
        if (f == 0) v = t / (float)(L - 1);
        else { const int i = (f - 1) & 15; const float band = 1e-4f + (float)i * ((15.f - 1e-4f) / 15.f); const float rev = t * band / (float)L;
            v = f <= 16 ? __builtin_amdgcn_cosf(rev) : -__builtin_amdgcn_sinf(rev); }
        zf[idx] = v;
    }
    __syncthreads();
    for (int idx = tid; idx < 32 * 64; idx += NT) {
        const int tt = idx >> 6, j = idx & 63; float a = cst[j];
#pragma unroll 11
        for (int f = 0; f < 33; ++f) a += zf[tt * 33 + f] * w1s[f * 64 + j];
        h1[idx] = __builtin_amdgcn_sinf(cst[128 + j] * a);
    }
    __syncthreads();
    for (int idx = tid; idx < 32 * 64; idx += NT) {
        const int tt = idx >> 6, j = idx & 63; float a = cst[64 + j];
#pragma unroll 16
        for (int i = 0; i < 64; ++i) a += h1[tt * 64 + i] * w2s[i * 64 + j];
        h2t[j * 32 + tt] = __builtin_amdgcn_sinf(cst[128 + j] * a);
    }
    __syncthreads();
    const int c = tid * 2;
    float acc0[32], acc1[32];
#pragma unroll
    for (int tt = 0; tt < 32; ++tt) { acc0[tt] = 0.f; acc1[tt] = 0.f; }
    float e0 = 0.f, e1 = 0.f;
    const bool extra = (DIR == 1 && ci == 0);
    for (int j0 = 0; j0 < 64; j0 += 8) {
        f32x2 wv[8];
#pragma unroll
        for (int jj = 0; jj < 8; ++jj) wv[jj] = *(const GAS f32x2*)((const GAS float*)w3 + (size_t)(j0 + jj) * 2048 + DIR * 1024 + c);
#pragma unroll
        for (int jj = 0; jj < 8; ++jj) {
            const int j = j0 + jj;
#pragma unroll
            for (int q = 0; q < 8; ++q) {
                const f32x4 hv = *(const LAS f32x4*)(h2t + j * 32 + q * 4);
#pragma unroll
                for (int e = 0; e < 4; ++e) { acc0[q * 4 + e] += hv[e] * wv[jj][0]; acc1[q * 4 + e] += hv[e] * wv[jj][1]; }
            }
        }
    }
    if (extra) {
#pragma unroll 8
        for (int j = 0; j < 64; ++j) { const f32x2 wf = *(const GAS f32x2*)((const GAS float*)w3 + (size_t)j * 2048 + c); const float h0 = h2t[j * 32]; e0 += h0 * wf[0]; e1 += h0 * wf[1]; }
    }
    const float max_decay = logf(1e-2f) / 0.3f, min_decay = logf(1e-2f) / 1.5f;
    const float d0 = fabsf(min_decay + (float)c * ((max_decay - min_decay) / 1023.f)), d1 = fabsf(min_decay + (float)(c + 1) * ((max_decay - min_decay) / 1023.f));
#pragma unroll
    for (int tt = 0; tt < 32; ++tt) {
        const int t = tbase + tt; const float t_norm = (float)t / (float)(L - 1);
        float v0 = acc0[tt] * (__expf(-t_norm * d0) + 0.05f), v1 = acc1[tt] * (__expf(-t_norm * d1) + 0.05f);
        if (DIR == 0 && t >= L) { v0 = 0.f; v1 = 0.f; }
        if (extra && tt == 0) { v0 += e0 * 1.05f + p.in[20][l * DHY + c]; v1 += e1 * 1.05f + p.in[20][l * DHY + c + 1]; }
        acc0[tt] = v0; acc1[tt] = v1;
    }
    const int n0 = DIR == 0 ? L - 32 - 32 * ci : L + 32 * ci;
    bf16_t* r0 = T + (size_t)c * (2 * L) + n0; bf16_t* r1 = r0 + 2 * L;
#pragma unroll
    for (int q = 0; q < 4; ++q) {
        u32x4 a, b;
        if (DIR == 0) {
            a.x = pk2(acc0[31 - (8 * q + 0)], acc0[31 - (8 * q + 1)]); a.y = pk2(acc0[31 - (8 * q + 2)], acc0[31 - (8 * q + 3)]); a.z = pk2(acc0[31 - (8 * q + 4)], acc0[31 - (8 * q + 5)]); a.w = pk2(acc0[31 - (8 * q + 6)], acc0[31 - (8 * q + 7)]);
            b.x = pk2(acc1[31 - (8 * q + 0)], acc1[31 - (8 * q + 1)]); b.y = pk2(acc1[31 - (8 * q + 2)], acc1[31 - (8 * q + 3)]); b.z = pk2(acc1[31 - (8 * q + 4)], acc1[31 - (8 * q + 5)]); b.w = pk2(acc1[31 - (8 * q + 6)], acc1[31 - (8 * q + 7)]);
        } else {
            a.x = pk2(acc0[8 * q + 0], acc0[8 * q + 1]); a.y = pk2(acc0[8 * q + 2], acc0[8 * q + 3]); a.z = pk2(acc0[8 * q + 4], acc0[8 * q + 5]); a.w = pk2(acc0[8 * q + 6], acc0[8 * q + 7]);
            b.x = pk2(acc1[8 * q + 0], acc1[8 * q + 1]); b.y = pk2(acc1[8 * q + 2], acc1[8 * q + 3]); b.z = pk2(acc1[8 * q + 4], acc1[8 * q + 5]); b.w = pk2(acc1[8 * q + 6], acc1[8 * q + 7]);
        }
        *(u32x4*)(r0 + 8 * q) = a; *(u32x4*)(r1 + 8 * q) = b;
    }
    __syncthreads();
}

namespace att {
using s16x4 = __attribute__((ext_vector_type(4))) short;
using f32x16 = __attribute__((ext_vector_type(16))) float;
constexpr int D = 128, QBLK = 32, KVBLK = 64;
constexpr float SCALE = 0.088388347648318440f, THR = 8.f;
constexpr size_t SHM_V = KVBLK * D * 2, SHM_K = KVBLK * D * 2, SHM_ATTN = 2 * SHM_V + 2 * SHM_K + NW * 64 * 4;
#define KSWZ(row, colB) ((row) * 256 + ((colB) ^ (((row) & 7) << 4)))
#define SBAR() __builtin_amdgcn_sched_barrier(0)
__device__ __forceinline__ int crow(int r, int hi) { return (r & 3) + 8 * (r >> 2) + 4 * hi; }
__device__ __forceinline__ void partialSM(f32x16& p0, f32x16& p1, float& m_reg, float& mn, float& alpha) {
  constexpr float C = SCALE * 1.4426950408889634f;
  float pmax = p0[0];
#pragma unroll
  for (int r = 1; r < 16; ++r) pmax = fmaxf(pmax, p0[r]);
#pragma unroll
  for (int r = 0; r < 16; ++r) pmax = fmaxf(pmax, p1[r]);
  { auto rr = __builtin_amdgcn_permlane32_swap(__float_as_uint(pmax), __float_as_uint(pmax), false, false);
    pmax = fmaxf(__uint_as_float(rr[0]), __uint_as_float(rr[1])); }
  if (__builtin_expect(__all(pmax - m_reg <= THR / SCALE), 1)) { mn = m_reg; alpha = 1.f; }
  else { mn = fmaxf(m_reg, pmax); alpha = __builtin_amdgcn_exp2f((m_reg - mn) * C); m_reg = mn; }
  float mnC = -mn * C;
#pragma unroll
  for (int r = 0; r < 16; ++r) p0[r] = fmaf(p0[r], C, mnC);
#pragma unroll
  for (int r = 0; r < 16; ++r) p1[r] = fmaf(p1[r], C, mnC);
#pragma unroll
  for (int r = 0; r < 16; ++r) p0[r] = __builtin_amdgcn_exp2f(p0[r]);
}
__device__ __forceinline__ void finishSM(f32x16& p0, f32x16& p1, float alpha, float& l_reg, bf16x8& pa0, bf16x8& pa1, bf16x8& pa2, bf16x8& pa3) {
#pragma unroll
  for (int r = 0; r < 16; ++r) p1[r] = __builtin_amdgcn_exp2f(p1[r]);
  float ps = 0;
#pragma unroll
  for (int r = 0; r < 16; ++r) ps += p0[r];
#pragma unroll
  for (int r = 0; r < 16; ++r) ps += p1[r];
  { auto rr = __builtin_amdgcn_permlane32_swap(__float_as_uint(ps), __float_as_uint(ps), false, false);
    ps = __uint_as_float(rr[0]) + __uint_as_float(rr[1]); }
  l_reg = l_reg * alpha + ps;
#define PK4(P, BASE, OUT) do { unsigned a0 = cvt_pk(P[BASE + 0], P[BASE + 1]), a1 = cvt_pk(P[BASE + 2], P[BASE + 3]);   \
    unsigned b0 = cvt_pk(P[BASE + 4], P[BASE + 5]), b1 = cvt_pk(P[BASE + 6], P[BASE + 7]);                              \
    auto r0 = __builtin_amdgcn_permlane32_swap(a0, b0, false, false); auto r1 = __builtin_amdgcn_permlane32_swap(a1, b1, false, false); \
    u32x4 w = {r0[0], r1[0], r0[1], r1[1]}; OUT = *reinterpret_cast<bf16x8*>(&w); } while (0)
  PK4(p0, 0, pa0); PK4(p0, 8, pa1); PK4(p1, 0, pa2); PK4(p1, 8, pa3);
#undef PK4
}
__device__ __forceinline__ void qkt(f32x16& p0, f32x16& p1, const bf16_t* Ks, const bf16x8* qr, int r32, int hi) {
  p0 = f32x16{}; p1 = f32x16{};
#pragma unroll
  for (int d0 = 0; d0 < 8; ++d0) { int cb = (d0 * 16 + hi * 8) * 2;
    bf16x8 b0 = *reinterpret_cast<const bf16x8*>((const char*)Ks + KSWZ(r32, cb));
    bf16x8 b1 = *reinterpret_cast<const bf16x8*>((const char*)Ks + KSWZ(32 + r32, cb));
    p0 = __builtin_amdgcn_mfma_f32_32x32x16_bf16(b0, qr[d0], p0, 0, 0, 0);
    p1 = __builtin_amdgcn_mfma_f32_32x32x16_bf16(b1, qr[d0], p1, 0, 0, 0); }
}
__device__ __forceinline__ int v_st(int k, int c) { const int kk = (k & ~0xC) | ((k & 4) << 1) | ((k & 8) >> 1); return ((kk >> 3) * 4 + (c >> 5)) * 512 + ((kk & 7) * 32 + (c & 31)) * 2; }
__device__ __forceinline__ int v_rd_base(int lane) { return ((lane & 3) << 3) | (((lane >> 2) & 3) << 6) | (((lane >> 4) & 1) << 5) | (((lane >> 5) & 1) << 8); }
constexpr int v_rd_off(int d0, int ks, int half) { return d0 * 512 + ks * 4096 + half * 2048; }
template <int OFF> __device__ __forceinline__ s16x4 tr_read(int vb) {
  s16x4 r; asm volatile("ds_read_b64_tr_b16 %0, %1 offset:%2" : "=&v"(r) : "v"(vb), "i"(OFF) : "memory"); return r;
}
template <int D0> __device__ __forceinline__ void pv_one(f32x16& od, int vb, bf16x8 pa0, bf16x8 pa1, bf16x8 pa2, bf16x8 pa3) {
  const s16x4 l0 = tr_read<v_rd_off(D0, 0, 0)>(vb), h0 = tr_read<v_rd_off(D0, 0, 1)>(vb), l1 = tr_read<v_rd_off(D0, 1, 0)>(vb), h1 = tr_read<v_rd_off(D0, 1, 1)>(vb);
  const s16x4 l2 = tr_read<v_rd_off(D0, 2, 0)>(vb), h2 = tr_read<v_rd_off(D0, 2, 1)>(vb), l3 = tr_read<v_rd_off(D0, 3, 0)>(vb), h3 = tr_read<v_rd_off(D0, 3, 1)>(vb);
  asm volatile("s_waitcnt lgkmcnt(0)" ::: "memory"); SBAR();
#define PK(L, H) (bf16x8){L[0], L[1], L[2], L[3], H[0], H[1], H[2], H[3]}
  od = __builtin_amdgcn_mfma_f32_32x32x16_bf16(pa0, PK(l0, h0), od, 0, 0, 0);
  od = __builtin_amdgcn_mfma_f32_32x32x16_bf16(pa1, PK(l1, h1), od, 0, 0, 0);
  od = __builtin_amdgcn_mfma_f32_32x32x16_bf16(pa2, PK(l2, h2), od, 0, 0, 0);
  od = __builtin_amdgcn_mfma_f32_32x32x16_bf16(pa3, PK(l3, h3), od, 0, 0, 0);
#undef PK
}
__device__ __forceinline__ void pv_d0(f32x16* o, int vb, bf16x8 pa0, bf16x8 pa1, bf16x8 pa2, bf16x8 pa3) {
  pv_one<0>(o[0], vb, pa0, pa1, pa2, pa3); pv_one<1>(o[1], vb, pa0, pa1, pa2, pa3); pv_one<2>(o[2], vb, pa0, pa1, pa2, pa3); pv_one<3>(o[3], vb, pa0, pa1, pa2, pa3);
}
__device__ __forceinline__ void attn_body(const bf16_t* __restrict__ Qb, int ldq, const bf16_t* __restrict__ Kh, const bf16_t* __restrict__ Vh, int ldk,
                                          const bf16_t* __restrict__ Gb, int ldg, bf16_t* __restrict__ Ob, int ldo, int seq, char* lds, float* __restrict__ Opart, float* __restrict__ MLpart) {
  int tid = threadIdx.x; asm volatile("" : "+v"(tid));
  const int wid = tid >> 6, lane = tid & 63, r32 = lane & 31, hi = lane >> 5;
  bf16_t* V_lds = (bf16_t*)lds; bf16_t* K_lds = (bf16_t*)(lds + 2 * SHM_V);
  float* wsf = (float*)(lds + 2 * SHM_V + 2 * SHM_K) + wid * 64; float* li_l = wsf; float* al_l = wsf + 32;
  float m_reg = -1e30f, l_reg = 0; f32x16 o[4] = {}; bf16x8 qr[8];
  const bf16_t* Qw = Qb + (long)(wid * QBLK + r32) * ldq + hi * 8;
#pragma unroll
  for (int d0 = 0; d0 < 8; ++d0) qr[d0] = *reinterpret_cast<const bf16x8*>(Qw + d0 * 16);
  const int sr = tid >> 4, sc = (tid & 15) * 8, vst0 = v_st(sr, sc), vst1 = v_st(32 + sr, sc);
  const int vb0 = (int)(uintptr_t)V_lds + v_rd_base(lane);
  constexpr int SDEPTH = 1;
  struct { bf16x8 vs0, vs1, ks0, ks1; } sr_[SDEPTH];
  const unsigned kvoff0 = (unsigned)(sr * ldk + sc) * 2u, kvoff1 = kvoff0 + (unsigned)(64 * ldk);
#define SLOAD(i, k0) do { const char* vb_ = (const char*)Vh + (size_t)(k0) * ldk * 2; const char* kb_ = (const char*)Kh + (size_t)(k0) * ldk * 2; \
    sr_[i].vs0 = *reinterpret_cast<const bf16x8*>(vb_ + kvoff0); sr_[i].vs1 = *reinterpret_cast<const bf16x8*>(vb_ + kvoff1); \
    sr_[i].ks0 = *reinterpret_cast<const bf16x8*>(kb_ + kvoff0); sr_[i].ks1 = *reinterpret_cast<const bf16x8*>(kb_ + kvoff1); } while (0)
#define SWRITE(b, i) do { *(bf16x8*)((char*)V_lds + (b) * SHM_V + vst0) = sr_[i].vs0;          \
    *(bf16x8*)((char*)V_lds + (b) * SHM_V + vst1) = sr_[i].vs1; int kc = sc * 2;               \
    *(bf16x8*)((char*)K_lds + (b) * SHM_K + KSWZ(sr, kc)) = sr_[i].ks0;                       \
    *(bf16x8*)((char*)K_lds + (b) * SHM_K + KSWZ(32 + sr, kc)) = sr_[i].ks1; } while (0)
#define SWAIT() do { if constexpr (SDEPTH == 2) asm volatile("s_waitcnt vmcnt(4)" ::: "memory"); else asm volatile("s_waitcnt vmcnt(0)" ::: "memory"); } while (0)
#define RESC(a) do { if (__any((a) < 1.f)) { if (hi == 0) al_l[r32] = (a); asm volatile("s_waitcnt lgkmcnt(0)" ::: "memory"); \
    _Pragma("unroll") for (int d = 0; d < 4; ++d) _Pragma("unroll") for (int r = 0; r < 16; ++r) o[d][r] *= al_l[crow(r, hi)]; } } while (0)
  f32x16 pA0, pA1, pB0, pB1; float mnA, mnB, alA, alB; bf16x8 pa0, pa1, pa2, pa3; const int NTL = seq / KVBLK;
  constexpr int SE = 0, SO = SDEPTH - 1;
  SLOAD(SE, 0); asm volatile("s_waitcnt vmcnt(0)" ::: "memory"); SWRITE(0, SE); __syncthreads();
  qkt(pA0, pA1, K_lds, qr, r32, hi); partialSM(pA0, pA1, m_reg, mnA, alA);
  SLOAD(SO, KVBLK); if constexpr (SDEPTH == 2) { if (2 < NTL) SLOAD(SE, 2 * KVBLK); }
  SWAIT(); SWRITE(1, SO); __syncthreads();
  for (int j = 1; j + 1 < NTL; j += 2) {
    SBAR(); qkt(pB0, pB1, (bf16_t*)((char*)K_lds + SHM_K), qr, r32, hi);
    finishSM(pA0, pA1, alA, l_reg, pa0, pa1, pa2, pa3); SBAR();
    SLOAD(SO, (j + SDEPTH) * KVBLK); SBAR();
    pv_d0(o, vb0, pa0, pa1, pa2, pa3); partialSM(pB0, pB1, m_reg, mnB, alB);
    __syncthreads(); SWAIT(); SWRITE(0, SE);
    RESC(alB); __syncthreads();
    SBAR(); qkt(pA0, pA1, K_lds, qr, r32, hi);
    finishSM(pB0, pB1, alB, l_reg, pa0, pa1, pa2, pa3); SBAR();
    if (SDEPTH == 1 || j + 3 < NTL) SLOAD(SE, (j + 1 + SDEPTH) * KVBLK); SBAR();
    pv_d0(o, vb0 + (int)SHM_V, pa0, pa1, pa2, pa3); partialSM(pA0, pA1, m_reg, mnA, alA);
    __syncthreads(); SWAIT(); SWRITE(1, SO);
    RESC(alA); __syncthreads();
  }
  SBAR(); qkt(pB0, pB1, (bf16_t*)((char*)K_lds + SHM_K), qr, r32, hi);
  finishSM(pA0, pA1, alA, l_reg, pa0, pa1, pa2, pa3); SBAR();
  pv_d0(o, vb0, pa0, pa1, pa2, pa3); partialSM(pB0, pB1, m_reg, mnB, alB);
  __syncthreads(); RESC(alB);
  finishSM(pB0, pB1, alB, l_reg, pa0, pa1, pa2, pa3); SBAR();
  pv_d0(o, vb0 + (int)SHM_V, pa0, pa1, pa2, pa3);
  if (Opart) {
    float* Ow = Opart + (long)(wid * QBLK) * D;
#pragma unroll
    for (int r = 0; r < 16; ++r) { const int orow = crow(r, hi);
#pragma unroll
      for (int d0 = 0; d0 < 4; ++d0) Ow[orow * D + d0 * 32 + r32] = o[d0][r]; }
    if (hi == 0) *(f32x2*)(MLpart + (wid * QBLK + r32) * 2) = (f32x2){m_reg, l_reg};
    __syncthreads();
    return;
  }
  if (hi == 0) li_l[r32] = l_reg; asm volatile("s_waitcnt lgkmcnt(0)" ::: "memory");
  float rli[16];
#pragma unroll
  for (int r = 0; r < 16; ++r) rli[r] = __builtin_amdgcn_rcpf(li_l[crow(r, hi)]);
  bf16_t* Ow = Ob + (long)(wid * QBLK) * ldo; const bf16_t* Gw = Gb + (long)(wid * QBLK) * ldg;
  bf16_t* stg = K_lds + wid * 2048;
#pragma unroll
  for (int ph = 0; ph < 2; ++ph) {
#pragma unroll
    for (int r = 0; r < 16; ++r) { const int orow = crow(r, hi);
#pragma unroll
      for (int dd = 0; dd < 2; ++dd) stg[orow * 64 + dd * 32 + r32] = (bf16_t)f2bf(o[2 * ph + dd][r] * rli[r]); }
    asm volatile("s_waitcnt lgkmcnt(0)" ::: "memory");
#pragma unroll
    for (int i = 0; i < 4; ++i) { const int row = i * 8 + (lane >> 3), ch = lane & 7;
      const u32x4 ov = *(const u32x4*)(stg + row * 64 + ch * 8), g = *(const u32x4*)(Gw + (long)row * ldg + ph * 64 + ch * 8);
      u32x4 w; w.x = cvt_pk(bflo(ov.x) * bflo(g.x), bfhi(ov.x) * bfhi(g.x)); w.y = cvt_pk(bflo(ov.y) * bflo(g.y), bfhi(ov.y) * bfhi(g.y));
      w.z = cvt_pk(bflo(ov.z) * bflo(g.z), bfhi(ov.z) * bfhi(g.z)); w.w = cvt_pk(bflo(ov.w) * bflo(g.w), bfhi(ov.w) * bfhi(g.w));
      *(u32x4*)(Ow + (long)row * ldo + ph * 64 + ch * 8) = w; }
    asm volatile("s_waitcnt lgkmcnt(0)" ::: "memory");
  }
  __syncthreads();
#undef SLOAD
#undef SWRITE
#undef SWAIT
#undef RESC
}
#undef KSWZ
#undef SBAR
}

namespace hy {
using f32x16 = __attribute__((ext_vector_type(16))) float;
constexpr int Z_OFF = 0, T_OFF = 65536, TW = 8448, ZERO_OFF = T_OFF + 8 * TW;
template <int L>
__device__ __forceinline__ void unit(const Params& p, int layer, int base, int cg, LAS unsigned char* lds, const bf16_t* P, bf16_t* HM, const bf16_t* Tl) {
    constexpr int NB = L / 32, NP = L / 256, C1OFF = 4 * L + 68;
    int tid = threadIdx.x; asm volatile("" : "+v"(tid));
    const int lane = tid & 63, wave = __builtin_amdgcn_readfirstlane(tid >> 6);
#define HY_MARK(id) do { if ((TS_J) != 0 && (int)blockIdx.x == (TS_BLK) && threadIdx.x == 0) { const unsigned long long t_ = __builtin_amdgcn_s_memrealtime(); ((volatile LAS unsigned*)(lds + MISC_OFF))[16 + 2 * (id)] = (unsigned)t_; ((volatile LAS unsigned*)(lds + MISC_OFF))[17 + 2 * (id)] = (unsigned)(t_ >> 32); } } while (0)
    HY_MARK(23);
    const float* cw = p.in[12] + (size_t)layer * 3 * 3072; const float* cb = p.in[13] + layer * 3072;
    u32x4 d[NP];
    { const unsigned char* Tsrc = (const unsigned char*)(Tl + (size_t)(cg * 32 + wave * 4) * (2 * L));
#pragma unroll
      for (int i = 0; i < NP; ++i) d[i] = *(const u32x4*)(Tsrc + i * 1024 + lane * 16); }
    {
        const int q = tid >> 2, oct = tid & 3, n = q >> 2, c = q & 3, T0 = n * 32 + c * 8, ch0 = cg * 32 + oct * 8;
        if (tid < 16) *(LAS unsigned*)(lds + ZERO_OFF + tid * 4) = 0u;
        const bf16_t* src = P + (size_t)(base + T0) * DIN + OFF_HY + ch0;
        const bool has_prev = (T0 & (L - 1)) != 0, has_next = ((T0 + 8) & (L - 1)) != 0;
        u32x4 r1[10], r2[10];
#pragma unroll
        for (int j = 0; j < 10; ++j) {
            const bool ok = (j == 0) ? has_prev : (j == 9 ? has_next : true);
            if (ok) { r1[j] = *(const u32x4*)(src + (long)(j - 1) * DIN + DHY); r2[j] = *(const u32x4*)(src + (long)(j - 1) * DIN + 2 * DHY); }
            else { r1[j] = (u32x4){0u, 0u, 0u, 0u}; r2[j] = (u32x4){0u, 0u, 0u, 0u}; }
        }
        f32x4 W1[3][2], W2[3][2], B1[2], B2[2];
#pragma unroll
        for (int i = 0; i < 2; ++i) { B1[i] = *(const f32x4*)(cb + DHY + ch0 + 4 * i); B2[i] = *(const f32x4*)(cb + 2 * DHY + ch0 + 4 * i);
#pragma unroll
            for (int tp = 0; tp < 3; ++tp) { W1[tp][i] = *(const f32x4*)(cw + tp * 3072 + DHY + ch0 + 4 * i); W2[tp][i] = *(const f32x4*)(cw + tp * 3072 + 2 * DHY + ch0 + 4 * i); } }
#pragma unroll
        for (int cc = 0; cc < 8; ++cc) {
            const float w10 = W1[0][cc >> 2][cc & 3], w11 = W1[1][cc >> 2][cc & 3], w12 = W1[2][cc >> 2][cc & 3], b1 = B1[cc >> 2][cc & 3];
            const float w20 = W2[0][cc >> 2][cc & 3], w21 = W2[1][cc >> 2][cc & 3], w22 = W2[2][cc >> 2][cc & 3], b2 = B2[cc >> 2][cc & 3];
            float x1[10], x2[10];
#pragma unroll
            for (int j = 0; j < 10; ++j) { const unsigned a = r1[j][cc >> 1], b = r2[j][cc >> 1]; x1[j] = (cc & 1) ? bfhi(a) : bflo(a); x2[j] = (cc & 1) ? bfhi(b) : bflo(b); }
            float z[8];
#pragma unroll
            for (int e = 0; e < 8; ++e) { const float u1 = b1 + w10 * x1[e] + w11 * x1[e + 1] + w12 * x1[e + 2], u2 = b2 + w20 * x2[e] + w21 * x2[e + 1] + w22 * x2[e + 2]; z[e] = u1 * u2; }
            u32x4 w; w.x = cvt_pk(z[0], z[1]); w.y = cvt_pk(z[2], z[3]); w.z = cvt_pk(z[4], z[5]); w.w = cvt_pk(z[6], z[7]);
            *(LAS u32x4*)(lds + Z_OFF + (oct * 8 + cc) * 2048 + n * 64 + ((c ^ ((n >> 2) & 3)) << 4)) = w;
        }
    }
    __syncthreads();
    HY_MARK(24);
    {
        LAS unsigned char* tw = lds + T_OFF + wave * TW;
        const int r = lane & 31, h = lane >> 5, e = r & 1;
        for (int ci = 0; ci < 4; ++ci) {
            const int chl = wave * 4 + ci, ch = cg * 32 + chl;
#pragma unroll
            for (int i = 0; i < NP; ++i) {
                *(LAS u32x4*)(tw + i * 1024 + lane * 16) = d[i];
                unsigned nx = (unsigned)__builtin_amdgcn_ds_bpermute(((lane + 1) & 63) << 2, (int)d[i].x);
                const unsigned nfirst = (i + 1 < NP) ? (unsigned)__builtin_amdgcn_readlane((int)d[(i + 1 < NP) ? i + 1 : i].x, 0) : 0u;
                if (lane == 63) nx = nfirst;
                LAS unsigned* o = (LAS unsigned*)(tw + C1OFF + i * 1024 + lane * 16);
                o[0] = __builtin_amdgcn_alignbit(d[i].y, d[i].x, 16); o[1] = __builtin_amdgcn_alignbit(d[i].z, d[i].y, 16);
                o[2] = __builtin_amdgcn_alignbit(d[i].w, d[i].z, 16); o[3] = __builtin_amdgcn_alignbit(nx, d[i].w, 16);
            }
            LDS_WAIT(); __builtin_amdgcn_wave_barrier();
            if (ci < 3) { const unsigned char* Tsrc = (const unsigned char*)(Tl + (size_t)(ch + 1) * (2 * L));
#pragma unroll
                for (int i = 0; i < NP; ++i) d[i] = *(const u32x4*)(Tsrc + i * 1024 + lane * 16); }
            const LAS unsigned char* aBase = tw + e * C1OFF + ((((L - r - e) >> 1) + 4 * h) << 2);
            const LAS unsigned char* zc = lds + Z_OFF + chl * 2048;
            f32x16 acc0 = {}, acc1 = {};
#pragma unroll 3
            for (int k = -(NB - 1); k <= NB - 1; ++k) {
                const int np = r - k;
                const bool valid = (L == 1024) ? ((unsigned)np < 32u) : ((unsigned)((r & 7) - k) < 8u);
                const int c0 = h ^ ((np >> 2) & 3);
                const LAS unsigned char* zp = zc + np * 64;
                const LAS unsigned char* z0 = valid ? zp + (c0 << 4) : lds + ZERO_OFF;
                const LAS unsigned char* z1 = valid ? zp + ((c0 ^ 2) << 4) : lds + ZERO_OFF;
                const LAS unsigned* ap = (const LAS unsigned*)(aBase - 64 * k);
                const u32x4 a0 = {ap[0], ap[1], ap[2], ap[3]}, a1 = {ap[8], ap[9], ap[10], ap[11]};
                const bf16x8 b0 = *(const LAS bf16x8*)z0, b1 = *(const LAS bf16x8*)z1;
                acc0 = __builtin_amdgcn_mfma_f32_32x32x16_bf16(__builtin_bit_cast(bf16x8, a0), b0, acc0, 0, 0, 0);
                acc1 = __builtin_amdgcn_mfma_f32_32x32x16_bf16(__builtin_bit_cast(bf16x8, a1), b1, acc1, 0, 0, 0);
            }
#pragma unroll
            for (int q = 0; q < 4; ++q) {
                u32x2 w; w.x = cvt_pk(acc0[4 * q] + acc1[4 * q], acc0[4 * q + 1] + acc1[4 * q + 1]); w.y = cvt_pk(acc0[4 * q + 2] + acc1[4 * q + 2], acc0[4 * q + 3] + acc1[4 * q + 3]);
                *(LAS u32x2*)(lds + Z_OFF + chl * 2048 + r * 64 + ((q ^ ((r >> 2) & 3)) << 4) + h * 8) = w;
            }
            LDS_WAIT(); __builtin_amdgcn_wave_barrier();
        }
    }
    __syncthreads();
    HY_MARK(25);
    {
        const int oct = tid & 3, ch0 = cg * 32 + oct * 8;
        f32x4 w0[2], w1[2], w2[2], bb[2];
#pragma unroll
        for (int i = 0; i < 2; ++i) { w0[i] = *(const f32x4*)(cw + ch0 + 4 * i); w1[i] = *(const f32x4*)(cw + 3072 + ch0 + 4 * i); w2[i] = *(const f32x4*)(cw + 2 * 3072 + ch0 + 4 * i); bb[i] = *(const f32x4*)(cb + ch0 + 4 * i); }
        for (int it0 = 0; it0 < 8; it0 += 4) {
            u32x4 xp[4], xc[4], xn[4], gh[4];
#pragma unroll
            for (int q = 0; q < 4; ++q) {
                const int T = (tid >> 2) + 128 * (it0 + q);
                const bf16_t* src = P + (size_t)(base + T) * DIN + OFF_HY + ch0;
                const bool has_prev = (T & (L - 1)) != 0, has_next = ((T + 1) & (L - 1)) != 0;
                xc[q] = *(const u32x4*)src;
                xp[q] = *(const u32x4*)(has_prev ? src - DIN : src);
                xn[q] = *(const u32x4*)(has_next ? src + DIN : src);
                if (!has_prev) xp[q] = (u32x4){0u, 0u, 0u, 0u};
                if (!has_next) xn[q] = (u32x4){0u, 0u, 0u, 0u};
                gh[q] = *(const u32x4*)(P + (size_t)(base + T) * DIN + OFF_GH + ch0);
            }
#pragma unroll
            for (int q = 0; q < 4; ++q) {
                const int T = (tid >> 2) + 128 * (it0 + q), n = T >> 5, i = T & 31;
                const LAS unsigned char* yb = lds + Z_OFF + (oct * 8) * 2048 + n * 64 + (((i >> 3) ^ ((n >> 2) & 3)) << 4) + (i & 7) * 2;
                float o[8];
#pragma unroll
                for (int cc = 0; cc < 8; ++cc) {
                    const unsigned a = xp[q][cc >> 1], b = xc[q][cc >> 1], c2 = xn[q][cc >> 1], g = gh[q][cc >> 1];
                    const float fp = (cc & 1) ? bfhi(a) : bflo(a), fc = (cc & 1) ? bfhi(b) : bflo(b), fn = (cc & 1) ? bfhi(c2) : bflo(c2), fg = (cc & 1) ? bfhi(g) : bflo(g);
                    const float x0 = bb[cc >> 2][cc & 3] + w0[cc >> 2][cc & 3] * fp + w1[cc >> 2][cc & 3] * fc + w2[cc >> 2][cc & 3] * fn;
                    const float y = bf2f(*(const LAS unsigned short*)(yb + cc * 2048));
                    o[cc] = x0 * y * fg;
                }
                u32x4 w; w.x = cvt_pk(o[0], o[1]); w.y = cvt_pk(o[2], o[3]); w.z = cvt_pk(o[4], o[5]); w.w = cvt_pk(o[6], o[7]);
                *(u32x4*)(HM + (size_t)(base + T) * DM + DHY + ch0) = w;
            }
        }
    }
    __syncthreads();
    HY_MARK(26);
}
}

__device__ __forceinline__ void prep_wave_items(const Params& p, int l, bool do_gemv, bool do_win, bool do_wout, bool do_common, int widx, int nw, int lane,
                                                LAS float* scr, const LAS float* sc, unsigned char* ws) {
    bf16_t* WinT = (bf16_t*)(ws + WS_WIN); bf16_t* WoutT = (bf16_t*)(ws + WS_WOUT); bf16_t* KL = (bf16_t*)(ws + WS_KL); bf16_t* VL = (bf16_t*)(ws + WS_VL);
    float* modp = (float*)(ws + WS_MODP); float* rope = (float*)(ws + WS_ROPE);
    constexpr int I_WIN = (DM / 64) * (DIN / 64), I_WOUT = (DM / 64) * (DM / 64), I_CACHE = 2 * 2 * 2 * PAST, I_ROPE = 0;
    const int n_gemv = do_gemv ? 48 * MODP : 0, n_win = do_win ? I_WIN : 0, n_wout = do_wout ? I_WOUT : 0, n_common = do_common ? I_CACHE + I_ROPE : 0;
    const int total = n_gemv + n_win + n_wout + n_common;
    for (int it = widx; it < total; it += nw) {
        int r = it;
        if (r < n_gemv) {
            const int nc = r % 48, kc = r / 48, kh = lane >> 5, c4 = (lane & 31) * 4;
            const float* w = p.in[7] + ((size_t)l * DM + kc * (DM / MODP) + kh) * (3 * DM) + nc * 128 + c4;
            f32x4 a0 = {0.f, 0.f, 0.f, 0.f}, a1 = a0, a2 = a0;
#pragma unroll 16
            for (int k = 0; k < DM / MODP / 2; ++k) {
                const f32x4 wv = __builtin_nontemporal_load((const GAS f32x4*)((const GAS float*)w + (size_t)(2 * k) * (3 * DM)));
                const int kk = kc * (DM / MODP) + 2 * k + kh;
                a0 += wv * sc[kk]; a1 += wv * sc[DM + kk]; a2 += wv * sc[2 * DM + kk];
            }
#pragma unroll
            for (int e = 0; e < 4; ++e) { a0[e] += shx(a0[e], 32, lane); a1[e] += shx(a1[e], 32, lane); a2[e] += shx(a2[e], 32, lane); }
            if (lane < 32) {
                float* o = modp + ((size_t)(l * MODP + kc) * 3) * (3 * DM) + nc * 128 + c4;
                *(f32x4*)o = a0; *(f32x4*)(o + 3 * DM) = a1; *(f32x4*)(o + 2 * 3 * DM) = a2;
            }
            continue;
        }
        r -= n_gemv;
        if (r < n_win) { p0_transpose_item(p.in[9] + (size_t)l * DM * DIN, DM, DIN, WinT + (size_t)l * DIN * DM, scr, r, lane); continue; }
        r -= n_win;
        if (r < n_wout) { p0_transpose_item(p.in[21] + (size_t)l * DM * DM, DM, DM, WoutT + (size_t)l * DM * DM, scr, r, lane); continue; }
        r -= n_wout;
        if (r < I_CACHE) {
            const int s_ = r % PAST, l2 = (r / PAST) & 1, b = (r / (2 * PAST)) & 1, which = r / (4 * PAST);
            const float* src = p.in[2 + which] + (((size_t)b * 2 + l2) * PAST + s_) * DKV + lane * 8;
            const f32x4 v0 = *(const f32x4*)src, v1 = *(const f32x4*)(src + 4);
            u32x4 w; w.x = pk2(v0[0], v0[1]); w.y = pk2(v0[2], v0[3]); w.z = pk2(v1[0], v1[1]); w.w = pk2(v1[2], v1[3]);
            bf16_t* dst = (which ? VL : KL) + (((size_t)l2 * 2 + b) * KVL + LS + s_) * DKV + lane * 8;
            *(u32x4*)dst = w;
            continue;
        }
        r -= I_CACHE;
        { (void)rope; }
    }
}
__device__ __forceinline__ void mod_reduce(const Params& p, int l, int idx, unsigned char* ws) {
    const float* modp = (const float*)(ws + WS_MODP); float* modf = (float*)(ws + WS_MODF);
    if (idx < 3 * 3 * DM) {
        const int n = idx % (3 * DM), j = idx / (3 * DM); float sacc = p.in[8][l * 3 * DM + n];
#pragma unroll 8
        for (int q = 0; q < MODP; ++q) sacc += modp[((size_t)(l * MODP + q) * 3 + j) * (3 * DM) + n];
        modf[(size_t)l * 3 * 3 * DM + idx] = sacc;
    }
}
#define LOAD_SILU_C(sc_) do { for (int i_ = tid; i_ < DM; i_ += NT) { (sc_)[i_] = silu_f(p.in[5][i_]); (sc_)[DM + i_] = silu_f(p.in[4][i_]); (sc_)[2 * DM + i_] = silu_f(p.in[4][DM + i_]); } __syncthreads(); } while (0)

#define XB_TMO      128
#define XB_XCNT(j)  (256  + 64 * (j))
#define XB_XSUB(j)  (1280 + 64 * (j))
#define XB_XGEN(j)  (2304 + 64 * (j))
#define XB_TOP      3328
#define XB_TOPGEN   3392
#define XCD_BAR_WORDS 3456
#define XB_SPIN_CAP (1u << 18)
__device__ __forceinline__ unsigned xb_ld(unsigned* p)              { return __hip_atomic_load(p, __ATOMIC_RELAXED, __HIP_MEMORY_SCOPE_AGENT); }
__device__ __forceinline__ unsigned xb_add(unsigned* p, unsigned v) { return __hip_atomic_fetch_add(p, v, __ATOMIC_RELAXED, __HIP_MEMORY_SCOPE_AGENT); }
__device__ __forceinline__ unsigned xb_xcc_id() { return (unsigned)__builtin_amdgcn_s_getreg((3 << 11) | 20) & 0xFu; }
#define XB_SPIN(cond, bar) do { unsigned _sp = 0; while (cond) { __builtin_amdgcn_s_sleep(1); \
    if ((++_sp & 255u) == 0u) { if (xb_ld(&(bar)[XB_TMO])) break; if (_sp > XB_SPIN_CAP) { atomicAdd(&(bar)[XB_TMO], 1u); break; } } } } while (0)
struct XcdBarrier { unsigned* bar; unsigned x; volatile LAS unsigned* st; };
__device__ __forceinline__ XcdBarrier xcd_barrier_post(unsigned* bar, volatile LAS unsigned* st) {
    XcdBarrier b; b.bar = bar; b.x = xb_xcc_id(); b.st = st;
    if (threadIdx.x == 0) (void)xb_add(&bar[XB_XCNT(b.x)], 1u);
    return b;
}
__device__ __forceinline__ void xcd_barrier_complete(unsigned* bar, unsigned x, unsigned& nloc, unsigned& nx) {
    const unsigned G = gridDim.x * gridDim.y * gridDim.z;
    unsigned sum, cnt, mine, sp = 0u;
    for (;;) {
        sum = 0u; cnt = 0u; mine = 0u;
#pragma unroll
        for (unsigned j = 0; j < 16; ++j) { const unsigned c = xb_ld(&bar[XB_XCNT(j)]); sum += c; cnt += (c > 0u) ? 1u : 0u; mine = (j == x) ? c : mine; }
        if (sum == G) break;
        __builtin_amdgcn_s_sleep(1);
        if ((++sp & 255u) == 0u) { if (xb_ld(&bar[XB_TMO])) break; if (sp > XB_SPIN_CAP) { atomicAdd(&bar[XB_TMO], 1u); break; } }
    }
    nloc = mine > 0u ? mine : 1u; nx = cnt > 0u ? cnt : 1u;
}
__device__ __forceinline__ void xcd_barrier(const XcdBarrier& b) {
    asm volatile("s_waitcnt vmcnt(0)" ::: "memory");
    __syncthreads();
    int t0_ = threadIdx.x; asm volatile("" : "+v"(t0_));
    if (t0_ == 0) {
        unsigned* bar = b.bar;
        __builtin_amdgcn_s_waitcnt(0);
        unsigned nloc = b.st[0], nx = b.st[1];
        if (nloc == 0u) { xcd_barrier_complete(bar, b.x, nloc, nx); b.st[0] = nloc; b.st[1] = nx; }
        const unsigned old = xb_add(&bar[XB_XSUB(b.x)], 1u);
        const unsigned gen = old / nloc;
        if (old + 1u == (gen + 1u) * nloc) {
            __builtin_amdgcn_fence(__ATOMIC_RELEASE, "agent");
            asm volatile("s_waitcnt vmcnt(0)" ::: "memory");
            const unsigned og = xb_add(&bar[XB_TOP], 1u);
            const unsigned tg = og / nx;
            if (og + 1u == (tg + 1u) * nx) xb_add(&bar[XB_TOPGEN], 1u);
            else XB_SPIN(xb_ld(&bar[XB_TOPGEN]) == tg, bar);
            __builtin_amdgcn_fence(__ATOMIC_ACQUIRE, "agent");
            xb_add(&bar[XB_XGEN(b.x)], 1u);
            asm volatile("s_waitcnt vmcnt(0)" ::: "memory");
        } else {
            XB_SPIN(xb_ld(&bar[XB_XGEN(b.x)]) == gen, bar);
            __builtin_amdgcn_fence(__ATOMIC_ACQUIRE, "agent");
            asm volatile("s_waitcnt vmcnt(0)" ::: "memory");
        }
    }
    __syncthreads();
}

__global__ void __launch_bounds__(NT, 2) fwd_megakernel(Params p) {
    extern __shared__ __attribute__((aligned(16))) unsigned char lds_raw[];
    LAS unsigned char* lds = (LAS unsigned char*)lds_raw;
    if (threadIdx.x < 2) ((volatile LAS unsigned*)(lds + MISC_OFF))[threadIdx.x] = 0u;
    __syncthreads();
    (void)xcd_barrier_post((unsigned*)(p.ws + WS_BAR), (volatile LAS unsigned*)(lds + MISC_OFF));
#define GRID_SYNC() do { XcdBarrier gb_; gb_.bar = (unsigned*)(p.ws + WS_BAR); gb_.x = xb_xcc_id(); gb_.st = (volatile LAS unsigned*)(lds + MISC_OFF); xcd_barrier(gb_); } while (0)
    const int wave = __builtin_amdgcn_readfirstlane(threadIdx.x >> 6);
    const int G = gridDim.x, bx = blockIdx.x, vcu = (G % 8 == 0) ? (bx % 8) * (G / 8) + bx / 8 : bx;
    const bool split = false; const bool filt_late = false;
    const int gw = wave * G + vcu, NGW = G * NW;
#define TS_MARK(id) do { if ((TS_J) != 0 && bx == (TS_BLK) && threadIdx.x == 0) { const unsigned long long t_ = __builtin_amdgcn_s_memrealtime(); ((volatile LAS unsigned*)(lds + MISC_OFF))[16 + 2 * (id)] = (unsigned)t_; ((volatile LAS unsigned*)(lds + MISC_OFF))[17 + 2 * (id)] = (unsigned)(t_ >> 32); } } while (0)
#define PHASE_IDS() int tid = threadIdx.x; asm volatile("" : "+v"(tid)); const int lane = tid & 63; (void)lane; int gwp = gw; asm volatile("" : "+s"(gwp)); (void)gwp
    TS_MARK(0);
#define WS_PTRS() unsigned char* ws = p.ws; asm volatile("" : "+s"(ws)); \
    bf16_t* WinT = (bf16_t*)(ws + WS_WIN); bf16_t* WoutT = (bf16_t*)(ws + WS_WOUT); bf16_t* HM = (bf16_t*)(ws + WS_HM); bf16_t* P = (bf16_t*)(ws + WS_P); \
    bf16_t* KL = (bf16_t*)(ws + WS_KL); bf16_t* VL = (bf16_t*)(ws + WS_VL); float* XB = (float*)(ws + WS_XB); \
    float* modp = (float*)(ws + WS_MODP); float* modf = (float*)(ws + WS_MODF); bf16_t* Tt = (bf16_t*)(ws + WS_T); float* rope = (float*)(ws + WS_ROPE); \
    const float* x_prompt = p.in[0]; const float* x_sample = p.in[1]; \
    (void)WinT; (void)WoutT; (void)HM; (void)P; (void)KL; (void)VL; (void)XB; (void)modp; (void)modf; (void)Tt; (void)rope; (void)x_prompt; (void)x_sample

    for (int rep = 0; rep < 1 + DUP_P0; ++rep) {
        PHASE_IDS(); WS_PTRS();
        LAS float* scr = (LAS float*)(lds + wave * 8448);
        LAS float* sc = (LAS float*)(lds + 8 * 8448);
        LAS float* fscr = (LAS float*)(lds + 8 * 8448 + 3 * DM * 4);
        LOAD_SILU_C(sc);
        if (!filt_late) for (int fr_ = 0; fr_ < 1 + DUP_FILT; ++fr_) for (int fi = vcu; fi < 160; fi += G) {
            const int l = fi / 80; int r = fi % 80; int L, dir, ci; bf16_t* T = Tt + (size_t)l * T_LAYER;
            if (r < 16) { L = 256; dir = r / 8; ci = r % 8; } else { r -= 16; L = 1024; dir = r / 32; ci = r % 32; T += (size_t)DHY * 512; }
            if (dir == 0) filter_item<0>(p, l, L, ci, T, fscr); else filter_item<1>(p, l, L, ci, T, fscr);
        }
        TS_MARK(20);
        prep_wave_items(p, 0, true, true, true, true, gwp, NGW, lane, scr, sc, ws);
        TS_MARK(21);
        if (DUP_GEMV) { prep_wave_items(p, 0, true, false, false, false, gwp, NGW, lane, scr, sc, ws); prep_wave_items(p, 1, true, false, false, false, gwp, NGW, lane, scr, sc, ws); }
        if (DUP_TR) { prep_wave_items(p, 0, false, true, true, false, gwp, NGW, lane, scr, sc, ws); prep_wave_items(p, 1, false, true, true, false, gwp, NGW, lane, scr, sc, ws); }
        if (!split) prep_wave_items(p, 1, true, true, true, false, gwp, NGW, lane, scr, sc, ws);
        TS_MARK(22);
    GRID_SYNC();
    }
    TS_MARK(1);

    {
        PHASE_IDS(); WS_PTRS();
        if (vcu == 0 && tid < 32) rope[tid] = powf(10000.f, -(float)tid / 32.f) * 0.15915494309189535f;
        mod_reduce(p, 0, vcu * NT + tid, ws);
        if (!split) mod_reduce(p, 1, vcu * NT + tid, ws);
    }
    GRID_SYNC();
    TS_MARK(2);

    for (int layer = 0; layer < 2; ++layer) {
        for (int rep = 0; rep < 1 + DUP_PA; ++rep) {
            PHASE_IDS(); WS_PTRS();
            const float* ng = p.in[6] + layer * DM;
            for (int row0 = gwp; row0 < NTOK; row0 += RIF * NGW) {
                f32x4 v[RIF][8];
#pragma unroll
                for (int r = 0; r < RIF; ++r) { const int rw = row0 + r * NGW, row = rw < NTOK ? rw : NTOK - 1;
                    const float* xr = layer == 0 ? (row < NCTX ? x_prompt + (size_t)row * DM : x_sample + (size_t)(row - NCTX) * DM) : XB + (size_t)row * DM;
                    const GAS f32x4* xg = (const GAS f32x4*)xr + lane;
#pragma unroll
                    for (int i = 0; i < 8; ++i) v[r][i] = xg[64 * i]; }
                asm volatile("" ::: "memory");
#pragma unroll
                for (int r = 0; r < RIF; ++r) { const int row = row0 + r * NGW;
                    if (row < NTOK) {
                        const int j = row < NCTX ? 0 : 1 + (row - NCTX) / LS;
                        const float* mrow = modf + ((size_t)layer * 3 + j) * (3 * DM);
                        float ss = 0.f;
#pragma unroll
                        for (int i = 0; i < 8; ++i) ss += (v[r][i][0] * v[r][i][0] + v[r][i][1] * v[r][i][1]) + (v[r][i][2] * v[r][i][2] + v[r][i][3] * v[r][i][3]);
                        ss = wave_sum(ss, lane);
                        const float rs = rsqrtf(ss * (1.f / DM) + EPS);
                        f32x4 gg[8], sh[8], scl[8];
#pragma unroll
                        for (int i = 0; i < 8; ++i) { const int col = 4 * lane + 256 * i; gg[i] = *(const f32x4*)(ng + col); sh[i] = *(const f32x4*)(mrow + col); scl[i] = *(const f32x4*)(mrow + DM + col); }
#pragma unroll
                        for (int i = 0; i < 8; ++i) {
                            const int col = 4 * lane + 256 * i;
                            const f32x4 h = v[r][i] * rs * gg[i] * (scl[i] + 1.f) + sh[i];
                            u32x2 w; w.x = cvt_pk(h[0], h[1]); w.y = cvt_pk(h[2], h[3]);
                            *(u32x2*)(HM + (size_t)row * DM + col) = w;
                        }
                        asm volatile("" ::: "memory");
                    } }
            }
        GRID_SYNC();
        }
        TS_MARK(3 + 8 * layer);

        for (int rep = 0; rep < 1 + DUP_PB; ++rep) {
            WS_PTRS();
            pg8::Gemm g{HM, WinT + (size_t)layer * DIN * DM, NTOK, DIN, DM};
            pg8::StaticOrder S; S.init(NTOK, DIN, G, bx);
            EpiInProj E{P, KL + (size_t)layer * 2 * KVL * DKV, VL + (size_t)layer * 2 * KVL * DKV, p.out, p.in[10] + layer * HD, p.in[11] + layer * HD, rope, (LAS float*)(lds + XCH_OFF), layer};
            pg8::gemm_phase<EpiInProj, pg8::StaticOrder, 4>(lds, g, S, E);
            TS_MARK(4 + 8 * layer);
            if (filt_late && bx >= 160 && bx < 240) {
                WS_PTRS();
                LAS float* fscr = (LAS float*)(lds + 8 * 8448 + 3 * DM * 4);
                {
                    const int fi = layer * 80 + (bx - 160);
                    const int l = fi / 80; int r = fi % 80; int L, dir, ci; bf16_t* T = Tt + (size_t)l * T_LAYER;
                    if (r < 16) { L = 256; dir = r / 8; ci = r % 8; } else { r -= 16; L = 1024; dir = r / 32; ci = r % 32; T += (size_t)DHY * 512; }
                    if (dir == 0) filter_item<0>(p, l, L, ci, T, fscr); else filter_item<1>(p, l, L, ci, T, fscr);
                }
            }
            if (split && layer == 0 && bx >= 160) {
                PHASE_IDS();
                LAS float* scr = (LAS float*)(lds + wave * 8448); LAS float* sc = (LAS float*)(lds + 8 * 8448);
                prep_wave_items(p, 1, false, true, false, false, wave * 96 + (bx - 160), 96 * NW, lane, scr, sc, ws);
            }
        GRID_SYNC();
        }
        TS_MARK(5 + 8 * layer);

        for (int rep = 0; rep < 1 + DUP_PC; ++rep) {
            WS_PTRS();
            const bf16_t* KLl = KL + (size_t)layer * 2 * KVL * DKV; const bf16_t* VLl = VL + (size_t)layer * 2 * KVL * DKV;
            const bf16_t* T256 = Tt + (size_t)layer * T_LAYER; const bf16_t* T1024 = T256 + (size_t)DHY * 512;
            float* Opart = (float*)(ws + WS_OPART); float* MLp = (float*)(ws + WS_ML);
            for (int slot = bx; slot < 512; slot += G) {
                const int rnd = slot >> 8, i = slot & 255;
                int kind = -1, u = 0;
                if (rnd == 0) { if (i < 128) { kind = 0; u = i; } else if (i < 192) { kind = 3; u = 2 * (i - 128); } else { kind = 2; u = i - 192; } }
                else if (rnd == 1) { if (i < 128) { kind = 1; u = i; } else if (i < 192) { kind = 3; u = 2 * (i - 128) + 1; } }
                if (kind == 0 || kind == 1) {
                    const bf16_t *Qb, *Kh, *Vh, *Gb; bf16_t* Ob; int ldk, seq; float* Op = nullptr; float* Mp = nullptr;
                    if (kind == 0) { const int un = u >> 1, half = u & 1, b = un >> 5, h = (un >> 2) & 7, qb = un & 3, kv = h >> 1; const size_t tok0 = NCTX + b * LS + qb * 256;
                        Qb = P + tok0 * DIN + h * HD; Gb = P + tok0 * DIN + OFF_GA + h * HD; Ob = HM + tok0 * DM + h * HD;
                        Kh = KLl + ((size_t)b * KVL + half * (KVL / 2)) * DKV + kv * HD; Vh = VLl + ((size_t)b * KVL + half * (KVL / 2)) * DKV + kv * HD; ldk = DKV; seq = KVL / 2;
                        Op = Opart + (size_t)u * 256 * HD; Mp = MLp + (size_t)u * 256 * 2; }
                    else { const int b = u >> 3, h = u & 7, kv = h >> 1; const size_t tok0 = (size_t)b * CS;
                        Qb = P + tok0 * DIN + h * HD; Gb = P + tok0 * DIN + OFF_GA + h * HD; Ob = HM + tok0 * DM + h * HD;
                        Kh = P + tok0 * DIN + OFF_K + kv * HD; Vh = P + tok0 * DIN + OFF_V + kv * HD; ldk = DIN; seq = CS; }
                    for (int r2 = 0; r2 < 1 + DUP_ATT; ++r2) att::attn_body(Qb, DIN, Kh, Vh, ldk, Gb, DIN, Ob, DM, seq, (char*)lds_raw, Op, Mp);
                } else if (kind == 2) { for (int r2 = 0; r2 < 1 + DUP_HY; ++r2) hy::unit<1024>(p, layer, (4 + (u >> 5)) * 1024, u & 31, lds, P, HM, T1024); }
                else if (kind == 3) { for (int r2 = 0; r2 < 1 + DUP_HY; ++r2) hy::unit<256>(p, layer, (u >> 5) * 1024, u & 31, lds, P, HM, T256); }
            }
            if (split && layer == 0 && bx >= 192) {
                PHASE_IDS();
                LAS float* sc = (LAS float*)(lds + 8 * 8448);
                LOAD_SILU_C(sc);
                prep_wave_items(p, 1, true, false, false, false, wave * 64 + (bx - 192), 64 * NW, lane, (LAS float*)lds, sc, ws);
                __syncthreads();
            }
        TS_MARK(6 + 8 * layer);
        GRID_SYNC();
        TS_MARK(7 + 8 * layer);
        for (int r5 = 0; r5 < 1 + DUP_PC2; ++r5) {
            if (r5) GRID_SYNC();
            PHASE_IDS();
            const int sub = tid & 15, rl = tid >> 4;
            for (int rb0 = vcu; rb0 < 64 * 8; rb0 += 2 * G) {
                f32x2 ml0[2], ml1[2]; f32x4 a0[2], a1[2], b0[2], b1[2]; u32x4 g[2]; size_t tok[2]; int hh[2];
#pragma unroll
                for (int q = 0; q < 2; ++q) {
                    const int rbq = rb0 + q * G, rb = rbq < 64 * 8 ? rbq : rb0;
                    const int un = rb >> 3, row = (rb & 7) * 32 + rl;
                    const int b = un >> 5, h = (un >> 2) & 7, qb = un & 3; tok[q] = NCTX + b * LS + qb * 256 + row; hh[q] = h;
                    ml0[q] = *(const f32x2*)(MLp + ((size_t)(2 * un) * 256 + row) * 2); ml1[q] = *(const f32x2*)(MLp + ((size_t)(2 * un + 1) * 256 + row) * 2);
                    const float* o0 = Opart + ((size_t)(2 * un) * 256 + row) * HD + sub * 8; const float* o1 = o0 + (size_t)256 * HD;
                    a0[q] = *(const f32x4*)o0; a1[q] = *(const f32x4*)(o0 + 4); b0[q] = *(const f32x4*)o1; b1[q] = *(const f32x4*)(o1 + 4);
                    g[q] = *(const u32x4*)(P + tok[q] * DIN + OFF_GA + h * HD + sub * 8);
                }
#pragma unroll
                for (int q = 0; q < 2; ++q) {
                    if (rb0 + q * G < 64 * 8) {
                        const float M = fmaxf(ml0[q][0], ml1[q][0]), f0 = __expf(att::SCALE * (ml0[q][0] - M)), f1 = __expf(att::SCALE * (ml1[q][0] - M));
                        const float inv = 1.f / (f0 * ml0[q][1] + f1 * ml1[q][1]), w0 = f0 * inv, w1 = f1 * inv;
                        const f32x4 r0 = a0[q] * w0 + b0[q] * w1, r1 = a1[q] * w0 + b1[q] * w1;
                        u32x4 w; w.x = cvt_pk(r0[0] * bflo(g[q].x), r0[1] * bfhi(g[q].x)); w.y = cvt_pk(r0[2] * bflo(g[q].y), r0[3] * bfhi(g[q].y));
                        w.z = cvt_pk(r1[0] * bflo(g[q].z), r1[1] * bfhi(g[q].z)); w.w = cvt_pk(r1[2] * bflo(g[q].w), r1[3] * bfhi(g[q].w));
                        *(u32x4*)(HM + tok[q] * DM + hh[q] * HD + sub * 8) = w;
                    }
                }
            }
        }
        GRID_SYNC();
        }
        TS_MARK(8 + 8 * layer);

        for (int rep = 0; rep < 1 + (layer == 0 ? DUP_PD : 0); ++rep) {
            WS_PTRS();
            pg8::Gemm g{HM, WoutT + (size_t)layer * DM * DM, NTOK, DM, DM};
            pg8::StaticOrder S; S.init(NTOK, DM, G, bx, 192);
            EpiOutProj E{layer == 0 ? x_prompt : XB, layer == 0 ? x_sample : XB + (size_t)NCTX * DM, XB, modf + (size_t)layer * 3 * 3 * DM};
            pg8::gemm_phase<EpiOutProj, pg8::StaticOrder, 3>(lds, g, S, E);
            TS_MARK(9 + 8 * layer);
            if (split && layer == 0 && bx >= 192) {
                PHASE_IDS();
                LAS float* scr = (LAS float*)(lds + wave * 8448);
                prep_wave_items(p, 1, false, false, true, false, wave * 64 + (bx - 192), 64 * NW, lane, scr, (const LAS float*)scr, ws);
                mod_reduce(p, 1, (bx - 192) * NT + tid, ws);
            }
        GRID_SYNC();
        }
        TS_MARK(10 + 8 * layer);
    }

    for (int r3 = 0; r3 < DUP_SYNC; ++r3) GRID_SYNC();
    {
        PHASE_IDS(); WS_PTRS();
        const float* fg = p.in[22];
        f32x4 fgv[8];
#pragma unroll
        for (int i = 0; i < 8; ++i) fgv[i] = *(const f32x4*)(fg + 4 * lane + 256 * i);
        for (int row0 = gwp; row0 < NTOK; row0 += RIF * NGW) {
            f32x4 v[RIF][8];
#pragma unroll
            for (int r = 0; r < RIF; ++r) { const int rw = row0 + r * NGW, row = rw < NTOK ? rw : NTOK - 1;
#pragma unroll
                for (int i = 0; i < 8; ++i) v[r][i] = *(const f32x4*)(XB + (size_t)row * DM + 4 * lane + 256 * i); }
            asm volatile("" ::: "memory");
#pragma unroll
            for (int r = 0; r < RIF; ++r) { const int row = row0 + r * NGW;
                if (row < NTOK) {
                    float ss = 0.f;
#pragma unroll
                    for (int i = 0; i < 8; ++i) ss += (v[r][i][0] * v[r][i][0] + v[r][i][1] * v[r][i][1]) + (v[r][i][2] * v[r][i][2] + v[r][i][3] * v[r][i][3]);
                    ss = wave_sum(ss, lane);
                    const float rs = rsqrtf(ss * (1.f / DM) + EPS);
#pragma unroll
                    for (int i = 0; i < 8; ++i) { const int col = 4 * lane + 256 * i; *(f32x4*)(p.out + (size_t)row * DM + col) = v[r][i] * rs * fgv[i]; }
                } }
        }
    }
    TS_MARK(19);
    if ((TS_J) != 0 && bx == (TS_BLK) && threadIdx.x == 0) {
        volatile LAS unsigned* m = (volatile LAS unsigned*)(lds + MISC_OFF);
        const unsigned long long ti = ((unsigned long long)m[17 + 2 * (TS_I)] << 32) | m[16 + 2 * (TS_I)], tj = ((unsigned long long)m[17 + 2 * (TS_J)] << 32) | m[16 + 2 * (TS_J)];
        const unsigned long long t0 = __builtin_amdgcn_s_memrealtime(), want = (tj - ti) * (TS_AMP);
        while (__builtin_amdgcn_s_memrealtime() - t0 < want) __builtin_amdgcn_s_sleep(32);
    }
}

extern "C" void kernel_launch(void* const* d_in, const int* in_sizes, int n_in, void* d_out, int out_size, void* d_ws, size_t ws_size, hipStream_t stream) {
    static int grid = 0;
    if (grid == 0) {
        if (n_in != 23 || ws_size < WS_END) { fprintf(stderr, "kernel_launch: n_in %d ws %zu (need %zu)\n", n_in, ws_size, (size_t)WS_END); grid = -1; return; }
        int dev = 0, cus = 0, per_cu = 0;
        if (hipGetDevice(&dev) != hipSuccess || hipDeviceGetAttribute(&cus, hipDeviceAttributeMultiprocessorCount, dev) != hipSuccess) { grid = -1; return; }
        if (hipFuncSetAttribute((const void*)fwd_megakernel, hipFuncAttributeMaxDynamicSharedMemorySize, LDS_BYTES) != hipSuccess) { fprintf(stderr, "kernel_launch: hipFuncSetAttribute failed\n"); grid = -1; return; }
        if (hipOccupancyMaxActiveBlocksPerMultiprocessor(&per_cu, (const void*)fwd_megakernel, NT, LDS_BYTES) != hipSuccess || per_cu < 1) { fprintf(stderr, "kernel_launch: occupancy query says %d\n", per_cu); grid = -1; return; }
        grid = cus;
    }
    if (grid < 0) return;
    Params prm{};
    for (int i = 0; i < 23; ++i) prm.in[i] = (const float*)d_in[i];
    prm.out = (float*)d_out; prm.ws = (unsigned char*)d_ws;
    if (hipMemsetAsync((char*)d_ws + WS_BAR, 0, 16384, stream) != hipSuccess) { fprintf(stderr, "kernel_launch: memset failed\n"); return; }
    void* args[] = {&prm};
    hipError_t e = hipLaunchCooperativeKernel((const void*)fwd_megakernel, dim3(grid), dim3(NT), args, LDS_BYTES, stream);
    if (e != hipSuccess) fprintf(stderr, "cooperative launch failed: %s (grid %d)\n", hipGetErrorString(e), grid);
}
```
